# Optimizing an MI355X kernel written in HIP

```python
import math
import jax, jax.numpy as jnp
from jax import lax
import numpy as np

D_MODEL = 2048
BATCH = 16
SEQ = 256
DEPTH = 2
DEC_BATCH = 2
DEC_SEQ = 1024
PAST_LEN = 256

GRID_W = 64
N_MIXERS = 2
N_A = (DEPTH + 1) // 2
N_B = DEPTH // 2
DN_DK = 128
DN_DV = 128
DN_HEADS_K = D_MODEL // DN_DK
DN_HEADS_V = 2 * DN_HEADS_K
DN_K_DIM = DN_HEADS_K * DN_DK
DN_V_DIM = DN_HEADS_V * DN_DV
DN_QKV_DIM = 2 * DN_K_DIM + DN_V_DIM
DN_PROJ = DN_QKV_DIM + DN_V_DIM + 4 * DN_HEADS_V
DN_CONV = 5
DN_CHUNK = 64
CM_DIM = 2 * D_MODEL
CM_CHUNK = 128
CM_GROUPS = 16
CM_GDIM = CM_DIM // CM_GROUPS
FF_DIM = 4 * D_MODEL
N_MOD = 6
EPS = 1e-6

kernel_name = 'hybrid_deltanet_chunkmlp_diffusion_step'


def rms_norm(x, w):
    xf = x.astype(jnp.float32)
    y = xf * lax.rsqrt(jnp.mean(xf * xf, axis=-1, keepdims=True) + EPS)
    return (y * w.astype(jnp.float32)).astype(x.dtype)


def layer_norm(x, w, b):
    xf = x.astype(jnp.float32)
    mu = jnp.mean(xf, axis=-1, keepdims=True)
    xc = xf - mu
    y = xc * lax.rsqrt(jnp.mean(xc * xc, axis=-1, keepdims=True) + EPS)
    return (y * w.astype(jnp.float32) + b.astype(jnp.float32)).astype(x.dtype)


def l2_norm(x):
    xf = x.astype(jnp.float32)
    return xf * lax.rsqrt(jnp.sum(xf * xf, axis=-1, keepdims=True) + EPS)


def grid_pos_embed(n_tokens, dtype):
    rows = n_tokens // GRID_W
    r = jnp.repeat(jnp.arange(rows), GRID_W).astype(jnp.float32)
    col = jnp.tile(jnp.arange(GRID_W), rows).astype(jnp.float32)
    quarter = D_MODEL // 4
    freq = 1.0 / (10000.0 ** (jnp.arange(quarter, dtype=jnp.float32) / quarter))
    ar = r[:, None] * freq[None, :]
    ac = col[:, None] * freq[None, :]
    pe = jnp.concatenate([jnp.sin(ar), jnp.cos(ar), jnp.sin(ac), jnp.cos(ac)], axis=-1)
    return pe.astype(dtype)


def adaln(cond, w_ada, b_ada):
    mod = (jax.nn.silu(cond) @ w_ada + b_ada)[:, None, :]
    return jnp.split(mod, N_MOD, axis=-1)


def modulate(h, shift, scale):
    return h * (1 + scale) + shift


def short_conv_centred(x, w):
    k_w = w.shape[0]
    pad = k_w // 2
    n = x.shape[1]
    xp = jnp.pad(x, ((0, 0), (pad, pad), (0, 0)))
    return sum(xp[:, j:j + n] * w[j] for j in range(k_w))


def gated_delta_chunked(q, k, v, log_g, beta, s0):
    b_sz, n_tok, n_h, dk = q.shape
    dv = v.shape[-1]
    c_len = DN_CHUNK
    n_ch = n_tok // c_len
    f32 = jnp.float32

    def chunks(t):
        t = t.astype(f32).reshape((b_sz, n_ch, c_len, n_h) + t.shape[3:])
        return jnp.moveaxis(t, (1, 3), (0, 2))

    qc, kc, vc = chunks(q), chunks(k), chunks(v)
    gc = jnp.cumsum(chunks(log_g), axis=-1)
    bc = chunks(beta)
    causal = jnp.tril(jnp.ones((c_len, c_len), dtype=bool))
    strict = jnp.tril(jnp.ones((c_len, c_len), dtype=bool), -1)
    decay = jnp.exp(jnp.where(causal, gc[..., :, None] - gc[..., None, :], -jnp.inf))
    kb = kc * bc[..., None]
    a_mat = jnp.where(strict, jnp.einsum('nbhik,nbhjk->nbhij', kb, kc) * decay, 0.0)
    t_sys = a_mat + jnp.eye(c_len, dtype=f32)
    rhs = jnp.concatenate([vc * bc[..., None], kb * jnp.exp(gc)[..., None]], axis=-1)
    sol = lax.linalg.triangular_solve(t_sys, rhs, left_side=True, lower=True, unit_diagonal=True)
    w_val, u_key = sol[..., :dv], sol[..., dv:]
    intra = jnp.einsum('nbhik,nbhjk->nbhij', qc, kc) * decay
    q_dec = qc * jnp.exp(gc)[..., None]
    g_last = gc[..., -1]
    k_dec = kc * jnp.exp(g_last[..., None] - gc)[..., None]

    def step(s, xs):
        w_i, u_i, intra_i, qd_i, kd_i, gl_i = xs
        v_new = w_i - jnp.einsum('bhck,bhkv->bhcv', u_i, s)
        o_i = jnp.einsum('bhck,bhkv->bhcv', qd_i, s) + jnp.einsum('bhij,bhjv->bhiv', intra_i, v_new)
        s = s * jnp.exp(gl_i)[..., None, None] + jnp.einsum('bhck,bhcv->bhkv', kd_i, v_new)
        return s, o_i

    s_fin, o = lax.scan(step, s0.astype(f32), (w_val, u_key, intra, q_dec, k_dec, g_last))
    o = jnp.moveaxis(o, (0, 2), (1, 3)).reshape(b_sz, n_tok, n_h, dv)
    return o, s_fin


def deltanet_mixer(h, s0_fwd, s0_bwd, w_in, conv_w, a_log, dt_bias, norm_w, w_out):
    b_sz, n_tok, _ = h.shape
    p = h @ w_in
    qkv = p[..., :DN_QKV_DIM]
    z = p[..., DN_QKV_DIM:DN_QKV_DIM + DN_V_DIM]
    ab = p[..., DN_QKV_DIM + DN_V_DIM:].reshape(b_sz, n_tok, 2, 2, DN_HEADS_V)
    qkv = jax.nn.silu(short_conv_centred(qkv, conv_w))
    q = qkv[..., :DN_K_DIM].reshape(b_sz, n_tok, DN_HEADS_K, DN_DK)
    k = qkv[..., DN_K_DIM:2 * DN_K_DIM].reshape(b_sz, n_tok, DN_HEADS_K, DN_DK)
    v = qkv[..., 2 * DN_K_DIM:].reshape(b_sz, n_tok, DN_HEADS_V, DN_DV)
    rep = DN_HEADS_V // DN_HEADS_K
    q = jnp.repeat(l2_norm(q) * (DN_DK ** -0.5), rep, axis=2)
    k = jnp.repeat(l2_norm(k), rep, axis=2)
    ab = ab.astype(jnp.float32)
    log_g = -jnp.exp(a_log.astype(jnp.float32)) * jax.nn.softplus(ab[..., 0, :] + dt_bias.astype(jnp.float32))
    beta = jax.nn.sigmoid(ab[..., 1, :])
    o_f, s_f = gated_delta_chunked(q, k, v, log_g[:, :, 0], beta[:, :, 0], s0_fwd)
    o_b, s_b = gated_delta_chunked(q[:, ::-1], k[:, ::-1], v[:, ::-1], log_g[:, ::-1, 1], beta[:, ::-1, 1], s0_bwd)
    o = o_f + o_b[:, ::-1]
    o = rms_norm(o, norm_w) * jax.nn.silu(z.reshape(b_sz, n_tok, DN_HEADS_V, DN_DV).astype(jnp.float32))
    out = o.reshape(b_sz, n_tok, DN_V_DIM).astype(h.dtype) @ w_out
    return out, s_f, s_b


def chunk_mlp_mixer(h, w_in, b_in, ln_w, ln_b, w_s, b_s, w_out):
    b_sz, n_tok, _ = h.shape
    zz = jax.nn.gelu(h @ w_in + b_in)
    u, v = jnp.split(zz, 2, axis=-1)
    v = layer_norm(v, ln_w, ln_b)
    v = v.reshape(b_sz, n_tok // CM_CHUNK, CM_CHUNK, CM_GROUPS, CM_GDIM)
    v = jnp.einsum('gpq,bnqgc->bnpgc', w_s, v) + b_s.T[None, None, :, :, None]
    return (u * v.reshape(b_sz, n_tok, CM_DIM)) @ w_out


def squared_relu_mlp(h, w1, w2):
    return jnp.square(jax.nn.relu(h @ w1)) @ w2


def setup_inputs(seed: int = 0) -> dict:
    key = jax.random.key(seed)
    ks = jax.random.split(key, 32)
    f32 = jnp.float32

    def nrm(k, shape, scale):
        return jax.random.normal(k, shape, f32) * scale

    dt = jnp.exp(jax.random.uniform(ks[13], (N_A, 2, DN_HEADS_V), f32, math.log(1e-3), math.log(1e-1)))
    return {
        'x_prompt': nrm(ks[0], (BATCH, SEQ, D_MODEL), 1.0),
        'x_sample': nrm(ks[1], (DEC_BATCH, DEC_SEQ, D_MODEL), 1.0),
        'state_dn_fwd': nrm(ks[2], (DEC_BATCH, N_A, DN_HEADS_V, DN_DK, DN_DV), 0.2),
        'state_dn_bwd': nrm(ks[3], (DEC_BATCH, N_A, DN_HEADS_V, DN_DK, DN_DV), 0.2),
        'c': nrm(ks[4], (DEC_BATCH, D_MODEL), 1.0),
        'c_ctx': nrm(ks[5], (D_MODEL,), 1.0),
        'norm_mix_w': 1.0 + nrm(ks[6], (DEPTH, D_MODEL), 0.01),
        'norm_mlp_w': 1.0 + nrm(ks[7], (DEPTH, D_MODEL), 0.01),
        'w_ada': nrm(ks[8], (DEPTH, D_MODEL, N_MOD * D_MODEL), 0.5 * D_MODEL ** -0.5),
        'b_ada': nrm(ks[9], (DEPTH, N_MOD * D_MODEL), 0.01),
        'dn_w_in': nrm(ks[10], (N_A, D_MODEL, DN_PROJ), D_MODEL ** -0.5),
        'dn_conv_w': nrm(ks[11], (N_A, DN_CONV, DN_QKV_DIM), DN_CONV ** -0.5),
        'dn_A_log': jnp.log(jax.random.uniform(ks[12], (N_A, 2, DN_HEADS_V), f32, 1.0, 16.0)),
        'dn_dt_bias': dt + jnp.log(-jnp.expm1(-dt)),
        'dn_norm_w': 1.0 + nrm(ks[14], (N_A, DN_DV), 0.01),
        'dn_w_out': nrm(ks[15], (N_A, DN_V_DIM, D_MODEL), DN_V_DIM ** -0.5),
        'cm_w_in': nrm(ks[16], (N_B, D_MODEL, 2 * CM_DIM), D_MODEL ** -0.5),
        'cm_b_in': nrm(ks[17], (N_B, 2 * CM_DIM), 0.01),
        'cm_ln_w': 1.0 + nrm(ks[18], (N_B, CM_DIM), 0.01),
        'cm_ln_b': nrm(ks[19], (N_B, CM_DIM), 0.01),
        'cm_w_s': nrm(ks[20], (N_B, CM_GROUPS, CM_CHUNK, CM_CHUNK), CM_CHUNK ** -0.5),
        'cm_b_s': 1.0 + nrm(ks[21], (N_B, CM_GROUPS, CM_CHUNK), 0.01),
        'cm_w_out': nrm(ks[22], (N_B, CM_DIM, D_MODEL), CM_DIM ** -0.5),
        'w_ff1': nrm(ks[23], (DEPTH, D_MODEL, FF_DIM), D_MODEL ** -0.5),
        'w_ff2': nrm(ks[24], (DEPTH, FF_DIM, D_MODEL), FF_DIM ** -0.5),
        'final_norm_w': 1.0 + nrm(ks[25], (D_MODEL,), 0.01),
    }


def reference(x_prompt, x_sample, state_dn_fwd, state_dn_bwd, c, c_ctx, norm_mix_w, norm_mlp_w,
              w_ada, b_ada, dn_w_in, dn_conv_w, dn_A_log, dn_dt_bias, dn_norm_w, dn_w_out,
              cm_w_in, cm_b_in, cm_ln_w, cm_ln_b, cm_w_s, cm_b_s, cm_w_out, w_ff1, w_ff2, final_norm_w):
    ctx = x_prompt
    lat = x_sample + grid_pos_embed(x_sample.shape[1], x_sample.dtype)[None]
    cond_ctx = c_ctx[None, :]
    zero_state = jnp.zeros((x_prompt.shape[0], DN_HEADS_V, DN_DK, DN_DV), jnp.float32)
    new_fwd, new_bwd = [], []
    for i in range(DEPTH):
        j = i // N_MIXERS
        sh_c, sc_c, g_c, sh2_c, sc2_c, g2_c = adaln(cond_ctx, w_ada[i], b_ada[i])
        sh_l, sc_l, g_l, sh2_l, sc2_l, g2_l = adaln(c, w_ada[i], b_ada[i])
        h_c = modulate(rms_norm(ctx, norm_mix_w[i]), sh_c, sc_c)
        h_l = modulate(rms_norm(lat, norm_mix_w[i]), sh_l, sc_l)
        if i % N_MIXERS == 0:
            dn = (dn_w_in[j], dn_conv_w[j], dn_A_log[j], dn_dt_bias[j], dn_norm_w[j], dn_w_out[j])
            m_c, s_f, s_b = deltanet_mixer(h_c, zero_state, zero_state, *dn)
            m_l, _, _ = deltanet_mixer(h_l, state_dn_fwd[:, j], state_dn_bwd[:, j], *dn)
            new_fwd.append(s_f.astype(x_prompt.dtype))
            new_bwd.append(s_b.astype(x_prompt.dtype))
        else:
            cm = (cm_w_in[j], cm_b_in[j], cm_ln_w[j], cm_ln_b[j], cm_w_s[j], cm_b_s[j], cm_w_out[j])
            m_c = chunk_mlp_mixer(h_c, *cm)
            m_l = chunk_mlp_mixer(h_l, *cm)
        ctx = ctx + g_c * m_c
        lat = lat + g_l * m_l
        ctx = ctx + g2_c * squared_relu_mlp(modulate(rms_norm(ctx, norm_mlp_w[i]), sh2_c, sc2_c), w_ff1[i], w_ff2[i])
        lat = lat + g2_l * squared_relu_mlp(modulate(rms_norm(lat, norm_mlp_w[i]), sh2_l, sc2_l), w_ff1[i], w_ff2[i])
    y_prompt = rms_norm(ctx, final_norm_w)
    y_sample = rms_norm(lat, final_norm_w)
    new_state_dn_fwd = jnp.stack(new_fwd, axis=1)
    new_state_dn_bwd = jnp.stack(new_bwd, axis=1)
    return (y_prompt, y_sample, new_state_dn_fwd, new_state_dn_bwd)
```

```cpp
#include <hip/hip_runtime.h>
#include <hip/hip_cooperative_groups.h>
#include <cstdio>
#include <cstdint>
namespace cg = cooperative_groups;
#ifndef MK_PER_PHASE
#define MK_PER_PHASE 1
#endif
namespace pg8 {
#define PG8_LAS __attribute__((address_space(3)))
typedef unsigned short bf16_t;
typedef short bf16x8 __attribute__((ext_vector_type(8)));
typedef float f32x4 __attribute__((ext_vector_type(4)));
typedef unsigned u32x4 __attribute__((ext_vector_type(4)));
constexpr int BM = 256, BK = 64, HALF = 128, HTB = HALF * BK * 2  , STAGE_BYTES = 8 * HTB, NXCD = 8, WGM = 8;

__host__ __device__ __forceinline__ int lds_byte(int r, int c) { const int st = (r >> 4) * 2 + (c >> 5), rr = r & 15, cc = c & 31, ob = rr * 64 + cc * 2; return st * 1024 + (ob ^ (((ob >> 9) & 1) << 5)); }
__host__ __device__ __forceinline__ void stage_rc(int b, int& R, int& C) { const int st = b / 1024, sb = b % 1024, swz = sb ^ (((sb >> 9) & 1) << 5); R = (st >> 1) * 16 + swz / 64; C = (st & 1) * 32 + (swz % 64) / 2; }
__host__ __device__ __forceinline__ int perm32(int rho) { const int n = rho >> 4, i = rho & 15; return 8 * (i >> 2) + 4 * n + (i & 3); }

struct Unit { int pm, pn; };
struct Gemm { const bf16_t* A; const bf16_t* Bt; int M, N, K; };

struct StaticOrder {
    int nM, nN, nwg, G, c;
    __host__ __device__ void init(int M, int N, int G_, int c_) { nM = M / BM; nN = N / BM; nwg = nM * nN; G = G_; c = c_; }
    __host__ __device__ bool next(int i, Unit& u) const {
        const long L = (long)i * G + c; if (L >= nwg) return false;
        int wgid = (int)L; { const int q = nwg / NXCD, r = nwg % NXCD, xcd = wgid % NXCD, off = wgid / NXCD; wgid = (xcd < r ? xcd * (q + 1) : r * (q + 1) + (xcd - r) * q) + off; }
        const int nig = WGM * nN, gid = wgid / nig, fm = gid * WGM, gsz = (nM - fm) < WGM ? (nM - fm) : WGM;
        u.pm = fm + ((wgid % nig) % gsz); u.pn = (wgid % nig) / gsz; return true;
    }
    __device__ __forceinline__ void a_ready(const Unit&) const {}
    __device__ __forceinline__ void done(const Unit&) const {}
};

__device__ __forceinline__ unsigned cvt_pk_bf16(float lo, float hi) { unsigned r; asm volatile("v_cvt_pk_bf16_f32 %0, %1, %2" : "=v"(r) : "v"(lo), "v"(hi)); return r; }
__device__ __forceinline__ u32x4 pack8(const f32x4 v0, const f32x4 v1) { u32x4 w; w.x = cvt_pk_bf16(v0[0], v0[1]); w.y = cvt_pk_bf16(v0[2], v0[3]); w.z = cvt_pk_bf16(v1[0], v1[1]); w.w = cvt_pk_bf16(v1[2], v1[3]); return w; }
__device__ __forceinline__ float gelu_tanh(float x) {
    const float u = 0.7978845608028654f * (x + 0.044715f * x * x * x);
    const float e = __builtin_amdgcn_exp2f(-2.0f * 1.4426950408889634f * u);
    return x * __builtin_amdgcn_rcpf(1.0f + e);
}
struct EpiProj {
    static constexpr bool PERM = true, AFTER_DRAIN = false;
    bf16_t* QKV; bf16_t* Z; float* AB;
    __device__ __forceinline__ void operator()(const f32x4 (&acc)[2][2][4][2], const Unit& u, int wr, int wc, int fr, int fq) const {
        const int row0 = u.pm * BM + wr * 64 + fr, cin = wc * 32 + 8 * fq;
        if (u.pn < 48) {
            bf16_t* base; int ldc, colt;
            if (u.pn < 32) { base = QKV; ldc = 8192; colt = u.pn * BM; } else { base = Z; ldc = 4096; colt = (u.pn - 32) * BM; }
#pragma unroll
            for (int ai = 0; ai < 2; ++ai)
#pragma unroll
                for (int m = 0; m < 4; ++m) { bf16_t* rowp = base + (size_t)(row0 + ai * HALF + m * 16) * ldc + colt + cin;
#pragma unroll
                    for (int bj = 0; bj < 2; ++bj) *(u32x4*)(rowp + bj * HALF) = pack8(acc[ai][bj][m][0], acc[ai][bj][m][1]); }
        } else {
#pragma unroll
            for (int ai = 0; ai < 2; ++ai)
#pragma unroll
                for (int m = 0; m < 4; ++m) { float* rowp = AB + (size_t)(row0 + ai * HALF + m * 16) * 128 + cin;
                    *(f32x4*)(rowp) = acc[ai][0][m][0]; *(f32x4*)(rowp + 4) = acc[ai][0][m][1]; }
        }
    }
};
struct EpiRes {
    static constexpr bool PERM = false, AFTER_DRAIN = false;
    float* X; const float* gate;
    __device__ __forceinline__ void operator()(const f32x4 (&acc)[2][2][4][2], const Unit& u, int wr, int wc, int fr, int fq) const {
        const int cond = u.pm < 16 ? 0 : (u.pm < 20 ? 1 : 2);
        const int row0 = u.pm * BM + wr * 64 + fr, col0 = u.pn * BM + wc * 32 + 4 * fq;
        const float* gp = gate + cond * 12288 + col0;
        f32x4 gv[2][2];
#pragma unroll
        for (int bj = 0; bj < 2; ++bj)
#pragma unroll
            for (int n = 0; n < 2; ++n) gv[bj][n] = *(const f32x4*)(gp + bj * HALF + n * 16);
#pragma unroll
        for (int ai = 0; ai < 2; ++ai)
#pragma unroll
            for (int m = 0; m < 4; ++m) { float* xp = X + (size_t)(row0 + ai * HALF + m * 16) * 2048 + col0;
#pragma unroll
                for (int bj = 0; bj < 2; ++bj)
#pragma unroll
                    for (int n = 0; n < 2; ++n) { f32x4 x = *(const f32x4*)(xp + bj * HALF + n * 16); x = x + gv[bj][n] * acc[ai][bj][m][n]; *(f32x4*)(xp + bj * HALF + n * 16) = x; } }
    }
};
template <int ACT> struct EpiAct {
    static constexpr bool PERM = true, AFTER_DRAIN = false;
    bf16_t* H; const float* bias; float* stats;
    __device__ __forceinline__ void operator()(const f32x4 (&acc)[2][2][4][2], const Unit& u, int wr, int wc, int fr, int fq) const {
        const int row0 = u.pm * BM + wr * 64 + fr, col0 = u.pn * BM + wc * 32 + 8 * fq;
        f32x4 bv[2][2];
#pragma unroll
        for (int bj = 0; bj < 2; ++bj)
#pragma unroll
            for (int n = 0; n < 2; ++n) bv[bj][n] = (ACT == 1) ? *(const f32x4*)(bias + col0 + bj * HALF + 4 * n) : (f32x4){0.f, 0.f, 0.f, 0.f};
#pragma unroll
        for (int ai = 0; ai < 2; ++ai)
#pragma unroll
            for (int m = 0; m < 4; ++m) { const int row = row0 + ai * HALF + m * 16; bf16_t* rowp = H + (size_t)row * 8192 + col0; float s1 = 0.f, s2 = 0.f;
#pragma unroll
                for (int bj = 0; bj < 2; ++bj) { f32x4 v0 = acc[ai][bj][m][0] + bv[bj][0], v1 = acc[ai][bj][m][1] + bv[bj][1];
#pragma unroll
                    for (int e = 0; e < 4; ++e) {
                        if (ACT == 0) { const float a = fmaxf(v0[e], 0.f), b = fmaxf(v1[e], 0.f); v0[e] = a * a; v1[e] = b * b; }
                        else { v0[e] = gelu_tanh(v0[e]); v1[e] = gelu_tanh(v1[e]); s1 += v0[e] + v1[e]; s2 += v0[e] * v0[e] + v1[e] * v1[e]; } }
                    *(u32x4*)(rowp + bj * HALF) = pack8(v0, v1); }
                if (ACT == 1) { if (u.pn >= 16) { s1 += __shfl_xor(s1, 16); s1 += __shfl_xor(s1, 32); s2 += __shfl_xor(s2, 16); s2 += __shfl_xor(s2, 32);
                    if (fq == 0) { typedef float f32x2 __attribute__((ext_vector_type(2))); *(f32x2*)(stats + (size_t)row * 128 + ((u.pn - 16) * 4 + wc) * 2) = (f32x2){s1, s2}; } } }
            }
    }
};

template <class Epi, class Sched, bool ALIGN_EPI = false, bool SP2 = false>
__device__ __forceinline__ void gemm_phase(PG8_LAS unsigned char* lds, const Gemm g, const Sched& S, const Epi& E) {
    const int tid = threadIdx.x, wid = __builtin_amdgcn_readfirstlane(tid >> 6), lane = tid & 63, wr = wid >> 2, wc = wid & 3, fr = lane & 15, fq = lane >> 4;
    const int K = g.K, nt = K / BK;
    unsigned voffA[2], voffB[2];
#pragma unroll
    for (int i = 0; i < 2; ++i) { int R, C; stage_rc(tid * 16 + i * 8192, R, C); const int Rb = Epi::PERM ? ((R & ~31) + perm32(R & 31)) : R;
        voffA[i] = (unsigned)(R * K + C) * 2u; voffB[i] = (unsigned)(Rb * K + C) * 2u; }
    const size_t kstep = (size_t)(BK * 2);
    const size_t hstep = (size_t)HALF * K * 2;
    const size_t tstep = 2 * hstep;
    const unsigned ldsw = (unsigned)wid * 1024u;
    const int aoff = lds_byte(wr * 64 + fr, fq * 8), boff = lds_byte(wc * 32 + fr, fq * 8);
#define PG8_SA(b, h) (((b) * 2 + (h)) * HTB)
#define PG8_SB(b, h) ((4 + (b) * 2 + (h)) * HTB)
#define PG8_STAGE(bufoff, gbase, voff) do { _Pragma("unroll") for (int _i = 0; _i < 2; ++_i) \
        __builtin_amdgcn_global_load_lds((const unsigned*)((const char*)(gbase) + (voff)[_i]), (PG8_LAS unsigned*)(lds + (bufoff) + ldsw + _i * 8192), 16, 0, 0); } while (0)
#define PG8_LDA(dst, b, h) do { _Pragma("unroll") for (int m = 0; m < 4; ++m) _Pragma("unroll") for (int k = 0; k < 2; ++k) dst[m][k] = *(const PG8_LAS bf16x8*)(lds + PG8_SA(b, h) + aoff + m * 2048 + k * 1024); } while (0)
#define PG8_LDB(dst, b, h) do { _Pragma("unroll") for (int n = 0; n < 2; ++n) _Pragma("unroll") for (int k = 0; k < 2; ++k) dst[n][k] = *(const PG8_LAS bf16x8*)(lds + PG8_SB(b, h) + boff + n * 2048 + k * 1024); } while (0)
#define PG8_MMA(ai, bj, At, Bt) do { __builtin_amdgcn_s_setprio(1); _Pragma("unroll") for (int m = 0; m < 4; ++m) _Pragma("unroll") for (int n = 0; n < 2; ++n) _Pragma("unroll") for (int k = 0; k < 2; ++k) \
        acc[ai][bj][m][n] = __builtin_amdgcn_mfma_f32_16x16x32_bf16(Bt[n][k], At[m][k], acc[ai][bj][m][n], 0, 0, 0); __builtin_amdgcn_s_setprio(0); } while (0)
#define PG8_WAIT_V(n) asm volatile("s_waitcnt vmcnt(" #n ")" ::: "memory")
#define PG8_WAIT_L(n) asm volatile("s_waitcnt lgkmcnt(" #n ")" ::: "memory")
#define PG8_BAR __builtin_amdgcn_s_barrier()
#define PG8_SCHED __builtin_amdgcn_sched_barrier(0)
    Unit cur, nxt; int ui = 0;
    if (!S.next(0, cur)) return;
    f32x4 acc[2][2][4][2];
#pragma unroll
    for (int a = 0; a < 2; ++a)
#pragma unroll
        for (int b = 0; b < 2; ++b)
#pragma unroll
            for (int m = 0; m < 4; ++m)
#pragma unroll
                for (int n = 0; n < 2; ++n) acc[a][b][m][n] = (f32x4){0.f, 0.f, 0.f, 0.f};
    bf16x8 At[4][2], B0[2][2], B1[2][2];
    const char* cA = (const char*)g.A + (size_t)cur.pm * tstep; const char* cB = (const char*)g.Bt + (size_t)cur.pn * tstep;
    S.a_ready(cur);
    if constexpr (SP2) {
        PG8_STAGE(PG8_SB(0, 0), cB, voffB); PG8_STAGE(PG8_SB(0, 1), cB + hstep, voffB); PG8_STAGE(PG8_SA(0, 0), cA, voffA); PG8_STAGE(PG8_SA(0, 1), cA + hstep, voffA);
        if (wr == 1) PG8_BAR;
        PG8_WAIT_V(2); PG8_BAR;
        PG8_STAGE(PG8_SB(1, 0), cB + kstep, voffB); PG8_STAGE(PG8_SA(1, 0), cA + kstep, voffA); PG8_STAGE(PG8_SB(1, 1), cB + hstep + kstep, voffB);
        PG8_WAIT_V(6); PG8_BAR;
    } else {
        PG8_STAGE(PG8_SB(0, 0), cB, voffB); PG8_STAGE(PG8_SA(0, 0), cA, voffA); PG8_STAGE(PG8_SB(0, 1), cB + hstep, voffB); PG8_STAGE(PG8_SA(0, 1), cA + hstep, voffA);
        if (wr == 1) PG8_BAR;
        PG8_WAIT_V(4); PG8_BAR;
        PG8_STAGE(PG8_SB(1, 0), cB + kstep, voffB); PG8_STAGE(PG8_SA(1, 0), cA + kstep, voffA); PG8_STAGE(PG8_SB(1, 1), cB + hstep + kstep, voffB);
        PG8_WAIT_V(6); PG8_BAR;
    }
    for (;;) {
        const bool has_next = S.next(ui + 1, nxt);
        const char* nA = has_next ? (const char*)g.A + (size_t)nxt.pm * tstep : cA; const char* nB = has_next ? (const char*)g.Bt + (size_t)nxt.pn * tstep : cB;
        for (int t = 0; t < nt; t += 2) {
            const bool last = (t == nt - 2);
            const char* a1 = cA + (size_t)(t + 1) * kstep;
            const char* a2 = last ? nA : cA + (size_t)(t + 2) * kstep; const char* b2 = last ? nB : cB + (size_t)(t + 2) * kstep;
            const char* a3 = a2 + kstep; const char* b3 = b2 + kstep;
            if (last && has_next) S.a_ready(nxt);
            if constexpr (SP2) {
            PG8_LDB(B0, 0, 0); PG8_LDB(B1, 0, 1); PG8_SCHED; PG8_LDA(At, 0, 0); PG8_STAGE(PG8_SA(1, 1), a1 + hstep, voffA);
            PG8_WAIT_V(8); PG8_WAIT_L(0); PG8_BAR; PG8_MMA(0, 0, At, B0); PG8_MMA(0, 1, At, B1); PG8_BAR; PG8_SCHED;
            PG8_LDA(At, 0, 1); PG8_STAGE(PG8_SB(0, 0), b2, voffB); PG8_STAGE(PG8_SB(0, 1), b2 + hstep, voffB); PG8_STAGE(PG8_SA(0, 0), a2, voffA);
            PG8_WAIT_V(8); PG8_WAIT_L(0); PG8_BAR; PG8_MMA(1, 0, At, B0); PG8_MMA(1, 1, At, B1); PG8_BAR; PG8_SCHED;
            PG8_LDB(B0, 1, 0); PG8_LDB(B1, 1, 1); PG8_SCHED; PG8_LDA(At, 1, 0); PG8_STAGE(PG8_SA(0, 1), a2 + hstep, voffA);
            PG8_WAIT_V(8); PG8_WAIT_L(0); PG8_BAR; PG8_MMA(0, 0, At, B0); PG8_MMA(0, 1, At, B1); PG8_BAR; PG8_SCHED;
            PG8_LDA(At, 1, 1); PG8_STAGE(PG8_SB(1, 0), b3, voffB); PG8_STAGE(PG8_SB(1, 1), b3 + hstep, voffB); PG8_STAGE(PG8_SA(1, 0), a3, voffA);
            PG8_WAIT_V(8); PG8_WAIT_L(0); PG8_BAR; PG8_MMA(1, 0, At, B0); PG8_MMA(1, 1, At, B1); PG8_BAR; PG8_SCHED;
            } else {
            PG8_LDB(B0, 0, 0); PG8_SCHED; PG8_LDA(At, 0, 0); PG8_STAGE(PG8_SA(1, 1), a1 + hstep, voffA);
            PG8_WAIT_L(8); PG8_BAR; PG8_WAIT_L(0); PG8_MMA(0, 0, At, B0); PG8_BAR; PG8_SCHED;
            PG8_LDB(B1, 0, 1); PG8_STAGE(PG8_SB(0, 0), b2, voffB);
            PG8_BAR; PG8_WAIT_L(0); PG8_MMA(0, 1, At, B1); PG8_BAR;
            PG8_LDA(At, 0, 1); PG8_STAGE(PG8_SA(0, 0), a2, voffA);
            PG8_BAR; PG8_WAIT_L(0); PG8_MMA(1, 0, At, B0); PG8_BAR; PG8_SCHED;
            PG8_STAGE(PG8_SB(0, 1), b2 + hstep, voffB);
            PG8_WAIT_V(6); PG8_BAR; PG8_MMA(1, 1, At, B1); PG8_BAR;
            PG8_LDB(B0, 1, 0); PG8_SCHED; PG8_LDA(At, 1, 0); PG8_STAGE(PG8_SA(0, 1), a2 + hstep, voffA);
            PG8_WAIT_L(8); PG8_BAR; PG8_WAIT_L(0); PG8_MMA(0, 0, At, B0); PG8_BAR; PG8_SCHED;
            PG8_LDB(B1, 1, 1); PG8_STAGE(PG8_SB(1, 0), b3, voffB);
            PG8_BAR; PG8_WAIT_L(0); PG8_MMA(0, 1, At, B1); PG8_BAR;
            PG8_LDA(At, 1, 1); PG8_STAGE(PG8_SA(1, 0), a3, voffA);
            PG8_BAR; PG8_WAIT_L(0); PG8_MMA(1, 0, At, B0); PG8_BAR; PG8_SCHED;
            PG8_STAGE(PG8_SB(1, 1), b3 + hstep, voffB);
            PG8_WAIT_V(6); PG8_BAR; PG8_MMA(1, 1, At, B1); PG8_BAR;
            }
        }
        if constexpr (ALIGN_EPI) { if (wr == 0) PG8_BAR; }
        if constexpr (!Epi::AFTER_DRAIN) { E(acc, cur, wr, wc, fr, fq); S.done(cur); }
        if (!has_next) break;
#pragma unroll
        for (int a = 0; a < 2; ++a)
#pragma unroll
            for (int b = 0; b < 2; ++b)
#pragma unroll
                for (int m = 0; m < 4; ++m)
#pragma unroll
                    for (int n = 0; n < 2; ++n) acc[a][b][m][n] = (f32x4){0.f, 0.f, 0.f, 0.f};
        cur = nxt; cA = nA; cB = nB; ++ui;
        if constexpr (ALIGN_EPI) { if (wr == 1) PG8_BAR; }
    }
    PG8_WAIT_V(0);
    if constexpr (!ALIGN_EPI) { if (wr == 0) PG8_BAR; }
    PG8_BAR;
    if constexpr (Epi::AFTER_DRAIN) { E.fused(acc, cur, wr, wc, fr, fq, lds, wid, lane); S.done(cur); }
#undef PG8_SA
#undef PG8_SB
#undef PG8_STAGE
#undef PG8_LDA
#undef PG8_LDB
#undef PG8_MMA
#undef PG8_WAIT_V
#undef PG8_WAIT_L
#undef PG8_BAR
#undef PG8_SCHED
}
}
#define LAS __attribute__((address_space(3)))
typedef unsigned short bf16;
typedef unsigned v4u __attribute__((ext_vector_type(4)));
typedef unsigned v2u __attribute__((ext_vector_type(2)));
typedef float f32x4 __attribute__((ext_vector_type(4)));
typedef float f32x2 __attribute__((ext_vector_type(2)));
typedef float f32x16 __attribute__((ext_vector_type(16)));
typedef short bf16x8 __attribute__((ext_vector_type(8)));

constexpr int NWAVES = 8;
constexpr int DM = 2048, MROWS = 6144;
constexpr int NPROJ = 12416, NPROJ_PAD = 12544;
constexpr int LDS_BYTES = 147456;
constexpr size_t MiB = 1u << 20;
constexpr size_t WS_CTL = 0, WS_MOD = 1 * MiB, WS_AB = 2 * MiB, WS_STATS = 6 * MiB, WS_VEC = 10 * MiB;
constexpr size_t WS_WIN = 16 * MiB, WS_WOUT = 65 * MiB, WS_WCMIN = 81 * MiB, WS_WCMOUT = 113 * MiB, WS_WFF1 = 129 * MiB, WS_WFF2 = 193 * MiB, WS_WSB = 257 * MiB;
constexpr size_t WS_X = 258 * MiB, WS_XN = 306 * MiB, WS_QKV = 330 * MiB  , WS_Z = 426 * MiB  ;
constexpr size_t WS_KA = 474 * MiB  , WS_QA = 498 * MiB, WS_KT = 522 * MiB, WS_VT = 546 * MiB, WS_TB = 594 * MiB, WS_IN = 642 * MiB, WS_END = 690 * MiB;
constexpr size_t OUT_SF = (size_t)MROWS * DM, OUT_SB = OUT_SF + (size_t)16 * 32 * 128 * 128;

struct Params { const float* in[26]; float* out; unsigned char* ws; int ph_lo, ph_hi; };

__device__ __forceinline__ unsigned f2bf(float f) { unsigned u = __builtin_bit_cast(unsigned, f); return (u + 0x7fffu + ((u >> 16) & 1u)) >> 16; }
__device__ __forceinline__ unsigned pk2(float lo, float hi) { return pg8::cvt_pk_bf16(lo, hi); }
__device__ __forceinline__ float bflo(unsigned u) { return __builtin_bit_cast(float, u << 16); }
__device__ __forceinline__ float bfhi(unsigned u) { return __builtin_bit_cast(float, u & 0xffff0000u); }
__device__ __forceinline__ float bf2f(bf16 b) { return __builtin_bit_cast(float, (unsigned)b << 16); }
__device__ __forceinline__ float wave_sum(float v) {
#pragma unroll
    for (int o = 1; o < 64; o <<= 1) v += __shfl_xor(v, o);
    return v;
}
__device__ __forceinline__ float silu_f(float x) { return x / (1.0f + __expf(-x)); }
#define LDS_WAIT() asm volatile("s_waitcnt lgkmcnt(0)" ::: "memory")

__device__ __forceinline__ void transpose_item(const float* W, int K, int N, bf16* WT, LAS float* scr, int item, int lane) {
    const int nblk = N >> 6, kb = item / nblk, nb = item - kb * nblk, k0 = kb * 64, n0 = nb * 64;
    const float* src = W + (size_t)k0 * N + n0 + lane;
#pragma unroll 16
    for (int i = 0; i < 64; ++i) scr[i * 65 + lane] = src[(size_t)i * N];
    LDS_WAIT();
    const int c = lane & 7;
#pragma unroll
    for (int j = 0; j < 8; ++j) { const int n = (lane >> 3) + 8 * j; const LAS float* s = scr + (8 * c) * 65 + n;
        v4u o; o.x = pk2(s[0 * 65], s[1 * 65]); o.y = pk2(s[2 * 65], s[3 * 65]); o.z = pk2(s[4 * 65], s[5 * 65]); o.w = pk2(s[6 * 65], s[7 * 65]);
        *(v4u*)(WT + (size_t)(n0 + n) * K + k0 + 8 * c) = o; }
    LDS_WAIT();
}
__device__ __forceinline__ void phase_prologue(const Params& p, LAS unsigned char* lds, int tid, int lane, int wave, int vcu, int G) {
    unsigned char* ws = p.ws;
    {
        LAS float* sc = (LAS float*)lds; LAS float* red = sc + 3 * 2048;
        for (int i = tid; i < 3 * 2048; i += 512) { const int cnd = i >> 11, k = i & 2047; const float x = cnd == 0 ? p.in[5][k] : p.in[4][(cnd - 1) * 2048 + k]; sc[i] = silu_f(x); }
        __syncthreads();
        float* MOD = (float*)(ws + WS_MOD);
        for (int strip = vcu; strip < 256; strip += G) {
            const int l = strip >> 7, n0 = (strip & 127) * 96;
            if (tid < 504) {
                const int cl = tid % 24, g = tid / 24;
                const float* W = p.in[8] + (size_t)l * 2048 * 12288 + n0 + 4 * cl;
                f32x4 a0 = {0.f, 0.f, 0.f, 0.f}, a1 = a0, a2 = a0;
#pragma unroll 7
                for (int k = g; k < 2048; k += 21) { const f32x4 w = *(const f32x4*)(W + (size_t)k * 12288); a0 += w * sc[k]; a1 += w * sc[2048 + k]; a2 += w * sc[4096 + k]; }
                LAS float* r = red + g * 288 + 4 * cl;
                *(LAS f32x4*)(r) = a0; *(LAS f32x4*)(r + 96) = a1; *(LAS f32x4*)(r + 192) = a2;
            }
            __syncthreads();
            if (tid < 288) { float s = 0.f;
#pragma unroll
                for (int g = 0; g < 21; ++g) s += red[g * 288 + tid];
                const int cnd = tid / 96, c = tid % 96; MOD[(l * 3 + cnd) * 12288 + n0 + c] = s + p.in[9][l * 12288 + n0 + c]; }
            __syncthreads();
        }
    }
    {
        LAS float* scr = (LAS float*)(lds + wave * 16640);
        const int gw = vcu * NWAVES + wave, NGW = G * NWAVES;
        constexpr int I0 = 32 * 194, I1 = 64 * 32, I2 = 32 * 128, I3 = 64 * 32, I4 = 32 * 128, I6 = 128 * 32;
        constexpr int NITEMS = I0 + I1 + I2 + I3 + 2 * I4 + 2 * I6;
        for (int it = gw; it < NITEMS; it += NGW) {
            int r = it;
            if (r < I0) { transpose_item(p.in[10], 2048, NPROJ, (bf16*)(ws + WS_WIN), scr, r, lane); continue; } r -= I0;
            if (r < I1) { transpose_item(p.in[15], 4096, 2048, (bf16*)(ws + WS_WOUT), scr, r, lane); continue; } r -= I1;
            if (r < I2) { transpose_item(p.in[16], 2048, 8192, (bf16*)(ws + WS_WCMIN), scr, r, lane); continue; } r -= I2;
            if (r < I3) { transpose_item(p.in[22], 4096, 2048, (bf16*)(ws + WS_WCMOUT), scr, r, lane); continue; } r -= I3;
            if (r < 2 * I4) { const int l = r / I4; transpose_item(p.in[23] + (size_t)l * 2048 * 8192, 2048, 8192, (bf16*)(ws + WS_WFF1) + (size_t)l * 2048 * 8192, scr, r - l * I4, lane); continue; } r -= 2 * I4;
            { const int l = r / I6; transpose_item(p.in[24] + (size_t)l * 2048 * 8192, 8192, 2048, (bf16*)(ws + WS_WFF2) + (size_t)l * 2048 * 8192, scr, r - l * I6, lane); }
        }
    }
    {
        const int gt = vcu * 512 + tid, NT = G * 512;
        const float* wsf = p.in[20]; v4u* dst = (v4u*)(ws + WS_WSB);
        for (int i = gt; i < 32768; i += NT) { const f32x4 a = *(const f32x4*)(wsf + 8 * i), b = *(const f32x4*)(wsf + 8 * i + 4); v4u o; o.x = pk2(a[0], a[1]); o.y = pk2(a[2], a[3]); o.z = pk2(b[0], b[1]); o.w = pk2(b[2], b[3]); dst[i] = o; }
        v4u* pad = (v4u*)((bf16*)(ws + WS_WIN) + (size_t)NPROJ * 2048);
        for (int i = gt; i < 32768; i += NT) pad[i] = (v4u){0u, 0u, 0u, 0u};
    }
}

template <int MODE>
__device__ __forceinline__ void phase_norm(const Params& p, int layer, int which, int lane, int wave, int vcu, int G) {
    unsigned char* ws = p.ws; float* X = (float*)(ws + WS_X); bf16* XN = (bf16*)(ws + WS_XN); const float* MOD = (const float*)(ws + WS_MOD);
    const int gw = vcu * NWAVES + wave, NGW = G * NWAVES;
    for (int row = gw; row < MROWS; row += NGW) {
        f32x4 v[8];
        const float* src = MODE == 0 ? (row < 4096 ? p.in[0] + (size_t)row * DM : p.in[1] + (size_t)(row - 4096) * DM) : X + (size_t)row * DM;
#pragma unroll
        for (int j = 0; j < 8; ++j) v[j] = *(const f32x4*)(src + 4 * (lane + 64 * j));
        if (MODE == 0) {
            if (row >= 4096) {
                const int pos = (row - 4096) & 1023; const float gr = (float)(pos >> 6), gc = (float)(pos & 63);
#pragma unroll
                for (int j = 0; j < 8; ++j) { const float base = (j >> 1) < 2 ? gr : gc;
#pragma unroll
                    for (int e = 0; e < 4; ++e) { const int i = (4 * (lane + 64 * j) + e) & 511; const float fr = expf(-(float)i * (9.210340371976184f / 512.0f)); const float ang = base * fr;
                        v[j][e] += ((j >> 1) & 1) ? cosf(ang) : sinf(ang); } }
            }
#pragma unroll
            for (int j = 0; j < 8; ++j) *(f32x4*)(X + (size_t)row * DM + 4 * (lane + 64 * j)) = v[j];
        }
        float ss = 0.f;
#pragma unroll
        for (int j = 0; j < 8; ++j) ss += (v[j][0] * v[j][0] + v[j][1] * v[j][1]) + (v[j][2] * v[j][2] + v[j][3] * v[j][3]);
        ss = wave_sum(ss);
        const float r = 1.0f / sqrtf(ss * (1.0f / DM) + 1e-6f);
        if (MODE == 2) {
#pragma unroll
            for (int j = 0; j < 8; ++j) { const f32x4 w = *(const f32x4*)(p.in[25] + 4 * (lane + 64 * j)); *(f32x4*)(p.out + (size_t)row * DM + 4 * (lane + 64 * j)) = v[j] * r * w; }
        } else {
            const int cond = row < 4096 ? 0 : (row < 5120 ? 1 : 2);
            const float* nw = p.in[which ? 7 : 6] + layer * DM; const float* mb = MOD + (size_t)(layer * 3 + cond) * 12288 + (which ? 6144 : 0);
#pragma unroll
            for (int j = 0; j < 8; ++j) { const int c = 4 * (lane + 64 * j); const f32x4 w = *(const f32x4*)(nw + c), sh = *(const f32x4*)(mb + c), sc = *(const f32x4*)(mb + 2048 + c);
                const f32x4 y = v[j] * r * w * (sc + 1.0f) + sh; v2u o; o.x = pk2(y[0], y[1]); o.y = pk2(y[2], y[3]); *(v2u*)(XN + (size_t)row * DM + c) = o; }
        }
    }
}

__device__ __forceinline__ void phase_conv(const Params& p, LAS unsigned char* lds, int tid, int lane, int wave, int vcu, int G) {
    unsigned char* ws = p.ws;
    LAS float* XQK = (LAS float*)lds;
    LAS bf16* XV = (LAS bf16*)(lds + 66560);
    LAS float* RN = (LAS float*)(lds + 66560 + 33792);
    const bf16* QKV = (const bf16*)(ws + WS_QKV); const float* cw = p.in[11];
    for (int u = vcu; u < 1536; u += G) {
        const int c = u >> 4, kh = u & 15;
        int s0, s1; if (c < 64) { s0 = (c >> 2) * 256; s1 = s0 + 256; } else { s0 = 4096 + ((c - 64) >> 4) * 1024; s1 = s0 + 1024; }
        {
            const int cp = tid & 255, th = tid >> 8;
            int gcol, lcol; if (cp < 64) { gcol = kh * 128 + 2 * cp; lcol = 2 * cp; } else if (cp < 128) { gcol = 2048 + kh * 128 + 2 * (cp - 64); lcol = 128 + 2 * (cp - 64); } else { gcol = 4096 + kh * 256 + 2 * (cp - 128); lcol = 2 * (cp - 128); }
            float w0[5], w1[5];
#pragma unroll
            for (int j = 0; j < 5; ++j) { w0[j] = cw[j * 8192 + gcol]; w1[j] = cw[j * 8192 + gcol + 1]; }
            const int r0 = c * 64 + th * 32;
            float x0[5], x1[5];
#pragma unroll
            for (int j = 0; j < 4; ++j) { const int rr = r0 - 2 + j; unsigned v = 0u; if (rr >= s0 && rr < s1) v = *(const unsigned*)(QKV + (size_t)rr * 8192 + gcol); x0[j] = bflo(v); x1[j] = bfhi(v); }
#pragma unroll 8
            for (int i = 0; i < 32; ++i) {
                { const int rr = r0 + i + 2; unsigned v = 0u; if (rr >= s0 && rr < s1) v = *(const unsigned*)(QKV + (size_t)rr * 8192 + gcol); x0[4] = bflo(v); x1[4] = bfhi(v); }
                float a0 = 0.f, a1 = 0.f;
#pragma unroll
                for (int j = 0; j < 5; ++j) { a0 += w0[j] * x0[j]; a1 += w1[j] * x1[j]; }
                a0 = silu_f(a0); a1 = silu_f(a1);
                const int t = th * 32 + i;
                if (cp < 128) *(LAS f32x2*)(XQK + t * 260 + lcol) = (f32x2){a0, a1}; else *(LAS unsigned*)(XV + t * 264 + lcol) = pk2(a0, a1);
#pragma unroll
                for (int j = 0; j < 4; ++j) { x0[j] = x0[j + 1]; x1[j] = x1[j + 1]; }
            }
        }
        __syncthreads();
#pragma unroll
        for (int tt = 0; tt < 8; ++tt) { const int t = wave * 8 + tt; const LAS float* r = XQK + t * 260;
            const float a = r[lane], b = r[64 + lane], cc = r[128 + lane], dd = r[192 + lane];
            const float sq = wave_sum(a * a + b * b), sk = wave_sum(cc * cc + dd * dd);
            if (lane == 0) { RN[t] = (1.0f / sqrtf(sq + 1e-6f)) * 0.08838834764831845f; RN[64 + t] = 1.0f / sqrtf(sk + 1e-6f); } }
        __syncthreads();
        v4u* KAo = (v4u*)(ws + WS_KA) + (size_t)u * 1024; v4u* QAo = (v4u*)(ws + WS_QA) + (size_t)u * 1024; v4u* KTo = (v4u*)(ws + WS_KT) + (size_t)u * 1024;
        v4u* VTo = (v4u*)(ws + WS_VT) + (size_t)(c * 32 + 2 * kh) * 1024;
        for (int pi = tid; pi < 1024; pi += 512) {
            const int rb = pi >> 9, s = (pi >> 6) & 7, ln = pi & 63, t = 32 * rb + (ln & 31), h = ln >> 5;
            const LAS float* rq = XQK + t * 260 + 16 * s + 4 * h;
            { const f32x4 a = *(const LAS f32x4*)rq * RN[t], b = *(const LAS f32x4*)(rq + 8) * RN[t]; v4u o; o.x = pk2(a[0], a[1]); o.y = pk2(a[2], a[3]); o.z = pk2(b[0], b[1]); o.w = pk2(b[2], b[3]); QAo[pi] = o; }
            { const f32x4 a = *(const LAS f32x4*)(rq + 128) * RN[64 + t], b = *(const LAS f32x4*)(rq + 136) * RN[64 + t]; v4u o; o.x = pk2(a[0], a[1]); o.y = pk2(a[2], a[3]); o.z = pk2(b[0], b[1]); o.w = pk2(b[2], b[3]); KAo[pi] = o; }
        }
        for (int pi = tid; pi < 1024; pi += 512) {
            const int rb = pi >> 8, s = (pi >> 6) & 3, ln = pi & 63, dk = 32 * rb + (ln & 31), h = ln >> 5, tb = 16 * s + 4 * h;
            float e[8];
#pragma unroll
            for (int j = 0; j < 8; ++j) { const int t = tb + (j & 3) + 8 * (j >> 2); e[j] = XQK[t * 260 + 128 + dk] * RN[64 + t]; }
            v4u o; o.x = pk2(e[0], e[1]); o.y = pk2(e[2], e[3]); o.z = pk2(e[4], e[5]); o.w = pk2(e[6], e[7]); KTo[pi] = o;
        }
        for (int pi = tid; pi < 2048; pi += 512) {
            const int e2 = pi >> 10, q = pi & 1023, sl = q >> 8, s = (q >> 6) & 3, ln = q & 63, dv = 32 * sl + (ln & 31), h = ln >> 5, tb = 16 * s + 4 * h;
            unsigned e[8];
#pragma unroll
            for (int j = 0; j < 8; ++j) { const int t = tb + (j & 3) + 8 * (j >> 2); e[j] = XV[t * 264 + e2 * 128 + dv]; }
            v4u o; o.x = e[0] | (e[1] << 16); o.y = e[2] | (e[3] << 16); o.z = e[4] | (e[5] << 16); o.w = e[6] | (e[7] << 16); VTo[pi] = o;
        }
        __syncthreads();
    }
}

__device__ __forceinline__ void phase_dn_naive(const Params& p, LAS unsigned char* lds, int tid, int vcu, int G) {
    unsigned char* ws = p.ws;
    const int sb = tid >> 7, j = tid & 127;
    LAS unsigned char* my = lds + sb * 33792;
    LAS bf16* Kc = (LAS bf16*)my; LAS bf16* Qc = (LAS bf16*)(my + 16384); LAS float* Gs = (LAS float*)(my + 32768); LAS float* Bs = Gs + 64;
    const float* AB = (const float*)(ws + WS_AB); bf16* OFOB = (bf16*)(ws + WS_QKV);
    for (int g = vcu; g < 288; g += G) {
        const int task = 4 * g + sb, seq = task >> 6, h = (task >> 1) & 31, d = task & 1, kh = h >> 1;
        const int nch = seq < 16 ? 4 : 16, cbase = seq < 16 ? 4 * seq : 64 + 16 * (seq - 16);
        float S[128];
        if (seq < 16) {
#pragma unroll
            for (int k = 0; k < 128; ++k) S[k] = 0.f;
        } else { const float* st = p.in[d ? 3 : 2] + (size_t)((seq - 16) * 32 + h) * 16384 + j;
#pragma unroll
            for (int k = 0; k < 128; ++k) S[k] = st[k * 128]; }
        const float Aexp = expf(p.in[12][d * 32 + h]), dtb = p.in[13][d * 32 + h];
        for (int n = 0; n < nch; ++n) {
            const int c = cbase + (d ? nch - 1 - n : n);
            __syncthreads();
            const v4u* KAi = (const v4u*)(ws + WS_KA) + (size_t)(c * 16 + kh) * 1024; const v4u* QAi = (const v4u*)(ws + WS_QA) + (size_t)(c * 16 + kh) * 1024;
            for (int pi = j; pi < 1024; pi += 128) { const int rb = pi >> 9, s = (pi >> 6) & 7, ln = pi & 63, t = 32 * rb + (ln & 31), hh = ln >> 5;
                const v4u a = KAi[pi], b = QAi[pi]; const int o = t * 128 + 16 * s + 4 * hh;
                *(LAS v2u*)(Kc + o) = (v2u){a.x, a.y}; *(LAS v2u*)(Kc + o + 8) = (v2u){a.z, a.w}; *(LAS v2u*)(Qc + o) = (v2u){b.x, b.y}; *(LAS v2u*)(Qc + o + 8) = (v2u){b.z, b.w}; }
            if (j < 64) { const int row = 64 * c + j; const float a = AB[(size_t)row * 128 + d * 64 + h], b = AB[(size_t)row * 128 + d * 64 + 32 + h];
                const float x = a + dtb, sp = x > 20.f ? x : log1pf(expf(x)); Gs[j] = expf(-Aexp * sp); Bs[j] = 1.0f / (1.0f + expf(-b)); }
            __syncthreads();
            const bf16* VTi = (const bf16*)(ws + WS_VT) + (size_t)(c * 32 + h) * 8192;
#pragma nounroll
            for (int tt = 0; tt < 64; ++tt) {
                const int t = d ? 63 - tt : tt;
                const int q = t & 15, piece = (j >> 5) * 256 + (t >> 4) * 64 + ((q >> 2) & 1) * 32 + (j & 31), jj = 4 * (q >> 3) + (q & 3);
                const float v = bf2f(VTi[piece * 8 + jj]);
                const float gg = Gs[t], bb = Bs[t];
                float kS = 0.f;
#pragma unroll
                for (int k8 = 0; k8 < 16; ++k8) { const v4u kk = *(const LAS v4u*)(Kc + t * 128 + 8 * k8);
                    kS += bflo(kk.x) * S[8 * k8 + 0]; kS += bfhi(kk.x) * S[8 * k8 + 1]; kS += bflo(kk.y) * S[8 * k8 + 2]; kS += bfhi(kk.y) * S[8 * k8 + 3];
                    kS += bflo(kk.z) * S[8 * k8 + 4]; kS += bfhi(kk.z) * S[8 * k8 + 5]; kS += bflo(kk.w) * S[8 * k8 + 6]; kS += bfhi(kk.w) * S[8 * k8 + 7];
                    if ((k8 & 3) == 3) asm volatile("" ::: "memory"); }
                const float coef = bb * (v - gg * kS);
                float o = 0.f;
#pragma unroll
                for (int k8 = 0; k8 < 16; ++k8) { const v4u kk = *(const LAS v4u*)(Kc + t * 128 + 8 * k8), qq = *(const LAS v4u*)(Qc + t * 128 + 8 * k8);
                    const float kf[8] = {bflo(kk.x), bfhi(kk.x), bflo(kk.y), bfhi(kk.y), bflo(kk.z), bfhi(kk.z), bflo(kk.w), bfhi(kk.w)};
                    const float qf[8] = {bflo(qq.x), bfhi(qq.x), bflo(qq.y), bfhi(qq.y), bflo(qq.z), bfhi(qq.z), bflo(qq.w), bfhi(qq.w)};
#pragma unroll
                    for (int e = 0; e < 8; ++e) { S[8 * k8 + e] = kf[e] * coef + gg * S[8 * k8 + e]; o += qf[e] * S[8 * k8 + e]; }
                    if ((k8 & 1) == 1) asm volatile("" ::: "memory"); }
                OFOB[(size_t)d * MROWS * 4096 + (size_t)(64 * c + t) * 4096 + h * 128 + j] = (bf16)f2bf(o);
            }
        }
        if (seq < 16) { float* so = p.out + (d ? OUT_SB : OUT_SF) + (size_t)(seq * 32 + h) * 16384 + j;
#pragma unroll
            for (int k = 0; k < 128; ++k) so[k * 128] = S[k]; }
    }
}

__device__ __forceinline__ void phase_combine(const Params& p, int lane, int wave, int vcu, int G) {
    unsigned char* ws = p.ws;
    const bf16* OF = (const bf16*)(ws + WS_QKV); const bf16* OB = OF + (size_t)MROWS * 4096; const bf16* Z = (const bf16*)(ws + WS_Z); bf16* OG = (bf16*)(ws + WS_KA);
    const int gw = vcu * NWAVES + wave, NGW = G * NWAVES, half = lane >> 5, l32 = lane & 31;
    const f32x4 nw = *(const f32x4*)(p.in[14] + 4 * l32);
    for (int it = gw; it < MROWS * 16; it += NGW) {
        const int row = it >> 4, hv = (it & 15) * 2 + half; const size_t off = (size_t)row * 4096 + hv * 128 + 4 * l32;
        const v2u a = *(const v2u*)(OF + off), b = *(const v2u*)(OB + off), z = *(const v2u*)(Z + off);
        f32x4 o = {bflo(a.x) + bflo(b.x), bfhi(a.x) + bfhi(b.x), bflo(a.y) + bflo(b.y), bfhi(a.y) + bfhi(b.y)};
        float ss = (o[0] * o[0] + o[1] * o[1]) + (o[2] * o[2] + o[3] * o[3]);
#pragma unroll
        for (int m = 1; m < 32; m <<= 1) ss += __shfl_xor(ss, m);
        const float r = 1.0f / sqrtf(ss * (1.0f / 128.0f) + 1e-6f);
        const f32x4 zz = {silu_f(bflo(z.x)), silu_f(bfhi(z.x)), silu_f(bflo(z.y)), silu_f(bfhi(z.y))};
        const f32x4 y = o * r * nw * zz; v2u w; w.x = pk2(y[0], y[1]); w.y = pk2(y[2], y[3]); *(v2u*)(OG + off) = w;
    }
}

__device__ __forceinline__ void phase_spatial(const Params& p, LAS unsigned char* lds, int tid, int lane, int wave, int vcu, int G) {
    unsigned char* ws = p.ws;
    LAS bf16* VL = (LAS bf16*)lds;
    LAS float* RS = (LAS float*)(lds + 67584);
    const bf16* H = (const bf16*)(ws + WS_QKV); bf16* UV = (bf16*)(ws + WS_Z); const float* STATS = (const float*)(ws + WS_STATS);
    for (int u = vcu; u < 768; u += G) {
        const int tc = u >> 4, g = u & 15;
        __syncthreads();
        { const int q = tid >> 2, part = tid & 3; const f32x2* st = (const f32x2*)(STATS + (size_t)(128 * tc + q) * 128) + part * 16; float s1 = 0.f, s2 = 0.f;
#pragma unroll
            for (int i = 0; i < 16; ++i) { const f32x2 x = st[i]; s1 += x[0]; s2 += x[1]; }
            s1 += __shfl_xor(s1, 1); s1 += __shfl_xor(s1, 2); s2 += __shfl_xor(s2, 1); s2 += __shfl_xor(s2, 2);
            const float mu = s1 * (1.0f / 4096.0f), var = s2 * (1.0f / 4096.0f) - mu * mu;
            if (part == 0) { RS[2 * q] = mu; RS[2 * q + 1] = 1.0f / sqrtf(fmaxf(var, 0.f) + 1e-6f); } }
        __syncthreads();
        for (int pi = tid; pi < 4096; pi += 512) { const int q = pi >> 5, c8 = pi & 31;
            const v4u raw = *(const v4u*)(H + (size_t)(128 * tc + q) * 8192 + 4096 + 256 * g + 8 * c8);
            const float mu = RS[2 * q], rs = RS[2 * q + 1];
            const float* lw = p.in[18] + 256 * g + 8 * c8; const float* lb = p.in[19] + 256 * g + 8 * c8;
            const f32x4 w0 = *(const f32x4*)lw, w1 = *(const f32x4*)(lw + 4), b0 = *(const f32x4*)lb, b1 = *(const f32x4*)(lb + 4);
            const f32x4 x0 = {bflo(raw.x), bfhi(raw.x), bflo(raw.y), bfhi(raw.y)}, x1 = {bflo(raw.z), bfhi(raw.z), bflo(raw.w), bfhi(raw.w)};
            const f32x4 y0 = (x0 - mu) * rs * w0 + b0, y1 = (x1 - mu) * rs * w1 + b1;
            v4u o; o.x = pk2(y0[0], y0[1]); o.y = pk2(y0[2], y0[3]); o.z = pk2(y1[0], y1[1]); o.w = pk2(y1[2], y1[3]);
            *(LAS v4u*)(VL + q * 264 + 8 * c8) = o; }
        __syncthreads();
        const int col = 32 * wave + (lane & 31), hh = lane >> 5;
        bf16x8 bfr[8];
#pragma unroll
        for (int s = 0; s < 8; ++s) {
#pragma unroll
            for (int e = 0; e < 8; ++e) bfr[s][e] = (short)VL[(16 * s + 8 * hh + e) * 264 + col]; }
        f32x16 acc[4];
#pragma unroll
        for (int rb = 0; rb < 4; ++rb)
#pragma unroll
            for (int e = 0; e < 16; ++e) acc[rb][e] = 0.f;
        const bf16* Wb = (const bf16*)(ws + WS_WSB) + (size_t)g * 16384;
#pragma unroll
        for (int rb = 0; rb < 4; ++rb)
#pragma unroll
            for (int s = 0; s < 8; ++s) { const bf16x8 a = *(const bf16x8*)(Wb + (32 * rb + (lane & 31)) * 128 + 16 * s + 8 * hh); acc[rb] = __builtin_amdgcn_mfma_f32_32x32x16_bf16(a, bfr[s], acc[rb], 0, 0, 0); }
        const float* bs = p.in[21] + g * 128;
#pragma unroll
        for (int rb = 0; rb < 4; ++rb)
#pragma unroll
            for (int e = 0; e < 16; ++e) { const int pr = 32 * rb + (e & 3) + 8 * (e >> 2) + 4 * hh; const size_t row = (size_t)(128 * tc + pr);
                const float val = acc[rb][e] + bs[pr]; const float uu = bf2f(H[row * 8192 + 256 * g + col]); UV[row * 4096 + 256 * g + col] = (bf16)f2bf(uu * val); }
    }
}

constexpr int NPHASE = 19;
__global__ void __launch_bounds__(NWAVES * 64, 2) mega_fwd(Params p) {
    extern __shared__ __attribute__((aligned(16))) unsigned char lds_raw[];
    LAS unsigned char* lds = (LAS unsigned char*)lds_raw;
    const int tid = threadIdx.x, lane = tid & 63, wave = __builtin_amdgcn_readfirstlane(tid >> 6);
    const int G = gridDim.x, bx = blockIdx.x, vcu = (G % 8 == 0) ? (bx % 8) * (G / 8) + bx / 8 : bx;
    unsigned char* ws = p.ws;
    const int lo = p.ph_lo, hi = p.ph_hi;
#ifndef PH_MASK
#define PH_MASK 0xFFFFFFFFu
#endif
#define IN(k) (((PH_MASK >> (k)) & 1u) && lo <= (k) && (k) < hi)
#define SEAM(k) do { if (IN(k) && IN((k) + 1)) { cg::this_grid().sync(); } } while (0)
    const float* MOD = (const float*)(ws + WS_MOD);
    bf16* XN = (bf16*)(ws + WS_XN); float* X = (float*)(ws + WS_X); bf16* Hb = (bf16*)(ws + WS_QKV);

    if (IN(0)) { phase_prologue(p, lds, tid, lane, wave, vcu, G); } SEAM(0);
    if (IN(1)) { phase_norm<0>(p, 0, 0, lane, wave, vcu, G); } SEAM(1);
    if (IN(2)) { pg8::Gemm g{XN, (const bf16*)(ws + WS_WIN), MROWS, NPROJ_PAD, 2048}; pg8::StaticOrder S; S.init(MROWS, NPROJ_PAD, G, bx);
        pg8::EpiProj E{(bf16*)(ws + WS_QKV), (bf16*)(ws + WS_Z), (float*)(ws + WS_AB)};
        pg8::gemm_phase<pg8::EpiProj, pg8::StaticOrder, true, true>(lds, g, S, E); } SEAM(2);
    if (IN(3)) { phase_conv(p, lds, tid, lane, wave, vcu, G); } SEAM(3);
    if (IN(4)) { phase_dn_naive(p, lds, tid, vcu, G); } SEAM(4);
    SEAM(5);
    if (IN(6)) { phase_combine(p, lane, wave, vcu, G); } SEAM(6);
    if (IN(7)) { pg8::Gemm g{(const bf16*)(ws + WS_KA), (const bf16*)(ws + WS_WOUT), MROWS, 2048, 4096}; pg8::StaticOrder S; S.init(MROWS, 2048, G, bx);
        pg8::EpiRes E{X, MOD + 4096};
        pg8::gemm_phase<pg8::EpiRes, pg8::StaticOrder, true, true>(lds, g, S, E); } SEAM(7);
    if (IN(8)) { phase_norm<1>(p, 0, 1, lane, wave, vcu, G); } SEAM(8);
    if (IN(9)) { pg8::Gemm g{XN, (const bf16*)(ws + WS_WFF1), MROWS, 8192, 2048}; pg8::StaticOrder S; S.init(MROWS, 8192, G, bx);
        pg8::EpiAct<0> E{Hb, nullptr, nullptr};
        pg8::gemm_phase<pg8::EpiAct<0>, pg8::StaticOrder, true, true>(lds, g, S, E); } SEAM(9);
    if (IN(10)) { pg8::Gemm g{Hb, (const bf16*)(ws + WS_WFF2), MROWS, 2048, 8192}; pg8::StaticOrder S; S.init(MROWS, 2048, G, bx);
        pg8::EpiRes E{X, MOD + 10240};
        pg8::gemm_phase<pg8::EpiRes, pg8::StaticOrder, true, true>(lds, g, S, E); } SEAM(10);
    if (IN(11)) { phase_norm<1>(p, 1, 0, lane, wave, vcu, G); } SEAM(11);
    if (IN(12)) { pg8::Gemm g{XN, (const bf16*)(ws + WS_WCMIN), MROWS, 8192, 2048}; pg8::StaticOrder S; S.init(MROWS, 8192, G, bx);
        pg8::EpiAct<1> E{Hb, p.in[17], (float*)(ws + WS_STATS)};
        pg8::gemm_phase<pg8::EpiAct<1>, pg8::StaticOrder, true, true>(lds, g, S, E); } SEAM(12);
    if (IN(13)) { phase_spatial(p, lds, tid, lane, wave, vcu, G); } SEAM(13);
    if (IN(14)) { pg8::Gemm g{(const bf16*)(ws + WS_Z), (const bf16*)(ws + WS_WCMOUT), MROWS, 2048, 4096}; pg8::StaticOrder S; S.init(MROWS, 2048, G, bx);
        pg8::EpiRes E{X, MOD + 3 * 12288 + 4096};
        pg8::gemm_phase<pg8::EpiRes, pg8::StaticOrder, true, true>(lds, g, S, E); } SEAM(14);
    if (IN(15)) { phase_norm<1>(p, 1, 1, lane, wave, vcu, G); } SEAM(15);
    if (IN(16)) { pg8::Gemm g{XN, (const bf16*)(ws + WS_WFF1) + (size_t)2048 * 8192, MROWS, 8192, 2048}; pg8::StaticOrder S; S.init(MROWS, 8192, G, bx);
        pg8::EpiAct<0> E{Hb, nullptr, nullptr};
        pg8::gemm_phase<pg8::EpiAct<0>, pg8::StaticOrder, true, true>(lds, g, S, E); } SEAM(16);
    if (IN(17)) { pg8::Gemm g{Hb, (const bf16*)(ws + WS_WFF2) + (size_t)2048 * 8192, MROWS, 2048, 8192}; pg8::StaticOrder S; S.init(MROWS, 2048, G, bx);
        pg8::EpiRes E{X, MOD + 3 * 12288 + 10240};
        pg8::gemm_phase<pg8::EpiRes, pg8::StaticOrder, true, true>(lds, g, S, E); } SEAM(17);
    if (IN(18)) { phase_norm<2>(p, 0, 0, lane, wave, vcu, G); }
#undef IN
#undef SEAM
}

extern "C" void kernel_launch(void* const* d_in, const int* in_sizes, int n_in, void* d_out, int out_size, void* d_ws, size_t ws_size, hipStream_t stream) {
    static int grid = 0;
    if (grid == 0) {
        if (n_in != 26 || ws_size < WS_END) { fprintf(stderr, "kernel_launch: expected 26 inputs and >= %zu bytes of workspace; got %d, %zu\n", (size_t)WS_END, n_in, ws_size); grid = -1; return; }
        int dev = 0, cus = 0, per_cu = 0;
        if (hipGetDevice(&dev) != hipSuccess || hipDeviceGetAttribute(&cus, hipDeviceAttributeMultiprocessorCount, dev) != hipSuccess) { grid = -1; return; }
        if (hipFuncSetAttribute((const void*)mega_fwd, hipFuncAttributeMaxDynamicSharedMemorySize, LDS_BYTES) != hipSuccess) { fprintf(stderr, "kernel_launch: hipFuncSetAttribute failed\n"); grid = -1; return; }
        if (hipOccupancyMaxActiveBlocksPerMultiprocessor(&per_cu, (const void*)mega_fwd, NWAVES * 64, LDS_BYTES) != hipSuccess || per_cu < 1) { fprintf(stderr, "kernel_launch: occupancy query reports %d blocks per CU\n", per_cu); (void)hipGetLastError(); per_cu = 1; }
        grid = cus;
    }
    if (grid < 0) return;
    Params a{};
    for (int i = 0; i < 26; ++i) a.in[i] = (const float*)d_in[i];
    a.out = (float*)d_out; a.ws = (unsigned char*)d_ws;
#if MK_PER_PHASE
    for (int ph = 0; ph < NPHASE; ++ph) { if (ph == 5) continue; a.ph_lo = ph; a.ph_hi = ph + 1; hipLaunchKernelGGL(mega_fwd, dim3(grid), dim3(NWAVES * 64), LDS_BYTES, stream, a); }
#else
    a.ph_lo = 0; a.ph_hi = NPHASE;
    void* args[] = {&a};
    hipError_t e = hipLaunchCooperativeKernel((const void*)mega_fwd, dim3(grid), dim3(NWAVES * 64), args, LDS_BYTES, stream);
    if (e != hipSuccess) fprintf(stderr, "kernel_launch: cooperative launch failed: %s (grid %d)\n", hipGetErrorString(e), grid);
#endif
}
```

```cpp
#include <hip/hip_runtime.h>
#include <hip/hip_cooperative_groups.h>
#include <cstdio>
#include <cstdint>
namespace cg = cooperative_groups;
#ifndef MK_PER_PHASE
#define MK_PER_PHASE 0
#endif
namespace pg8 {
#define PG8_LAS __attribute__((address_space(3)))
typedef unsigned short bf16_t;
typedef short bf16x8 __attribute__((ext_vector_type(8)));
typedef float f32x4 __attribute__((ext_vector_type(4)));
typedef unsigned u32x4 __attribute__((ext_vector_type(4)));
constexpr int BM = 256, BK = 64, HALF = 128, HTB = HALF * BK * 2  , STAGE_BYTES = 8 * HTB, NXCD = 8, WGM = 8;

__host__ __device__ __forceinline__ int lds_byte(int r, int c) { const int st = (r >> 4) * 2 + (c >> 5), rr = r & 15, cc = c & 31, ob = rr * 64 + cc * 2; return st * 1024 + (ob ^ (((ob >> 9) & 1) << 5)); }
__host__ __device__ __forceinline__ void stage_rc(int b, int& R, int& C) { const int st = b / 1024, sb = b % 1024, swz = sb ^ (((sb >> 9) & 1) << 5); R = (st >> 1) * 16 + swz / 64; C = (st & 1) * 32 + (swz % 64) / 2; }
__host__ __device__ __forceinline__ int perm32(int rho) { const int n = rho >> 4, i = rho & 15; return 8 * (i >> 2) + 4 * n + (i & 3); }

struct Unit { int pm, pn; };
struct Gemm { const bf16_t* A; const bf16_t* Bt; int M, N, K; };

struct StaticOrder {
    int nM, nN, nwg, G, c;
    __host__ __device__ void init(int M, int N, int G_, int c_) { nM = M / BM; nN = N / BM; nwg = nM * nN; G = G_; c = c_; }
    __host__ __device__ bool next(int i, Unit& u) const {
        const long L = (long)i * G + c; if (L >= nwg) return false;
        int wgid = (int)L; { const int q = nwg / NXCD, r = nwg % NXCD, xcd = wgid % NXCD, off = wgid / NXCD; wgid = (xcd < r ? xcd * (q + 1) : r * (q + 1) + (xcd - r) * q) + off; }
        const int nig = WGM * nN, gid = wgid / nig, fm = gid * WGM, gsz = (nM - fm) < WGM ? (nM - fm) : WGM;
        u.pm = fm + ((wgid % nig) % gsz); u.pn = (wgid % nig) / gsz; return true;
    }
    __device__ __forceinline__ void a_ready(const Unit&) const {}
    __device__ __forceinline__ void done(const Unit&) const {}
};

__device__ __forceinline__ unsigned cvt_pk_bf16(float lo, float hi) { unsigned r; asm volatile("v_cvt_pk_bf16_f32 %0, %1, %2" : "=v"(r) : "v"(lo), "v"(hi)); return r; }
__device__ __forceinline__ u32x4 pack8(const f32x4 v0, const f32x4 v1) { u32x4 w; w.x = cvt_pk_bf16(v0[0], v0[1]); w.y = cvt_pk_bf16(v0[2], v0[3]); w.z = cvt_pk_bf16(v1[0], v1[1]); w.w = cvt_pk_bf16(v1[2], v1[3]); return w; }
__device__ __forceinline__ float gelu_tanh(float x) {
    const float u = 0.7978845608028654f * (x + 0.044715f * x * x * x);
    const float e = __builtin_amdgcn_exp2f(-2.0f * 1.4426950408889634f * u);
    return x * __builtin_amdgcn_rcpf(1.0f + e);
}
struct EpiProj {
    static constexpr bool PERM = true, AFTER_DRAIN = false;
    bf16_t* QKV; bf16_t* Z; float* AB;
    __device__ __forceinline__ void operator()(const f32x4 (&acc)[2][2][4][2], const Unit& u, int wr, int wc, int fr, int fq) const {
        const int row0 = u.pm * BM + wr * 64 + fr, cin = wc * 32 + 8 * fq;
        if (u.pn < 48) {
            bf16_t* base; int ldc, colt;
            if (u.pn < 32) { base = QKV; ldc = 8192; colt = u.pn * BM; } else { base = Z; ldc = 4096; colt = (u.pn - 32) * BM; }
#pragma unroll
            for (int ai = 0; ai < 2; ++ai)
#pragma unroll
                for (int m = 0; m < 4; ++m) { bf16_t* rowp = base + (size_t)(row0 + ai * HALF + m * 16) * ldc + colt + cin;
#pragma unroll
                    for (int bj = 0; bj < 2; ++bj) *(u32x4*)(rowp + bj * HALF) = pack8(acc[ai][bj][m][0], acc[ai][bj][m][1]); }
        } else {
#pragma unroll
            for (int ai = 0; ai < 2; ++ai)
#pragma unroll
                for (int m = 0; m < 4; ++m) { float* rowp = AB + (size_t)(row0 + ai * HALF + m * 16) * 128 + cin;
                    *(f32x4*)(rowp) = acc[ai][0][m][0]; *(f32x4*)(rowp + 4) = acc[ai][0][m][1]; }
        }
    }
};
struct EpiRes {
    static constexpr bool PERM = false, AFTER_DRAIN = false;
    float* X; const float* gate;
    __device__ __forceinline__ void operator()(const f32x4 (&acc)[2][2][4][2], const Unit& u, int wr, int wc, int fr, int fq) const {
        const int cond = u.pm < 16 ? 0 : (u.pm < 20 ? 1 : 2);
        const int row0 = u.pm * BM + wr * 64 + fr, col0 = u.pn * BM + wc * 32 + 4 * fq;
        const float* gp = gate + cond * 12288 + col0;
        f32x4 gv[2][2];
#pragma unroll
        for (int bj = 0; bj < 2; ++bj)
#pragma unroll
            for (int n = 0; n < 2; ++n) gv[bj][n] = *(const f32x4*)(gp + bj * HALF + n * 16);
#pragma unroll
        for (int ai = 0; ai < 2; ++ai)
#pragma unroll
            for (int m = 0; m < 4; ++m) { float* xp = X + (size_t)(row0 + ai * HALF + m * 16) * 2048 + col0;
#pragma unroll
                for (int bj = 0; bj < 2; ++bj)
#pragma unroll
                    for (int n = 0; n < 2; ++n) { f32x4 x = *(const f32x4*)(xp + bj * HALF + n * 16); x = x + gv[bj][n] * acc[ai][bj][m][n]; *(f32x4*)(xp + bj * HALF + n * 16) = x; } }
    }
};
template <int ACT> struct EpiAct {
    static constexpr bool PERM = true, AFTER_DRAIN = false;
    bf16_t* H; const float* bias; float* stats;
    __device__ __forceinline__ void operator()(const f32x4 (&acc)[2][2][4][2], const Unit& u, int wr, int wc, int fr, int fq) const {
        const int row0 = u.pm * BM + wr * 64 + fr, col0 = u.pn * BM + wc * 32 + 8 * fq;
        f32x4 bv[2][2];
#pragma unroll
        for (int bj = 0; bj < 2; ++bj)
#pragma unroll
            for (int n = 0; n < 2; ++n) bv[bj][n] = (ACT == 1) ? *(const f32x4*)(bias + col0 + bj * HALF + 4 * n) : (f32x4){0.f, 0.f, 0.f, 0.f};
#pragma unroll
        for (int ai = 0; ai < 2; ++ai)
#pragma unroll
            for (int m = 0; m < 4; ++m) { const int row = row0 + ai * HALF + m * 16; bf16_t* rowp = H + (size_t)row * 8192 + col0; float s1 = 0.f, s2 = 0.f;
#pragma unroll
                for (int bj = 0; bj < 2; ++bj) { f32x4 v0 = acc[ai][bj][m][0] + bv[bj][0], v1 = acc[ai][bj][m][1] + bv[bj][1];
#pragma unroll
                    for (int e = 0; e < 4; ++e) {
                        if (ACT == 0) { const float a = fmaxf(v0[e], 0.f), b = fmaxf(v1[e], 0.f); v0[e] = a * a; v1[e] = b * b; }
                        else { v0[e] = gelu_tanh(v0[e]); v1[e] = gelu_tanh(v1[e]); s1 += v0[e] + v1[e]; s2 += v0[e] * v0[e] + v1[e] * v1[e]; } }
                    *(u32x4*)(rowp + bj * HALF) = pack8(v0, v1); }
                if (ACT == 1) { if (u.pn >= 16) { s1 += __shfl_xor(s1, 16); s1 += __shfl_xor(s1, 32); s2 += __shfl_xor(s2, 16); s2 += __shfl_xor(s2, 32);
                    if (fq == 0) { typedef float f32x2 __attribute__((ext_vector_type(2))); *(f32x2*)(stats + (size_t)row * 128 + ((u.pn - 16) * 4 + wc) * 2) = (f32x2){s1, s2}; } } }
            }
    }
};

template <class Epi, class Sched, bool ALIGN_EPI = false, bool SP2 = false>
__device__ __forceinline__ void gemm_phase(PG8_LAS unsigned char* lds, const Gemm g, const Sched& S, const Epi& E) {
    const int tid = threadIdx.x, wid = __builtin_amdgcn_readfirstlane(tid >> 6), lane = tid & 63, wr = wid >> 2, wc = wid & 3, fr = lane & 15, fq = lane >> 4;
    const int K = g.K, nt = K / BK;
    unsigned voffA[2], voffB[2];
#pragma unroll
    for (int i = 0; i < 2; ++i) { int R, C; stage_rc(tid * 16 + i * 8192, R, C); const int Rb = Epi::PERM ? ((R & ~31) + perm32(R & 31)) : R;
        voffA[i] = (unsigned)(R * K + C) * 2u; voffB[i] = (unsigned)(Rb * K + C) * 2u; }
    const size_t kstep = (size_t)(BK * 2);
    const size_t hstep = (size_t)HALF * K * 2;
    const size_t tstep = 2 * hstep;
    const unsigned ldsw = (unsigned)wid * 1024u;
    const int aoff = lds_byte(wr * 64 + fr, fq * 8), boff = lds_byte(wc * 32 + fr, fq * 8);
#define PG8_SA(b, h) (((b) * 2 + (h)) * HTB)
#define PG8_SB(b, h) ((4 + (b) * 2 + (h)) * HTB)
#define PG8_STAGE(bufoff, gbase, voff) do { _Pragma("unroll") for (int _i = 0; _i < 2; ++_i) \
        __builtin_amdgcn_global_load_lds((const unsigned*)((const char*)(gbase) + (voff)[_i]), (PG8_LAS unsigned*)(lds + (bufoff) + ldsw + _i * 8192), 16, 0, 0); } while (0)
#define PG8_LDA(dst, b, h) do { _Pragma("unroll") for (int m = 0; m < 4; ++m) _Pragma("unroll") for (int k = 0; k < 2; ++k) dst[m][k] = *(const PG8_LAS bf16x8*)(lds + PG8_SA(b, h) + aoff + m * 2048 + k * 1024); } while (0)
#define PG8_LDB(dst, b, h) do { _Pragma("unroll") for (int n = 0; n < 2; ++n) _Pragma("unroll") for (int k = 0; k < 2; ++k) dst[n][k] = *(const PG8_LAS bf16x8*)(lds + PG8_SB(b, h) + boff + n * 2048 + k * 1024); } while (0)
#define PG8_MMA(ai, bj, At, Bt) do { __builtin_amdgcn_s_setprio(1); _Pragma("unroll") for (int m = 0; m < 4; ++m) _Pragma("unroll") for (int n = 0; n < 2; ++n) _Pragma("unroll") for (int k = 0; k < 2; ++k) \
        acc[ai][bj][m][n] = __builtin_amdgcn_mfma_f32_16x16x32_bf16(Bt[n][k], At[m][k], acc[ai][bj][m][n], 0, 0, 0); __builtin_amdgcn_s_setprio(0); } while (0)
#define PG8_WAIT_V(n) asm volatile("s_waitcnt vmcnt(" #n ")" ::: "memory")
#define PG8_WAIT_L(n) asm volatile("s_waitcnt lgkmcnt(" #n ")" ::: "memory")
#define PG8_BAR __builtin_amdgcn_s_barrier()
#define PG8_SCHED __builtin_amdgcn_sched_barrier(0)
    Unit cur, nxt; int ui = 0;
    if (!S.next(0, cur)) return;
    f32x4 acc[2][2][4][2];
#pragma unroll
    for (int a = 0; a < 2; ++a)
#pragma unroll
        for (int b = 0; b < 2; ++b)
#pragma unroll
            for (int m = 0; m < 4; ++m)
#pragma unroll
                for (int n = 0; n < 2; ++n) acc[a][b][m][n] = (f32x4){0.f, 0.f, 0.f, 0.f};
    bf16x8 At[4][2], B0[2][2], B1[2][2];
    const char* cA = (const char*)g.A + (size_t)cur.pm * tstep; const char* cB = (const char*)g.Bt + (size_t)cur.pn * tstep;
    S.a_ready(cur);
    if constexpr (SP2) {
        PG8_STAGE(PG8_SB(0, 0), cB, voffB); PG8_STAGE(PG8_SB(0, 1), cB + hstep, voffB); PG8_STAGE(PG8_SA(0, 0), cA, voffA); PG8_STAGE(PG8_SA(0, 1), cA + hstep, voffA);
        if (wr == 1) PG8_BAR;
        PG8_WAIT_V(2); PG8_BAR;
        PG8_STAGE(PG8_SB(1, 0), cB + kstep, voffB); PG8_STAGE(PG8_SA(1, 0), cA + kstep, voffA); PG8_STAGE(PG8_SB(1, 1), cB + hstep + kstep, voffB);
        PG8_WAIT_V(6); PG8_BAR;
    } else {
        PG8_STAGE(PG8_SB(0, 0), cB, voffB); PG8_STAGE(PG8_SA(0, 0), cA, voffA); PG8_STAGE(PG8_SB(0, 1), cB + hstep, voffB); PG8_STAGE(PG8_SA(0, 1), cA + hstep, voffA);
        if (wr == 1) PG8_BAR;
        PG8_WAIT_V(4); PG8_BAR;
        PG8_STAGE(PG8_SB(1, 0), cB + kstep, voffB); PG8_STAGE(PG8_SA(1, 0), cA + kstep, voffA); PG8_STAGE(PG8_SB(1, 1), cB + hstep + kstep, voffB);
        PG8_WAIT_V(6); PG8_BAR;
    }
    for (;;) {
        const bool has_next = S.next(ui + 1, nxt);
        const char* nA = has_next ? (const char*)g.A + (size_t)nxt.pm * tstep : cA; const char* nB = has_next ? (const char*)g.Bt + (size_t)nxt.pn * tstep : cB;
        for (int t = 0; t < nt; t += 2) {
            const bool last = (t == nt - 2);
            const char* a1 = cA + (size_t)(t + 1) * kstep;
            const char* a2 = last ? nA : cA + (size_t)(t + 2) * kstep; const char* b2 = last ? nB : cB + (size_t)(t + 2) * kstep;
            const char* a3 = a2 + kstep; const char* b3 = b2 + kstep;
            if (last && has_next) S.a_ready(nxt);
            if constexpr (SP2) {
            PG8_LDB(B0, 0, 0); PG8_LDB(B1, 0, 1); PG8_SCHED; PG8_LDA(At, 0, 0); PG8_STAGE(PG8_SA(1, 1), a1 + hstep, voffA);
            PG8_WAIT_V(8); PG8_WAIT_L(0); PG8_BAR; PG8_MMA(0, 0, At, B0); PG8_MMA(0, 1, At, B1); PG8_BAR; PG8_SCHED;
            PG8_LDA(At, 0, 1); PG8_STAGE(PG8_SB(0, 0), b2, voffB); PG8_STAGE(PG8_SB(0, 1), b2 + hstep, voffB); PG8_STAGE(PG8_SA(0, 0), a2, voffA);
            PG8_WAIT_V(8); PG8_WAIT_L(0); PG8_BAR; PG8_MMA(1, 0, At, B0); PG8_MMA(1, 1, At, B1); PG8_BAR; PG8_SCHED;
            PG8_LDB(B0, 1, 0); PG8_LDB(B1, 1, 1); PG8_SCHED; PG8_LDA(At, 1, 0); PG8_STAGE(PG8_SA(0, 1), a2 + hstep, voffA);
            PG8_WAIT_V(8); PG8_WAIT_L(0); PG8_BAR; PG8_MMA(0, 0, At, B0); PG8_MMA(0, 1, At, B1); PG8_BAR; PG8_SCHED;
            PG8_LDA(At, 1, 1); PG8_STAGE(PG8_SB(1, 0), b3, voffB); PG8_STAGE(PG8_SB(1, 1), b3 + hstep, voffB); PG8_STAGE(PG8_SA(1, 0), a3, voffA);
            PG8_WAIT_V(8); PG8_WAIT_L(0); PG8_BAR; PG8_MMA(1, 0, At, B0); PG8_MMA(1, 1, At, B1); PG8_BAR; PG8_SCHED;
            } else {
            PG8_LDB(B0, 0, 0); PG8_SCHED; PG8_LDA(At, 0, 0); PG8_STAGE(PG8_SA(1, 1), a1 + hstep, voffA);
            PG8_WAIT_L(8); PG8_BAR; PG8_WAIT_L(0); PG8_MMA(0, 0, At, B0); PG8_BAR; PG8_SCHED;
            PG8_LDB(B1, 0, 1); PG8_STAGE(PG8_SB(0, 0), b2, voffB);
            PG8_BAR; PG8_WAIT_L(0); PG8_MMA(0, 1, At, B1); PG8_BAR;
            PG8_LDA(At, 0, 1); PG8_STAGE(PG8_SA(0, 0), a2, voffA);
            PG8_BAR; PG8_WAIT_L(0); PG8_MMA(1, 0, At, B0); PG8_BAR; PG8_SCHED;
            PG8_STAGE(PG8_SB(0, 1), b2 + hstep, voffB);
            PG8_WAIT_V(6); PG8_BAR; PG8_MMA(1, 1, At, B1); PG8_BAR;
            PG8_LDB(B0, 1, 0); PG8_SCHED; PG8_LDA(At, 1, 0); PG8_STAGE(PG8_SA(0, 1), a2 + hstep, voffA);
            PG8_WAIT_L(8); PG8_BAR; PG8_WAIT_L(0); PG8_MMA(0, 0, At, B0); PG8_BAR; PG8_SCHED;
            PG8_LDB(B1, 1, 1); PG8_STAGE(PG8_SB(1, 0), b3, voffB);
            PG8_BAR; PG8_WAIT_L(0); PG8_MMA(0, 1, At, B1); PG8_BAR;
            PG8_LDA(At, 1, 1); PG8_STAGE(PG8_SA(1, 0), a3, voffA);
            PG8_BAR; PG8_WAIT_L(0); PG8_MMA(1, 0, At, B0); PG8_BAR; PG8_SCHED;
            PG8_STAGE(PG8_SB(1, 1), b3 + hstep, voffB);
            PG8_WAIT_V(6); PG8_BAR; PG8_MMA(1, 1, At, B1); PG8_BAR;
            }
        }
        if constexpr (ALIGN_EPI) { if (wr == 0) PG8_BAR; }
        if constexpr (!Epi::AFTER_DRAIN) { E(acc, cur, wr, wc, fr, fq); S.done(cur); }
        if (!has_next) break;
#pragma unroll
        for (int a = 0; a < 2; ++a)
#pragma unroll
            for (int b = 0; b < 2; ++b)
#pragma unroll
                for (int m = 0; m < 4; ++m)
#pragma unroll
                    for (int n = 0; n < 2; ++n) acc[a][b][m][n] = (f32x4){0.f, 0.f, 0.f, 0.f};
        cur = nxt; cA = nA; cB = nB; ++ui;
        if constexpr (ALIGN_EPI) { if (wr == 1) PG8_BAR; }
    }
    PG8_WAIT_V(0);
    if constexpr (!ALIGN_EPI) { if (wr == 0) PG8_BAR; }
    PG8_BAR;
    if constexpr (Epi::AFTER_DRAIN) { E.fused(acc, cur, wr, wc, fr, fq, lds, wid, lane); S.done(cur); }
#undef PG8_SA
#undef PG8_SB
#undef PG8_STAGE
#undef PG8_LDA
#undef PG8_LDB
#undef PG8_MMA
#undef PG8_WAIT_V
#undef PG8_WAIT_L
#undef PG8_BAR
#undef PG8_SCHED
}
}
#define LAS __attribute__((address_space(3)))
typedef unsigned short bf16;
typedef unsigned v4u __attribute__((ext_vector_type(4)));
typedef unsigned v2u __attribute__((ext_vector_type(2)));
typedef float f32x4 __attribute__((ext_vector_type(4)));
typedef float f32x2 __attribute__((ext_vector_type(2)));
typedef float f32x16 __attribute__((ext_vector_type(16)));
typedef short bf16x8 __attribute__((ext_vector_type(8)));

constexpr int NWAVES = 8;
constexpr int DM = 2048, MROWS = 6144;
constexpr int NPROJ = 12416, NPROJ_PAD = 12544;
constexpr int LDS_BYTES = 147456;
constexpr size_t MiB = 1u << 20;
constexpr size_t WS_CTL = 0, WS_MOD = 1 * MiB, WS_AB = 2 * MiB, WS_STATS = 6 * MiB, WS_VEC = 10 * MiB;
constexpr size_t WS_WIN = 16 * MiB, WS_WOUT = 65 * MiB, WS_WCMIN = 81 * MiB, WS_WCMOUT = 113 * MiB, WS_WFF1 = 129 * MiB, WS_WFF2 = 193 * MiB, WS_WSB = 257 * MiB;
constexpr size_t WS_X = 258 * MiB, WS_XN = 306 * MiB, WS_QKV = 330 * MiB  , WS_Z = 426 * MiB  ;
constexpr size_t WS_KA = 474 * MiB  , WS_QA = 498 * MiB, WS_KT = 522 * MiB, WS_VT = 546 * MiB, WS_TB = 594 * MiB, WS_IN = 642 * MiB, WS_END = 690 * MiB;
constexpr size_t OUT_SF = (size_t)MROWS * DM, OUT_SB = OUT_SF + (size_t)16 * 32 * 128 * 128;

struct Params { const float* in[26]; float* out; unsigned char* ws; int ph_lo, ph_hi; };

__device__ __forceinline__ unsigned f2bf(float f) { unsigned u = __builtin_bit_cast(unsigned, f); return (u + 0x7fffu + ((u >> 16) & 1u)) >> 16; }
__device__ __forceinline__ unsigned pk2(float lo, float hi) { return pg8::cvt_pk_bf16(lo, hi); }
__device__ __forceinline__ float bflo(unsigned u) { return __builtin_bit_cast(float, u << 16); }
__device__ __forceinline__ float bfhi(unsigned u) { return __builtin_bit_cast(float, u & 0xffff0000u); }
__device__ __forceinline__ float bf2f(bf16 b) { return __builtin_bit_cast(float, (unsigned)b << 16); }
__device__ __forceinline__ float wave_sum(float v) {
#pragma unroll
    for (int o = 1; o < 64; o <<= 1) v += __shfl_xor(v, o);
    return v;
}
__device__ __forceinline__ float silu_f(float x) { return x / (1.0f + __expf(-x)); }
#define LDS_WAIT() asm volatile("s_waitcnt lgkmcnt(0)" ::: "memory")

__device__ __forceinline__ void transpose_item(const float* W, int K, int N, bf16* WT, LAS float* scr, int item, int lane) {
    const int nblk = N >> 6, kb = item / nblk, nb = item - kb * nblk, k0 = kb * 64, n0 = nb * 64;
    const float* src = W + (size_t)k0 * N + n0 + lane;
#pragma unroll 16
    for (int i = 0; i < 64; ++i) scr[i * 65 + lane] = src[(size_t)i * N];
    LDS_WAIT();
    const int c = lane & 7;
#pragma unroll
    for (int j = 0; j < 8; ++j) { const int n = (lane >> 3) + 8 * j; const LAS float* s = scr + (8 * c) * 65 + n;
        v4u o; o.x = pk2(s[0 * 65], s[1 * 65]); o.y = pk2(s[2 * 65], s[3 * 65]); o.z = pk2(s[4 * 65], s[5 * 65]); o.w = pk2(s[6 * 65], s[7 * 65]);
        *(v4u*)(WT + (size_t)(n0 + n) * K + k0 + 8 * c) = o; }
    LDS_WAIT();
}
__device__ __forceinline__ void phase_prologue(const Params& p, LAS unsigned char* lds, int tid, int lane, int wave, int vcu, int G) {
    unsigned char* ws = p.ws;
    {
        LAS float* sc = (LAS float*)lds; LAS float* red = sc + 3 * 2048;
        for (int i = tid; i < 3 * 2048; i += 512) { const int cnd = i >> 11, k = i & 2047; const float x = cnd == 0 ? p.in[5][k] : p.in[4][(cnd - 1) * 2048 + k]; sc[i] = silu_f(x); }
        __syncthreads();
        float* MOD = (float*)(ws + WS_MOD);
        for (int strip = vcu; strip < 256; strip += G) {
            const int l = strip >> 7, n0 = (strip & 127) * 96;
            if (tid < 504) {
                const int cl = tid % 24, g = tid / 24;
                const float* W = p.in[8] + (size_t)l * 2048 * 12288 + n0 + 4 * cl;
                f32x4 a0 = {0.f, 0.f, 0.f, 0.f}, a1 = a0, a2 = a0;
#pragma unroll 7
                for (int k = g; k < 2048; k += 21) { const f32x4 w = *(const f32x4*)(W + (size_t)k * 12288); a0 += w * sc[k]; a1 += w * sc[2048 + k]; a2 += w * sc[4096 + k]; }
                LAS float* r = red + g * 288 + 4 * cl;
                *(LAS f32x4*)(r) = a0; *(LAS f32x4*)(r + 96) = a1; *(LAS f32x4*)(r + 192) = a2;
            }
            __syncthreads();
            if (tid < 288) { float s = 0.f;
#pragma unroll
                for (int g = 0; g < 21; ++g) s += red[g * 288 + tid];
                const int cnd = tid / 96, c = tid % 96; MOD[(l * 3 + cnd) * 12288 + n0 + c] = s + p.in[9][l * 12288 + n0 + c]; }
            __syncthreads();
        }
    }
    {
        LAS float* scr = (LAS float*)(lds + wave * 16640);
        const int gw = vcu * NWAVES + wave, NGW = G * NWAVES;
        constexpr int I0 = 32 * 194, I1 = 64 * 32, I2 = 32 * 128, I3 = 64 * 32, I4 = 32 * 128, I6 = 128 * 32;
        constexpr int NITEMS = I0 + I1 + I2 + I3 + 2 * I4 + 2 * I6;
        for (int it = gw; it < NITEMS; it += NGW) {
            int r = it;
            if (r < I0) { transpose_item(p.in[10], 2048, NPROJ, (bf16*)(ws + WS_WIN), scr, r, lane); continue; } r -= I0;
            if (r < I1) { transpose_item(p.in[15], 4096, 2048, (bf16*)(ws + WS_WOUT), scr, r, lane); continue; } r -= I1;
            if (r < I2) { transpose_item(p.in[16], 2048, 8192, (bf16*)(ws + WS_WCMIN), scr, r, lane); continue; } r -= I2;
            if (r < I3) { transpose_item(p.in[22], 4096, 2048, (bf16*)(ws + WS_WCMOUT), scr, r, lane); continue; } r -= I3;
            if (r < 2 * I4) { const int l = r / I4; transpose_item(p.in[23] + (size_t)l * 2048 * 8192, 2048, 8192, (bf16*)(ws + WS_WFF1) + (size_t)l * 2048 * 8192, scr, r - l * I4, lane); continue; } r -= 2 * I4;
            { const int l = r / I6; transpose_item(p.in[24] + (size_t)l * 2048 * 8192, 8192, 2048, (bf16*)(ws + WS_WFF2) + (size_t)l * 2048 * 8192, scr, r - l * I6, lane); }
        }
    }
    {
        const int gt = vcu * 512 + tid, NT = G * 512;
        const float* wsf = p.in[20]; v4u* dst = (v4u*)(ws + WS_WSB);
        for (int i = gt; i < 32768; i += NT) { const f32x4 a = *(const f32x4*)(wsf + 8 * i), b = *(const f32x4*)(wsf + 8 * i + 4); v4u o; o.x = pk2(a[0], a[1]); o.y = pk2(a[2], a[3]); o.z = pk2(b[0], b[1]); o.w = pk2(b[2], b[3]); dst[i] = o; }
        v4u* pad = (v4u*)((bf16*)(ws + WS_WIN) + (size_t)NPROJ * 2048);
        for (int i = gt; i < 32768; i += NT) pad[i] = (v4u){0u, 0u, 0u, 0u};
    }
}

template <int MODE>
__device__ __forceinline__ void phase_norm(const Params& p, int layer, int which, int lane, int wave, int vcu, int G) {
    unsigned char* ws = p.ws; float* X = (float*)(ws + WS_X); bf16* XN = (bf16*)(ws + WS_XN); const float* MOD = (const float*)(ws + WS_MOD);
    const int gw = vcu * NWAVES + wave, NGW = G * NWAVES;
    for (int row = gw; row < MROWS; row += NGW) {
        f32x4 v[8];
        const float* src = MODE == 0 ? (row < 4096 ? p.in[0] + (size_t)row * DM : p.in[1] + (size_t)(row - 4096) * DM) : X + (size_t)row * DM;
#pragma unroll
        for (int j = 0; j < 8; ++j) v[j] = *(const f32x4*)(src + 4 * (lane + 64 * j));
        if (MODE == 0) {
            if (row >= 4096) {
                const int pos = (row - 4096) & 1023; const float gr = (float)(pos >> 6), gc = (float)(pos & 63);
#pragma unroll
                for (int j = 0; j < 8; ++j) { const float base = (j >> 1) < 2 ? gr : gc;
#pragma unroll
                    for (int e = 0; e < 4; ++e) { const int i = (4 * (lane + 64 * j) + e) & 511; const float fr = expf(-(float)i * (9.210340371976184f / 512.0f)); const float ang = base * fr;
                        v[j][e] += ((j >> 1) & 1) ? cosf(ang) : sinf(ang); } }
            }
#pragma unroll
            for (int j = 0; j < 8; ++j) *(f32x4*)(X + (size_t)row * DM + 4 * (lane + 64 * j)) = v[j];
        }
        float ss = 0.f;
#pragma unroll
        for (int j = 0; j < 8; ++j) ss += (v[j][0] * v[j][0] + v[j][1] * v[j][1]) + (v[j][2] * v[j][2] + v[j][3] * v[j][3]);
        ss = wave_sum(ss);
        const float r = 1.0f / sqrtf(ss * (1.0f / DM) + 1e-6f);
        if (MODE == 2) {
#pragma unroll
            for (int j = 0; j < 8; ++j) { const f32x4 w = *(const f32x4*)(p.in[25] + 4 * (lane + 64 * j)); *(f32x4*)(p.out + (size_t)row * DM + 4 * (lane + 64 * j)) = v[j] * r * w; }
        } else {
            const int cond = row < 4096 ? 0 : (row < 5120 ? 1 : 2);
            const float* nw = p.in[which ? 7 : 6] + layer * DM; const float* mb = MOD + (size_t)(layer * 3 + cond) * 12288 + (which ? 6144 : 0);
#pragma unroll
            for (int j = 0; j < 8; ++j) { const int c = 4 * (lane + 64 * j); const f32x4 w = *(const f32x4*)(nw + c), sh = *(const f32x4*)(mb + c), sc = *(const f32x4*)(mb + 2048 + c);
                const f32x4 y = v[j] * r * w * (sc + 1.0f) + sh; v2u o; o.x = pk2(y[0], y[1]); o.y = pk2(y[2], y[3]); *(v2u*)(XN + (size_t)row * DM + c) = o; }
        }
    }
}

__device__ __forceinline__ void phase_conv(const Params& p, LAS unsigned char* lds, int tid, int lane, int wave, int vcu, int G) {
    unsigned char* ws = p.ws;
    LAS float* XQK = (LAS float*)lds;
    LAS bf16* XV = (LAS bf16*)(lds + 66560);
    LAS float* RN = (LAS float*)(lds + 66560 + 33792);
    const bf16* QKV = (const bf16*)(ws + WS_QKV); const float* cw = p.in[11];
    for (int u = vcu; u < 1536; u += G) {
        const int c = u >> 4, kh = u & 15;
        int s0, s1; if (c < 64) { s0 = (c >> 2) * 256; s1 = s0 + 256; } else { s0 = 4096 + ((c - 64) >> 4) * 1024; s1 = s0 + 1024; }
        {
            const int cp = tid & 255, th = tid >> 8;
            int gcol, lcol; if (cp < 64) { gcol = kh * 128 + 2 * cp; lcol = 2 * cp; } else if (cp < 128) { gcol = 2048 + kh * 128 + 2 * (cp - 64); lcol = 128 + 2 * (cp - 64); } else { gcol = 4096 + kh * 256 + 2 * (cp - 128); lcol = 2 * (cp - 128); }
            float w0[5], w1[5];
#pragma unroll
            for (int j = 0; j < 5; ++j) { w0[j] = cw[j * 8192 + gcol]; w1[j] = cw[j * 8192 + gcol + 1]; }
            const int r0 = c * 64 + th * 32;
            float x0[5], x1[5];
#pragma unroll
            for (int j = 0; j < 4; ++j) { const int rr = r0 - 2 + j; unsigned v = 0u; if (rr >= s0 && rr < s1) v = *(const unsigned*)(QKV + (size_t)rr * 8192 + gcol); x0[j] = bflo(v); x1[j] = bfhi(v); }
#pragma unroll 8
            for (int i = 0; i < 32; ++i) {
                { const int rr = r0 + i + 2; unsigned v = 0u; if (rr >= s0 && rr < s1) v = *(const unsigned*)(QKV + (size_t)rr * 8192 + gcol); x0[4] = bflo(v); x1[4] = bfhi(v); }
                float a0 = 0.f, a1 = 0.f;
#pragma unroll
                for (int j = 0; j < 5; ++j) { a0 += w0[j] * x0[j]; a1 += w1[j] * x1[j]; }
                a0 = silu_f(a0); a1 = silu_f(a1);
                const int t = th * 32 + i;
                if (cp < 128) *(LAS f32x2*)(XQK + t * 260 + lcol) = (f32x2){a0, a1}; else *(LAS unsigned*)(XV + t * 264 + lcol) = pk2(a0, a1);
#pragma unroll
                for (int j = 0; j < 4; ++j) { x0[j] = x0[j + 1]; x1[j] = x1[j + 1]; }
            }
        }
        __syncthreads();
#pragma unroll
        for (int tt = 0; tt < 8; ++tt) { const int t = wave * 8 + tt; const LAS float* r = XQK + t * 260;
            const float a = r[lane], b = r[64 + lane], cc = r[128 + lane], dd = r[192 + lane];
            const float sq = wave_sum(a * a + b * b), sk = wave_sum(cc * cc + dd * dd);
            if (lane == 0) { RN[t] = (1.0f / sqrtf(sq + 1e-6f)) * 0.08838834764831845f; RN[64 + t] = 1.0f / sqrtf(sk + 1e-6f); } }
        __syncthreads();
        v4u* KAo = (v4u*)(ws + WS_KA) + (size_t)u * 1024; v4u* QAo = (v4u*)(ws + WS_QA) + (size_t)u * 1024; v4u* KTo = (v4u*)(ws + WS_KT) + (size_t)u * 1024;
        v4u* VTo = (v4u*)(ws + WS_VT) + (size_t)(c * 32 + 2 * kh) * 1024;
        for (int pi = tid; pi < 1024; pi += 512) {
            const int rb = pi >> 9, s = (pi >> 6) & 7, ln = pi & 63, t = 32 * rb + (ln & 31), h = ln >> 5;
            const LAS float* rq = XQK + t * 260 + 16 * s + 4 * h;
            { const f32x4 a = *(const LAS f32x4*)rq * RN[t], b = *(const LAS f32x4*)(rq + 8) * RN[t]; v4u o; o.x = pk2(a[0], a[1]); o.y = pk2(a[2], a[3]); o.z = pk2(b[0], b[1]); o.w = pk2(b[2], b[3]); QAo[pi] = o; }
            { const f32x4 a = *(const LAS f32x4*)(rq + 128) * RN[64 + t], b = *(const LAS f32x4*)(rq + 136) * RN[64 + t]; v4u o; o.x = pk2(a[0], a[1]); o.y = pk2(a[2], a[3]); o.z = pk2(b[0], b[1]); o.w = pk2(b[2], b[3]); KAo[pi] = o; }
        }
        for (int pi = tid; pi < 1024; pi += 512) {
            const int rb = pi >> 8, s = (pi >> 6) & 3, ln = pi & 63, dk = 32 * rb + (ln & 31), h = ln >> 5, tb = 16 * s + 4 * h;
            float e[8];
#pragma unroll
            for (int j = 0; j < 8; ++j) { const int t = tb + (j & 3) + 8 * (j >> 2); e[j] = XQK[t * 260 + 128 + dk] * RN[64 + t]; }
            v4u o; o.x = pk2(e[0], e[1]); o.y = pk2(e[2], e[3]); o.z = pk2(e[4], e[5]); o.w = pk2(e[6], e[7]); KTo[pi] = o;
        }
        for (int pi = tid; pi < 2048; pi += 512) {
            const int e2 = pi >> 10, q = pi & 1023, sl = q >> 8, s = (q >> 6) & 3, ln = q & 63, dv = 32 * sl + (ln & 31), h = ln >> 5, tb = 16 * s + 4 * h;
            unsigned e[8];
#pragma unroll
            for (int j = 0; j < 8; ++j) { const int t = tb + (j & 3) + 8 * (j >> 2); e[j] = XV[t * 264 + e2 * 128 + dv]; }
            v4u o; o.x = e[0] | (e[1] << 16); o.y = e[2] | (e[3] << 16); o.z = e[4] | (e[5] << 16); o.w = e[6] | (e[7] << 16); VTo[pi] = o;
        }
        __syncthreads();
    }
}

__device__ __forceinline__ void phase_dn_naive(const Params& p, LAS unsigned char* lds, int tid, int vcu, int G) {
    unsigned char* ws = p.ws;
    const int sb = tid >> 7, j = tid & 127;
    LAS unsigned char* my = lds + sb * 33792;
    LAS bf16* Kc = (LAS bf16*)my; LAS bf16* Qc = (LAS bf16*)(my + 16384); LAS float* Gs = (LAS float*)(my + 32768); LAS float* Bs = Gs + 64;
    const float* AB = (const float*)(ws + WS_AB); bf16* OFOB = (bf16*)(ws + WS_QKV);
    for (int g = vcu; g < 288; g += G) {
        const int task = 4 * g + sb, seq = task >> 6, h = (task >> 1) & 31, d = task & 1, kh = h >> 1;
        const int nch = seq < 16 ? 4 : 16, cbase = seq < 16 ? 4 * seq : 64 + 16 * (seq - 16);
        float S[128];
        if (seq < 16) {
#pragma unroll
            for (int k = 0; k < 128; ++k) S[k] = 0.f;
        } else { const float* st = p.in[d ? 3 : 2] + (size_t)((seq - 16) * 32 + h) * 16384 + j;
#pragma unroll
            for (int k = 0; k < 128; ++k) S[k] = st[k * 128]; }
        const float Aexp = expf(p.in[12][d * 32 + h]), dtb = p.in[13][d * 32 + h];
        for (int n = 0; n < nch; ++n) {
            const int c = cbase + (d ? nch - 1 - n : n);
            __syncthreads();
            const v4u* KAi = (const v4u*)(ws + WS_KA) + (size_t)(c * 16 + kh) * 1024; const v4u* QAi = (const v4u*)(ws + WS_QA) + (size_t)(c * 16 + kh) * 1024;
            for (int pi = j; pi < 1024; pi += 128) { const int rb = pi >> 9, s = (pi >> 6) & 7, ln = pi & 63, t = 32 * rb + (ln & 31), hh = ln >> 5;
                const v4u a = KAi[pi], b = QAi[pi]; const int o = t * 128 + 16 * s + 4 * hh;
                *(LAS v2u*)(Kc + o) = (v2u){a.x, a.y}; *(LAS v2u*)(Kc + o + 8) = (v2u){a.z, a.w}; *(LAS v2u*)(Qc + o) = (v2u){b.x, b.y}; *(LAS v2u*)(Qc + o + 8) = (v2u){b.z, b.w}; }
            if (j < 64) { const int row = 64 * c + j; const float a = AB[(size_t)row * 128 + d * 64 + h], b = AB[(size_t)row * 128 + d * 64 + 32 + h];
                const float x = a + dtb, sp = x > 20.f ? x : log1pf(expf(x)); Gs[j] = expf(-Aexp * sp); Bs[j] = 1.0f / (1.0f + expf(-b)); }
            __syncthreads();
            const bf16* VTi = (const bf16*)(ws + WS_VT) + (size_t)(c * 32 + h) * 8192;
#pragma nounroll
            for (int tt = 0; tt < 64; ++tt) {
                const int t = d ? 63 - tt : tt;
                const int q = t & 15, piece = (j >> 5) * 256 + (t >> 4) * 64 + ((q >> 2) & 1) * 32 + (j & 31), jj = 4 * (q >> 3) + (q & 3);
                const float v = bf2f(VTi[piece * 8 + jj]);
                const float gg = Gs[t], bb = Bs[t];
                float kS = 0.f;
#pragma unroll
                for (int k8 = 0; k8 < 16; ++k8) { const v4u kk = *(const LAS v4u*)(Kc + t * 128 + 8 * k8);
                    kS += bflo(kk.x) * S[8 * k8 + 0]; kS += bfhi(kk.x) * S[8 * k8 + 1]; kS += bflo(kk.y) * S[8 * k8 + 2]; kS += bfhi(kk.y) * S[8 * k8 + 3];
                    kS += bflo(kk.z) * S[8 * k8 + 4]; kS += bfhi(kk.z) * S[8 * k8 + 5]; kS += bflo(kk.w) * S[8 * k8 + 6]; kS += bfhi(kk.w) * S[8 * k8 + 7];
                    if ((k8 & 3) == 3) asm volatile("" ::: "memory"); }
                const float coef = bb * (v - gg * kS);
                float o = 0.f;
#pragma unroll
                for (int k8 = 0; k8 < 16; ++k8) { const v4u kk = *(const LAS v4u*)(Kc + t * 128 + 8 * k8), qq = *(const LAS v4u*)(Qc + t * 128 + 8 * k8);
                    const float kf[8] = {bflo(kk.x), bfhi(kk.x), bflo(kk.y), bfhi(kk.y), bflo(kk.z), bfhi(kk.z), bflo(kk.w), bfhi(kk.w)};
                    const float qf[8] = {bflo(qq.x), bfhi(qq.x), bflo(qq.y), bfhi(qq.y), bflo(qq.z), bfhi(qq.z), bflo(qq.w), bfhi(qq.w)};
#pragma unroll
                    for (int e = 0; e < 8; ++e) { S[8 * k8 + e] = kf[e] * coef + gg * S[8 * k8 + e]; o += qf[e] * S[8 * k8 + e]; }
                    if ((k8 & 1) == 1) asm volatile("" ::: "memory"); }
                OFOB[(size_t)d * MROWS * 4096 + (size_t)(64 * c + t) * 4096 + h * 128 + j] = (bf16)f2bf(o);
            }
        }
        if (seq < 16) { float* so = p.out + (d ? OUT_SB : OUT_SF) + (size_t)(seq * 32 + h) * 16384 + j;
#pragma unroll
            for (int k = 0; k < 128; ++k) so[k * 128] = S[k]; }
    }
}

__device__ __forceinline__ void phase_combine(const Params& p, int lane, int wave, int vcu, int G) {
    unsigned char* ws = p.ws;
    const bf16* OF = (const bf16*)(ws + WS_QKV); const bf16* OB = OF + (size_t)MROWS * 4096; const bf16* Z = (const bf16*)(ws + WS_Z); bf16* OG = (bf16*)(ws + WS_KA);
    const int gw = vcu * NWAVES + wave, NGW = G * NWAVES, half = lane >> 5, l32 = lane & 31;
    const f32x4 nw = *(const f32x4*)(p.in[14] + 4 * l32);
    for (int it = gw; it < MROWS * 16; it += NGW) {
        const int row = it >> 4, hv = (it & 15) * 2 + half; const size_t off = (size_t)row * 4096 + hv * 128 + 4 * l32;
        const v2u a = *(const v2u*)(OF + off), b = *(const v2u*)(OB + off), z = *(const v2u*)(Z + off);
        f32x4 o = {bflo(a.x) + bflo(b.x), bfhi(a.x) + bfhi(b.x), bflo(a.y) + bflo(b.y), bfhi(a.y) + bfhi(b.y)};
        float ss = (o[0] * o[0] + o[1] * o[1]) + (o[2] * o[2] + o[3] * o[3]);
#pragma unroll
        for (int m = 1; m < 32; m <<= 1) ss += __shfl_xor(ss, m);
        const float r = 1.0f / sqrtf(ss * (1.0f / 128.0f) + 1e-6f);
        const f32x4 zz = {silu_f(bflo(z.x)), silu_f(bfhi(z.x)), silu_f(bflo(z.y)), silu_f(bfhi(z.y))};
        const f32x4 y = o * r * nw * zz; v2u w; w.x = pk2(y[0], y[1]); w.y = pk2(y[2], y[3]); *(v2u*)(OG + off) = w;
    }
}

__device__ __forceinline__ void phase_spatial(const Params& p, LAS unsigned char* lds, int tid, int lane, int wave, int vcu, int G) {
    unsigned char* ws = p.ws;
    LAS bf16* VL = (LAS bf16*)lds;
    LAS float* RS = (LAS float*)(lds + 67584);
    const bf16* H = (const bf16*)(ws + WS_QKV); bf16* UV = (bf16*)(ws + WS_Z); const float* STATS = (const float*)(ws + WS_STATS);
    for (int u = vcu; u < 768; u += G) {
        const int tc = u >> 4, g = u & 15;
        __syncthreads();
        { const int q = tid >> 2, part = tid & 3; const f32x2* st = (const f32x2*)(STATS + (size_t)(128 * tc + q) * 128) + part * 16; float s1 = 0.f, s2 = 0.f;
#pragma unroll
            for (int i = 0; i < 16; ++i) { const f32x2 x = st[i]; s1 += x[0]; s2 += x[1]; }
            s1 += __shfl_xor(s1, 1); s1 += __shfl_xor(s1, 2); s2 += __shfl_xor(s2, 1); s2 += __shfl_xor(s2, 2);
            const float mu = s1 * (1.0f / 4096.0f), var = s2 * (1.0f / 4096.0f) - mu * mu;
            if (part == 0) { RS[2 * q] = mu; RS[2 * q + 1] = 1.0f / sqrtf(fmaxf(var, 0.f) + 1e-6f); } }
        __syncthreads();
        for (int pi = tid; pi < 4096; pi += 512) { const int q = pi >> 5, c8 = pi & 31;
            const v4u raw = *(const v4u*)(H + (size_t)(128 * tc + q) * 8192 + 4096 + 256 * g + 8 * c8);
            const float mu = RS[2 * q], rs = RS[2 * q + 1];
            const float* lw = p.in[18] + 256 * g + 8 * c8; const float* lb = p.in[19] + 256 * g + 8 * c8;
            const f32x4 w0 = *(const f32x4*)lw, w1 = *(const f32x4*)(lw + 4), b0 = *(const f32x4*)lb, b1 = *(const f32x4*)(lb + 4);
            const f32x4 x0 = {bflo(raw.x), bfhi(raw.x), bflo(raw.y), bfhi(raw.y)}, x1 = {bflo(raw.z), bfhi(raw.z), bflo(raw.w), bfhi(raw.w)};
            const f32x4 y0 = (x0 - mu) * rs * w0 + b0, y1 = (x1 - mu) * rs * w1 + b1;
            v4u o; o.x = pk2(y0[0], y0[1]); o.y = pk2(y0[2], y0[3]); o.z = pk2(y1[0], y1[1]); o.w = pk2(y1[2], y1[3]);
            *(LAS v4u*)(VL + q * 264 + 8 * c8) = o; }
        __syncthreads();
        const int col = 32 * wave + (lane & 31), hh = lane >> 5;
        bf16x8 bfr[8];
#pragma unroll
        for (int s = 0; s < 8; ++s) {
#pragma unroll
            for (int e = 0; e < 8; ++e) bfr[s][e] = (short)VL[(16 * s + 8 * hh + e) * 264 + col]; }
        f32x16 acc[4];
#pragma unroll
        for (int rb = 0; rb < 4; ++rb)
#pragma unroll
            for (int e = 0; e < 16; ++e) acc[rb][e] = 0.f;
        const bf16* Wb = (const bf16*)(ws + WS_WSB) + (size_t)g * 16384;
#pragma unroll
        for (int rb = 0; rb < 4; ++rb)
#pragma unroll
            for (int s = 0; s < 8; ++s) { const bf16x8 a = *(const bf16x8*)(Wb + (32 * rb + (lane & 31)) * 128 + 16 * s + 8 * hh); acc[rb] = __builtin_amdgcn_mfma_f32_32x32x16_bf16(a, bfr[s], acc[rb], 0, 0, 0); }
        const float* bs = p.in[21] + g * 128;
#pragma unroll
        for (int rb = 0; rb < 4; ++rb)
#pragma unroll
            for (int e = 0; e < 16; ++e) { const int pr = 32 * rb + (e & 3) + 8 * (e >> 2) + 4 * hh; const size_t row = (size_t)(128 * tc + pr);
                const float val = acc[rb][e] + bs[pr]; const float uu = bf2f(H[row * 8192 + 256 * g + col]); UV[row * 4096 + 256 * g + col] = (bf16)f2bf(uu * val); }
    }
}

constexpr int NPHASE = 19;
__global__ void __launch_bounds__(NWAVES * 64, 2) mega_fwd(Params p) {
    extern __shared__ __attribute__((aligned(16))) unsigned char lds_raw[];
    LAS unsigned char* lds = (LAS unsigned char*)lds_raw;
    const int tid = threadIdx.x, lane = tid & 63, wave = __builtin_amdgcn_readfirstlane(tid >> 6);
    const int G = gridDim.x, bx = blockIdx.x, vcu = (G % 8 == 0) ? (bx % 8) * (G / 8) + bx / 8 : bx;
    unsigned char* ws = p.ws;
    const int lo = p.ph_lo, hi = p.ph_hi;
#ifndef PH_MASK
#define PH_MASK 0xFFFFFFFFu
#endif
#define IN(k) (((PH_MASK >> (k)) & 1u) && lo <= (k) && (k) < hi)
#define SEAM(k) do { if (IN(k) && IN((k) + 1)) { cg::this_grid().sync(); } } while (0)
    const float* MOD = (const float*)(ws + WS_MOD);
    bf16* XN = (bf16*)(ws + WS_XN); float* X = (float*)(ws + WS_X); bf16* Hb = (bf16*)(ws + WS_QKV);

    if (IN(0)) { phase_prologue(p, lds, tid, lane, wave, vcu, G); } SEAM(0);
    if (IN(1)) { phase_norm<0>(p, 0, 0, lane, wave, vcu, G); } SEAM(1);
    if (IN(2)) { pg8::Gemm g{XN, (const bf16*)(ws + WS_WIN), MROWS, NPROJ_PAD, 2048}; pg8::StaticOrder S; S.init(MROWS, NPROJ_PAD, G, bx);
        pg8::EpiProj E{(bf16*)(ws + WS_QKV), (bf16*)(ws + WS_Z), (float*)(ws + WS_AB)};
        pg8::gemm_phase<pg8::EpiProj, pg8::StaticOrder, true, true>(lds, g, S, E); } SEAM(2);
    if (IN(3)) { phase_conv(p, lds, tid, lane, wave, vcu, G); } SEAM(3);
    if (IN(4)) { phase_dn_naive(p, lds, tid, vcu, G); } SEAM(4);
    SEAM(5);
    if (IN(6)) { phase_combine(p, lane, wave, vcu, G); } SEAM(6);
    if (IN(7)) { pg8::Gemm g{(const bf16*)(ws + WS_KA), (const bf16*)(ws + WS_WOUT), MROWS, 2048, 4096}; pg8::StaticOrder S; S.init(MROWS, 2048, G, bx);
        pg8::EpiRes E{X, MOD + 4096};
        pg8::gemm_phase<pg8::EpiRes, pg8::StaticOrder, true, true>(lds, g, S, E); } SEAM(7);
    if (IN(8)) { phase_norm<1>(p, 0, 1, lane, wave, vcu, G); } SEAM(8);
    if (IN(9)) { pg8::Gemm g{XN, (const bf16*)(ws + WS_WFF1), MROWS, 8192, 2048}; pg8::StaticOrder S; S.init(MROWS, 8192, G, bx);
        pg8::EpiAct<0> E{Hb, nullptr, nullptr};
        pg8::gemm_phase<pg8::EpiAct<0>, pg8::StaticOrder, true, true>(lds, g, S, E); } SEAM(9);
    if (IN(10)) { pg8::Gemm g{Hb, (const bf16*)(ws + WS_WFF2), MROWS, 2048, 8192}; pg8::StaticOrder S; S.init(MROWS, 2048, G, bx);
        pg8::EpiRes E{X, MOD + 10240};
        pg8::gemm_phase<pg8::EpiRes, pg8::StaticOrder, true, true>(lds, g, S, E); } SEAM(10);
    if (IN(11)) { phase_norm<1>(p, 1, 0, lane, wave, vcu, G); } SEAM(11);
    if (IN(12)) { pg8::Gemm g{XN, (const bf16*)(ws + WS_WCMIN), MROWS, 8192, 2048}; pg8::StaticOrder S; S.init(MROWS, 8192, G, bx);
        pg8::EpiAct<1> E{Hb, p.in[17], (float*)(ws + WS_STATS)};
        pg8::gemm_phase<pg8::EpiAct<1>, pg8::StaticOrder, true, true>(lds, g, S, E); } SEAM(12);
    if (IN(13)) { phase_spatial(p, lds, tid, lane, wave, vcu, G); } SEAM(13);
    if (IN(14)) { pg8::Gemm g{(const bf16*)(ws + WS_Z), (const bf16*)(ws + WS_WCMOUT), MROWS, 2048, 4096}; pg8::StaticOrder S; S.init(MROWS, 2048, G, bx);
        pg8::EpiRes E{X, MOD + 3 * 12288 + 4096};
        pg8::gemm_phase<pg8::EpiRes, pg8::StaticOrder, true, true>(lds, g, S, E); } SEAM(14);
    if (IN(15)) { phase_norm<1>(p, 1, 1, lane, wave, vcu, G); } SEAM(15);
    if (IN(16)) { pg8::Gemm g{XN, (const bf16*)(ws + WS_WFF1) + (size_t)2048 * 8192, MROWS, 8192, 2048}; pg8::StaticOrder S; S.init(MROWS, 8192, G, bx);
        pg8::EpiAct<0> E{Hb, nullptr, nullptr};
        pg8::gemm_phase<pg8::EpiAct<0>, pg8::StaticOrder, true, true>(lds, g, S, E); } SEAM(16);
    if (IN(17)) { pg8::Gemm g{Hb, (const bf16*)(ws + WS_WFF2) + (size_t)2048 * 8192, MROWS, 2048, 8192}; pg8::StaticOrder S; S.init(MROWS, 2048, G, bx);
        pg8::EpiRes E{X, MOD + 3 * 12288 + 10240};
        pg8::gemm_phase<pg8::EpiRes, pg8::StaticOrder, true, true>(lds, g, S, E); } SEAM(17);
    if (IN(18)) { phase_norm<2>(p, 0, 0, lane, wave, vcu, G); }
#undef IN
#undef SEAM
}

extern "C" void kernel_launch(void* const* d_in, const int* in_sizes, int n_in, void* d_out, int out_size, void* d_ws, size_t ws_size, hipStream_t stream) {
    static int grid = 0;
    if (grid == 0) {
        if (n_in != 26 || ws_size < WS_END) { fprintf(stderr, "kernel_launch: expected 26 inputs and >= %zu bytes of workspace; got %d, %zu\n", (size_t)WS_END, n_in, ws_size); grid = -1; return; }
        int dev = 0, cus = 0, per_cu = 0;
        if (hipGetDevice(&dev) != hipSuccess || hipDeviceGetAttribute(&cus, hipDeviceAttributeMultiprocessorCount, dev) != hipSuccess) { grid = -1; return; }
        if (hipFuncSetAttribute((const void*)mega_fwd, hipFuncAttributeMaxDynamicSharedMemorySize, LDS_BYTES) != hipSuccess) { fprintf(stderr, "kernel_launch: hipFuncSetAttribute failed\n"); grid = -1; return; }
        if (hipOccupancyMaxActiveBlocksPerMultiprocessor(&per_cu, (const void*)mega_fwd, NWAVES * 64, LDS_BYTES) != hipSuccess || per_cu < 1) { fprintf(stderr, "kernel_launch: occupancy query reports %d blocks per CU\n", per_cu); (void)hipGetLastError(); per_cu = 1; }
        grid = cus;
    }
    if (grid < 0) return;
    Params a{};
    for (int i = 0; i < 26; ++i) a.in[i] = (const float*)d_in[i];
    a.out = (float*)d_out; a.ws = (unsigned char*)d_ws;
#if MK_PER_PHASE
    for (int ph = 0; ph < NPHASE; ++ph) { if (ph == 5) continue; a.ph_lo = ph; a.ph_hi = ph + 1; hipLaunchKernelGGL(mega_fwd, dim3(grid), dim3(NWAVES * 64), LDS_BYTES, stream, a); }
#else
    a.ph_lo = 0; a.ph_hi = NPHASE;
    void* args[] = {&a};
    hipError_t e = hipLaunchCooperativeKernel((const void*)mega_fwd, dim3(grid), dim3(NWAVES * 64), args, LDS_BYTES, stream);
    if (e != hipSuccess) fprintf(stderr, "kernel_launch: cooperative launch failed: %s (grid %d)\n", hipGetErrorString(e), grid);
#endif
}
```

```cpp
#include <hip/hip_runtime.h>
#include <hip/hip_cooperative_groups.h>
#include <cstdio>
#include <cstdint>
namespace cg = cooperative_groups;
#ifndef MK_PER_PHASE
#define MK_PER_PHASE 0
#endif
namespace pg8 {
#define PG8_LAS __attribute__((address_space(3)))
typedef unsigned short bf16_t;
typedef short bf16x8 __attribute__((ext_vector_type(8)));
typedef float f32x4 __attribute__((ext_vector_type(4)));
typedef unsigned u32x4 __attribute__((ext_vector_type(4)));
constexpr int BM = 256, BK = 64, HALF = 128, HTB = HALF * BK * 2  , STAGE_BYTES = 8 * HTB, NXCD = 8, WGM = 8;

__host__ __device__ __forceinline__ int lds_byte(int r, int c) { const int st = (r >> 4) * 2 + (c >> 5), rr = r & 15, cc = c & 31, ob = rr * 64 + cc * 2; return st * 1024 + (ob ^ (((ob >> 9) & 1) << 5)); }
__host__ __device__ __forceinline__ void stage_rc(int b, int& R, int& C) { const int st = b / 1024, sb = b % 1024, swz = sb ^ (((sb >> 9) & 1) << 5); R = (st >> 1) * 16 + swz / 64; C = (st & 1) * 32 + (swz % 64) / 2; }
__host__ __device__ __forceinline__ int perm32(int rho) { const int n = rho >> 4, i = rho & 15; return 8 * (i >> 2) + 4 * n + (i & 3); }

struct Unit { int pm, pn; };
struct Gemm { const bf16_t* A; const bf16_t* Bt; int M, N, K; };

struct StaticOrder {
    int nM, nN, nwg, G, c;
    __host__ __device__ void init(int M, int N, int G_, int c_) { nM = M / BM; nN = N / BM; nwg = nM * nN; G = G_; c = c_; }
    __host__ __device__ bool next(int i, Unit& u) const {
        const long L = (long)i * G + c; if (L >= nwg) return false;
        int wgid = (int)L; { const int q = nwg / NXCD, r = nwg % NXCD, xcd = wgid % NXCD, off = wgid / NXCD; wgid = (xcd < r ? xcd * (q + 1) : r * (q + 1) + (xcd - r) * q) + off; }
        const int nig = WGM * nN, gid = wgid / nig, fm = gid * WGM, gsz = (nM - fm) < WGM ? (nM - fm) : WGM;
        u.pm = fm + ((wgid % nig) % gsz); u.pn = (wgid % nig) / gsz; return true;
    }
    __device__ __forceinline__ void a_ready(const Unit&) const {}
    __device__ __forceinline__ void done(const Unit&) const {}
};

typedef float f32x2_t __attribute__((ext_vector_type(2))); typedef __bf16 bf16x2_t __attribute__((ext_vector_type(2)));
__device__ __forceinline__ unsigned cvt_pk_bf16(float lo, float hi) { const f32x2_t v = {lo, hi}; const bf16x2_t b = __builtin_convertvector(v, bf16x2_t); return __builtin_bit_cast(unsigned, b); }
__device__ __forceinline__ u32x4 pack8(const f32x4 v0, const f32x4 v1) { u32x4 w; w.x = cvt_pk_bf16(v0[0], v0[1]); w.y = cvt_pk_bf16(v0[2], v0[3]); w.z = cvt_pk_bf16(v1[0], v1[1]); w.w = cvt_pk_bf16(v1[2], v1[3]); return w; }
__device__ __forceinline__ float gelu_tanh(float x) {
    const float u = 0.7978845608028654f * (x + 0.044715f * x * x * x);
    const float e = __builtin_amdgcn_exp2f(-2.0f * 1.4426950408889634f * u);
    return x * __builtin_amdgcn_rcpf(1.0f + e);
}
struct EpiProj {
    static constexpr bool PERM = true, AFTER_DRAIN = false;
    bf16_t* QKV; bf16_t* Z; float* AB;
    __device__ __forceinline__ void operator()(const f32x4 (&acc)[2][2][4][2], const Unit& u, int wr, int wc, int fr, int fq) const {
        const int row0 = u.pm * BM + wr * 64 + fr, cin = wc * 32 + 8 * fq;
        if (u.pn < 48) {
            bf16_t* base; int ldc, colt;
            if (u.pn < 32) { base = QKV; ldc = 8192; colt = u.pn * BM; } else { base = Z; ldc = 4096; colt = (u.pn - 32) * BM; }
#pragma unroll
            for (int ai = 0; ai < 2; ++ai)
#pragma unroll
                for (int m = 0; m < 4; ++m) { bf16_t* rowp = base + (size_t)(row0 + ai * HALF + m * 16) * ldc + colt + cin;
#pragma unroll
                    for (int bj = 0; bj < 2; ++bj) *(u32x4*)(rowp + bj * HALF) = pack8(acc[ai][bj][m][0], acc[ai][bj][m][1]); }
        } else {
#pragma unroll
            for (int ai = 0; ai < 2; ++ai)
#pragma unroll
                for (int m = 0; m < 4; ++m) { float* rowp = AB + (size_t)(row0 + ai * HALF + m * 16) * 128 + cin;
                    *(f32x4*)(rowp) = acc[ai][0][m][0]; *(f32x4*)(rowp + 4) = acc[ai][0][m][1]; }
        }
    }
};
struct EpiRes {
    static constexpr bool PERM = false, AFTER_DRAIN = false;
    float* X; const float* gate;
    __device__ __forceinline__ void operator()(const f32x4 (&acc)[2][2][4][2], const Unit& u, int wr, int wc, int fr, int fq) const {
        const int cond = u.pm < 16 ? 0 : (u.pm < 20 ? 1 : 2);
        const int row0 = u.pm * BM + wr * 64 + fr, col0 = u.pn * BM + wc * 32 + 4 * fq;
        const float* gp = gate + cond * 12288 + col0;
        f32x4 gv[2][2];
#pragma unroll
        for (int bj = 0; bj < 2; ++bj)
#pragma unroll
            for (int n = 0; n < 2; ++n) gv[bj][n] = *(const f32x4*)(gp + bj * HALF + n * 16);
#pragma unroll
        for (int ai = 0; ai < 2; ++ai)
#pragma unroll
            for (int m = 0; m < 4; ++m) { float* xp = X + (size_t)(row0 + ai * HALF + m * 16) * 2048 + col0;
#pragma unroll
                for (int bj = 0; bj < 2; ++bj)
#pragma unroll
                    for (int n = 0; n < 2; ++n) { f32x4 x = *(const f32x4*)(xp + bj * HALF + n * 16); x = x + gv[bj][n] * acc[ai][bj][m][n]; *(f32x4*)(xp + bj * HALF + n * 16) = x; } }
    }
};
template <int ACT> struct EpiAct {
    static constexpr bool PERM = true, AFTER_DRAIN = false;
    bf16_t* H; const float* bias; float* stats;
    __device__ __forceinline__ void operator()(const f32x4 (&acc)[2][2][4][2], const Unit& u, int wr, int wc, int fr, int fq) const {
        const int row0 = u.pm * BM + wr * 64 + fr, col0 = u.pn * BM + wc * 32 + 8 * fq;
        f32x4 bv[2][2];
#pragma unroll
        for (int bj = 0; bj < 2; ++bj)
#pragma unroll
            for (int n = 0; n < 2; ++n) bv[bj][n] = (ACT == 1) ? *(const f32x4*)(bias + col0 + bj * HALF + 4 * n) : (f32x4){0.f, 0.f, 0.f, 0.f};
#pragma unroll
        for (int ai = 0; ai < 2; ++ai)
#pragma unroll
            for (int m = 0; m < 4; ++m) { const int row = row0 + ai * HALF + m * 16; bf16_t* rowp = H + (size_t)row * 8192 + col0; float s1 = 0.f, s2 = 0.f;
#pragma unroll
                for (int bj = 0; bj < 2; ++bj) { f32x4 v0 = acc[ai][bj][m][0] + bv[bj][0], v1 = acc[ai][bj][m][1] + bv[bj][1];
#pragma unroll
                    for (int e = 0; e < 4; ++e) {
                        if (ACT == 0) { const float a = fmaxf(v0[e], 0.f), b = fmaxf(v1[e], 0.f); v0[e] = a * a; v1[e] = b * b; }
                        else { v0[e] = gelu_tanh(v0[e]); v1[e] = gelu_tanh(v1[e]); s1 += v0[e] + v1[e]; s2 += v0[e] * v0[e] + v1[e] * v1[e]; } }
                    *(u32x4*)(rowp + bj * HALF) = pack8(v0, v1); }
                if (ACT == 1) { if (u.pn >= 16) { s1 += __shfl_xor(s1, 16); s1 += __shfl_xor(s1, 32); s2 += __shfl_xor(s2, 16); s2 += __shfl_xor(s2, 32);
                    if (fq == 0) { typedef float f32x2 __attribute__((ext_vector_type(2))); *(f32x2*)(stats + (size_t)row * 128 + ((u.pn - 16) * 4 + wc) * 2) = (f32x2){s1, s2}; } } }
            }
    }
};

template <class Epi, class Sched, bool ALIGN_EPI = false, bool SP2 = false>
__device__ __forceinline__ void gemm_phase(PG8_LAS unsigned char* lds, const Gemm g, const Sched& S, const Epi& E) {
    const int tid = threadIdx.x, wid = __builtin_amdgcn_readfirstlane(tid >> 6), lane = tid & 63, wr = wid >> 2, wc = wid & 3, fr = lane & 15, fq = lane >> 4;
    const int K = g.K, nt = K / BK;
    unsigned voffA[2], voffB[2];
#pragma unroll
    for (int i = 0; i < 2; ++i) { int R, C; stage_rc(tid * 16 + i * 8192, R, C); const int Rb = Epi::PERM ? ((R & ~31) + perm32(R & 31)) : R;
        voffA[i] = (unsigned)(R * K + C) * 2u; voffB[i] = (unsigned)(Rb * K + C) * 2u; }
    const size_t kstep = (size_t)(BK * 2);
    const size_t hstep = (size_t)HALF * K * 2;
    const size_t tstep = 2 * hstep;
    const unsigned ldsw = (unsigned)wid * 1024u;
    const int aoff = lds_byte(wr * 64 + fr, fq * 8), boff = lds_byte(wc * 32 + fr, fq * 8);
#define PG8_SA(b, h) (((b) * 2 + (h)) * HTB)
#define PG8_SB(b, h) ((4 + (b) * 2 + (h)) * HTB)
#define PG8_STAGE(bufoff, gbase, voff) do { _Pragma("unroll") for (int _i = 0; _i < 2; ++_i) \
        __builtin_amdgcn_global_load_lds((const unsigned*)((const char*)(gbase) + (voff)[_i]), (PG8_LAS unsigned*)(lds + (bufoff) + ldsw + _i * 8192), 16, 0, 0); } while (0)
#define PG8_LDA(dst, b, h) do { _Pragma("unroll") for (int m = 0; m < 4; ++m) _Pragma("unroll") for (int k = 0; k < 2; ++k) dst[m][k] = *(const PG8_LAS bf16x8*)(lds + PG8_SA(b, h) + aoff + m * 2048 + k * 1024); } while (0)
#define PG8_LDB(dst, b, h) do { _Pragma("unroll") for (int n = 0; n < 2; ++n) _Pragma("unroll") for (int k = 0; k < 2; ++k) dst[n][k] = *(const PG8_LAS bf16x8*)(lds + PG8_SB(b, h) + boff + n * 2048 + k * 1024); } while (0)
#define PG8_MMA(ai, bj, At, Bt) do { __builtin_amdgcn_s_setprio(1); _Pragma("unroll") for (int m = 0; m < 4; ++m) _Pragma("unroll") for (int n = 0; n < 2; ++n) _Pragma("unroll") for (int k = 0; k < 2; ++k) \
        acc[ai][bj][m][n] = __builtin_amdgcn_mfma_f32_16x16x32_bf16(Bt[n][k], At[m][k], acc[ai][bj][m][n], 0, 0, 0); __builtin_amdgcn_s_setprio(0); } while (0)
#define PG8_WAIT_V(n) asm volatile("s_waitcnt vmcnt(" #n ")" ::: "memory")
#define PG8_WAIT_L(n) asm volatile("s_waitcnt lgkmcnt(" #n ")" ::: "memory")
#define PG8_BAR __builtin_amdgcn_s_barrier()
#define PG8_SCHED __builtin_amdgcn_sched_barrier(0)
    Unit cur, nxt; int ui = 0;
    if (!S.next(0, cur)) return;
    f32x4 acc[2][2][4][2];
#pragma unroll
    for (int a = 0; a < 2; ++a)
#pragma unroll
        for (int b = 0; b < 2; ++b)
#pragma unroll
            for (int m = 0; m < 4; ++m)
#pragma unroll
                for (int n = 0; n < 2; ++n) acc[a][b][m][n] = (f32x4){0.f, 0.f, 0.f, 0.f};
    bf16x8 At[4][2], B0[2][2], B1[2][2];
    const char* cA = (const char*)g.A + (size_t)cur.pm * tstep; const char* cB = (const char*)g.Bt + (size_t)cur.pn * tstep;
    S.a_ready(cur);
    if constexpr (SP2) {
        PG8_STAGE(PG8_SB(0, 0), cB, voffB); PG8_STAGE(PG8_SB(0, 1), cB + hstep, voffB); PG8_STAGE(PG8_SA(0, 0), cA, voffA); PG8_STAGE(PG8_SA(0, 1), cA + hstep, voffA);
        if (wr == 1) PG8_BAR;
        PG8_WAIT_V(2); PG8_BAR;
        PG8_STAGE(PG8_SB(1, 0), cB + kstep, voffB); PG8_STAGE(PG8_SA(1, 0), cA + kstep, voffA); PG8_STAGE(PG8_SB(1, 1), cB + hstep + kstep, voffB);
        PG8_WAIT_V(6); PG8_BAR;
    } else {
        PG8_STAGE(PG8_SB(0, 0), cB, voffB); PG8_STAGE(PG8_SA(0, 0), cA, voffA); PG8_STAGE(PG8_SB(0, 1), cB + hstep, voffB); PG8_STAGE(PG8_SA(0, 1), cA + hstep, voffA);
        if (wr == 1) PG8_BAR;
        PG8_WAIT_V(4); PG8_BAR;
        PG8_STAGE(PG8_SB(1, 0), cB + kstep, voffB); PG8_STAGE(PG8_SA(1, 0), cA + kstep, voffA); PG8_STAGE(PG8_SB(1, 1), cB + hstep + kstep, voffB);
        PG8_WAIT_V(6); PG8_BAR;
    }
    for (;;) {
        const bool has_next = S.next(ui + 1, nxt);
        const char* nA = has_next ? (const char*)g.A + (size_t)nxt.pm * tstep : cA; const char* nB = has_next ? (const char*)g.Bt + (size_t)nxt.pn * tstep : cB;
        for (int t = 0; t < nt; t += 2) {
            const bool last = (t == nt - 2);
            const char* a1 = cA + (size_t)(t + 1) * kstep;
            const char* a2 = last ? nA : cA + (size_t)(t + 2) * kstep; const char* b2 = last ? nB : cB + (size_t)(t + 2) * kstep;
            const char* a3 = a2 + kstep; const char* b3 = b2 + kstep;
            if (last && has_next) S.a_ready(nxt);
            if constexpr (SP2) {
            PG8_LDB(B0, 0, 0); PG8_LDB(B1, 0, 1); PG8_SCHED; PG8_LDA(At, 0, 0); PG8_STAGE(PG8_SA(1, 1), a1 + hstep, voffA);
            PG8_WAIT_V(8); PG8_WAIT_L(0); PG8_BAR; PG8_MMA(0, 0, At, B0); PG8_MMA(0, 1, At, B1); PG8_BAR; PG8_SCHED;
            PG8_LDA(At, 0, 1); PG8_STAGE(PG8_SB(0, 0), b2, voffB); PG8_STAGE(PG8_SB(0, 1), b2 + hstep, voffB); PG8_STAGE(PG8_SA(0, 0), a2, voffA);
            PG8_WAIT_V(8); PG8_WAIT_L(0); PG8_BAR; PG8_MMA(1, 0, At, B0); PG8_MMA(1, 1, At, B1); PG8_BAR; PG8_SCHED;
            PG8_LDB(B0, 1, 0); PG8_LDB(B1, 1, 1); PG8_SCHED; PG8_LDA(At, 1, 0); PG8_STAGE(PG8_SA(0, 1), a2 + hstep, voffA);
            PG8_WAIT_V(8); PG8_WAIT_L(0); PG8_BAR; PG8_MMA(0, 0, At, B0); PG8_MMA(0, 1, At, B1); PG8_BAR; PG8_SCHED;
            PG8_LDA(At, 1, 1); PG8_STAGE(PG8_SB(1, 0), b3, voffB); PG8_STAGE(PG8_SB(1, 1), b3 + hstep, voffB); PG8_STAGE(PG8_SA(1, 0), a3, voffA);
            PG8_WAIT_V(8); PG8_WAIT_L(0); PG8_BAR; PG8_MMA(1, 0, At, B0); PG8_MMA(1, 1, At, B1); PG8_BAR; PG8_SCHED;
            } else {
            PG8_LDB(B0, 0, 0); PG8_SCHED; PG8_LDA(At, 0, 0); PG8_STAGE(PG8_SA(1, 1), a1 + hstep, voffA);
            PG8_WAIT_L(8); PG8_BAR; PG8_WAIT_L(0); PG8_MMA(0, 0, At, B0); PG8_BAR; PG8_SCHED;
            PG8_LDB(B1, 0, 1); PG8_STAGE(PG8_SB(0, 0), b2, voffB);
            PG8_BAR; PG8_WAIT_L(0); PG8_MMA(0, 1, At, B1); PG8_BAR;
            PG8_LDA(At, 0, 1); PG8_STAGE(PG8_SA(0, 0), a2, voffA);
            PG8_BAR; PG8_WAIT_L(0); PG8_MMA(1, 0, At, B0); PG8_BAR; PG8_SCHED;
            PG8_STAGE(PG8_SB(0, 1), b2 + hstep, voffB);
            PG8_WAIT_V(6); PG8_BAR; PG8_MMA(1, 1, At, B1); PG8_BAR;
            PG8_LDB(B0, 1, 0); PG8_SCHED; PG8_LDA(At, 1, 0); PG8_STAGE(PG8_SA(0, 1), a2 + hstep, voffA);
            PG8_WAIT_L(8); PG8_BAR; PG8_WAIT_L(0); PG8_MMA(0, 0, At, B0); PG8_BAR; PG8_SCHED;
            PG8_LDB(B1, 1, 1); PG8_STAGE(PG8_SB(1, 0), b3, voffB);
            PG8_BAR; PG8_WAIT_L(0); PG8_MMA(0, 1, At, B1); PG8_BAR;
            PG8_LDA(At, 1, 1); PG8_STAGE(PG8_SA(1, 0), a3, voffA);
            PG8_BAR; PG8_WAIT_L(0); PG8_MMA(1, 0, At, B0); PG8_BAR; PG8_SCHED;
            PG8_STAGE(PG8_SB(1, 1), b3 + hstep, voffB);
            PG8_WAIT_V(6); PG8_BAR; PG8_MMA(1, 1, At, B1); PG8_BAR;
            }
        }
        if constexpr (ALIGN_EPI) { if (wr == 0) PG8_BAR; }
        if constexpr (!Epi::AFTER_DRAIN) { E(acc, cur, wr, wc, fr, fq); S.done(cur); }
        if (!has_next) break;
#pragma unroll
        for (int a = 0; a < 2; ++a)
#pragma unroll
            for (int b = 0; b < 2; ++b)
#pragma unroll
                for (int m = 0; m < 4; ++m)
#pragma unroll
                    for (int n = 0; n < 2; ++n) acc[a][b][m][n] = (f32x4){0.f, 0.f, 0.f, 0.f};
        cur = nxt; cA = nA; cB = nB; ++ui;
        if constexpr (ALIGN_EPI) { if (wr == 1) PG8_BAR; }
    }
    PG8_WAIT_V(0);
    if constexpr (!ALIGN_EPI) { if (wr == 0) PG8_BAR; }
    PG8_BAR;
    if constexpr (Epi::AFTER_DRAIN) { E.fused(acc, cur, wr, wc, fr, fq, lds, wid, lane); S.done(cur); }
#undef PG8_SA
#undef PG8_SB
#undef PG8_STAGE
#undef PG8_LDA
#undef PG8_LDB
#undef PG8_MMA
#undef PG8_WAIT_V
#undef PG8_WAIT_L
#undef PG8_BAR
#undef PG8_SCHED
}
}
#define LAS __attribute__((address_space(3)))
typedef unsigned short bf16;
typedef unsigned v4u __attribute__((ext_vector_type(4)));
typedef unsigned v2u __attribute__((ext_vector_type(2)));
typedef float f32x4 __attribute__((ext_vector_type(4)));
typedef float f32x2 __attribute__((ext_vector_type(2)));
typedef float f32x16 __attribute__((ext_vector_type(16)));
typedef short bf16x8 __attribute__((ext_vector_type(8)));

constexpr int NWAVES = 8;
constexpr int DM = 2048, MROWS = 6144;
constexpr int NPROJ = 12416, NPROJ_PAD = 12544;
constexpr int LDS_BYTES = 147456;
constexpr size_t MiB = 1u << 20;
constexpr size_t WS_CTL = 0, WS_MOD = 1 * MiB, WS_AB = 2 * MiB, WS_STATS = 6 * MiB, WS_VEC = 10 * MiB;
constexpr size_t WS_WIN = 16 * MiB, WS_WOUT = 65 * MiB, WS_WCMIN = 81 * MiB, WS_WCMOUT = 113 * MiB, WS_WFF1 = 129 * MiB, WS_WFF2 = 193 * MiB, WS_WSB = 257 * MiB;
constexpr size_t WS_X = 258 * MiB, WS_XN = 306 * MiB, WS_QKV = 330 * MiB  , WS_Z = 426 * MiB  ;
constexpr size_t WS_KA = 474 * MiB  , WS_QA = 498 * MiB, WS_KT = 522 * MiB, WS_VT = 546 * MiB, WS_TB = 594 * MiB, WS_IN = 642 * MiB, WS_END = 690 * MiB;
constexpr size_t OUT_SF = (size_t)MROWS * DM, OUT_SB = OUT_SF + (size_t)16 * 32 * 128 * 128;

struct Params { const float* in[26]; float* out; unsigned char* ws; int ph_lo, ph_hi, flags, pad; };

__device__ __forceinline__ unsigned f2bf(float f) { unsigned u = __builtin_bit_cast(unsigned, f); return (u + 0x7fffu + ((u >> 16) & 1u)) >> 16; }
__device__ __forceinline__ unsigned pk2(float lo, float hi) { return pg8::cvt_pk_bf16(lo, hi); }
__device__ __forceinline__ float bflo(unsigned u) { return __builtin_bit_cast(float, u << 16); }
__device__ __forceinline__ float bfhi(unsigned u) { return __builtin_bit_cast(float, u & 0xffff0000u); }
__device__ __forceinline__ float bf2f(bf16 b) { return __builtin_bit_cast(float, (unsigned)b << 16); }
__device__ __forceinline__ float wave_sum(float v) {
#pragma unroll
    for (int o = 1; o < 64; o <<= 1) v += __shfl_xor(v, o);
    return v;
}
__device__ __forceinline__ float silu_f(float x) { return x * __builtin_amdgcn_rcpf(1.0f + __expf(-x)); }
#define LDS_WAIT() asm volatile("s_waitcnt lgkmcnt(0)" ::: "memory")

__device__ __forceinline__ void transpose_item(const float* W, int K, int N, bf16* WT, LAS float* scr, int item, int lane) {
    const int nblk = N >> 6, kb = item / nblk, nb = item - kb * nblk, k0 = kb * 64, n0 = nb * 64;
    const float* src = W + (size_t)k0 * N + n0 + lane;
#pragma unroll 16
    for (int i = 0; i < 64; ++i) scr[i * 65 + lane] = src[(size_t)i * N];
    LDS_WAIT();
    const int c = lane & 7;
#pragma unroll
    for (int j = 0; j < 8; ++j) { const int n = (lane >> 3) + 8 * j; const LAS float* s = scr + (8 * c) * 65 + n;
        v4u o; o.x = pk2(s[0 * 65], s[1 * 65]); o.y = pk2(s[2 * 65], s[3 * 65]); o.z = pk2(s[4 * 65], s[5 * 65]); o.w = pk2(s[6 * 65], s[7 * 65]);
        *(v4u*)(WT + (size_t)(n0 + n) * K + k0 + 8 * c) = o; }
    LDS_WAIT();
}
__device__ __forceinline__ void phase_prologue(const Params& p, LAS unsigned char* lds, int tid, int lane, int wave, int vcu, int G) {
    unsigned char* ws = p.ws;
    {
        LAS float* sc = (LAS float*)lds; LAS float* red = sc + 3 * 2048;
        for (int i = tid; i < 3 * 2048; i += 512) { const int cnd = i >> 11, k = i & 2047; const float x = cnd == 0 ? p.in[5][k] : p.in[4][(cnd - 1) * 2048 + k]; sc[i] = silu_f(x); }
        __syncthreads();
        float* MOD = (float*)(ws + WS_MOD);
        for (int strip = vcu; strip < 256; strip += G) {
            const int l = strip >> 7, n0 = (strip & 127) * 96;
            if (tid < 504) {
                const int cl = tid % 24, g = tid / 24;
                const float* W = p.in[8] + (size_t)l * 2048 * 12288 + n0 + 4 * cl;
                f32x4 a0 = {0.f, 0.f, 0.f, 0.f}, a1 = a0, a2 = a0;
#pragma unroll 7
                for (int k = g; k < 2048; k += 21) { const f32x4 w = *(const f32x4*)(W + (size_t)k * 12288); a0 += w * sc[k]; a1 += w * sc[2048 + k]; a2 += w * sc[4096 + k]; }
                LAS float* r = red + g * 288 + 4 * cl;
                *(LAS f32x4*)(r) = a0; *(LAS f32x4*)(r + 96) = a1; *(LAS f32x4*)(r + 192) = a2;
            }
            __syncthreads();
            if (tid < 288) { float s = 0.f;
#pragma unroll
                for (int g = 0; g < 21; ++g) s += red[g * 288 + tid];
                const int cnd = tid / 96, c = tid % 96; MOD[(l * 3 + cnd) * 12288 + n0 + c] = s + p.in[9][l * 12288 + n0 + c]; }
            __syncthreads();
        }
    }
    {
        LAS float* scr = (LAS float*)(lds + wave * 16640);
        const int gw = vcu * NWAVES + wave, NGW = G * NWAVES;
        constexpr int I0 = 32 * 194, I1 = 64 * 32, I2 = 32 * 128, I3 = 64 * 32, I4 = 32 * 128, I6 = 128 * 32;
        constexpr int NITEMS = I0 + I1 + I2 + I3 + 2 * I4 + 2 * I6;
        for (int it = gw; it < NITEMS; it += NGW) {
            int r = it;
            if (r < I0) { transpose_item(p.in[10], 2048, NPROJ, (bf16*)(ws + WS_WIN), scr, r, lane); continue; } r -= I0;
            if (r < I1) { transpose_item(p.in[15], 4096, 2048, (bf16*)(ws + WS_WOUT), scr, r, lane); continue; } r -= I1;
            if (r < I2) { transpose_item(p.in[16], 2048, 8192, (bf16*)(ws + WS_WCMIN), scr, r, lane); continue; } r -= I2;
            if (r < I3) { transpose_item(p.in[22], 4096, 2048, (bf16*)(ws + WS_WCMOUT), scr, r, lane); continue; } r -= I3;
            if (r < 2 * I4) { const int l = r / I4; transpose_item(p.in[23] + (size_t)l * 2048 * 8192, 2048, 8192, (bf16*)(ws + WS_WFF1) + (size_t)l * 2048 * 8192, scr, r - l * I4, lane); continue; } r -= 2 * I4;
            { const int l = r / I6; transpose_item(p.in[24] + (size_t)l * 2048 * 8192, 8192, 2048, (bf16*)(ws + WS_WFF2) + (size_t)l * 2048 * 8192, scr, r - l * I6, lane); }
        }
    }
    {
        const int gt = vcu * 512 + tid, NT = G * 512;
        const float* wsf = p.in[20]; v4u* dst = (v4u*)(ws + WS_WSB);
        for (int i = gt; i < 32768; i += NT) { const f32x4 a = *(const f32x4*)(wsf + 8 * i), b = *(const f32x4*)(wsf + 8 * i + 4); v4u o; o.x = pk2(a[0], a[1]); o.y = pk2(a[2], a[3]); o.z = pk2(b[0], b[1]); o.w = pk2(b[2], b[3]); dst[i] = o; }
        v4u* pad = (v4u*)((bf16*)(ws + WS_WIN) + (size_t)NPROJ * 2048);
        for (int i = gt; i < 32768; i += NT) pad[i] = (v4u){0u, 0u, 0u, 0u};
    }
}

template <int MODE>
__device__ __forceinline__ void phase_norm(const Params& p, int layer, int which, int lane, int wave, int vcu, int G) {
    unsigned char* ws = p.ws; float* X = (float*)(ws + WS_X); bf16* XN = (bf16*)(ws + WS_XN); const float* MOD = (const float*)(ws + WS_MOD);
    const int gw = vcu * NWAVES + wave, NGW = G * NWAVES;
    for (int row = gw; row < MROWS; row += NGW) {
        f32x4 v[8];
        const float* src = MODE == 0 ? (row < 4096 ? p.in[0] + (size_t)row * DM : p.in[1] + (size_t)(row - 4096) * DM) : X + (size_t)row * DM;
#pragma unroll
        for (int j = 0; j < 8; ++j) v[j] = *(const f32x4*)(src + 4 * (lane + 64 * j));
        if (MODE == 0) {
            if (row >= 4096) {
                const int pos = (row - 4096) & 1023; const float gr = (float)(pos >> 6), gc = (float)(pos & 63);
#pragma unroll
                for (int j = 0; j < 8; ++j) { const float base = (j >> 1) < 2 ? gr : gc;
#pragma unroll
                    for (int e = 0; e < 4; ++e) { const int i = (4 * (lane + 64 * j) + e) & 511; const float fr = expf(-(float)i * (9.210340371976184f / 512.0f)); const float ang = base * fr;
                        v[j][e] += ((j >> 1) & 1) ? cosf(ang) : sinf(ang); } }
            }
#pragma unroll
            for (int j = 0; j < 8; ++j) *(f32x4*)(X + (size_t)row * DM + 4 * (lane + 64 * j)) = v[j];
        }
        float ss = 0.f;
#pragma unroll
        for (int j = 0; j < 8; ++j) ss += (v[j][0] * v[j][0] + v[j][1] * v[j][1]) + (v[j][2] * v[j][2] + v[j][3] * v[j][3]);
        ss = wave_sum(ss);
        const float r = 1.0f / sqrtf(ss * (1.0f / DM) + 1e-6f);
        if (MODE == 2) {
#pragma unroll
            for (int j = 0; j < 8; ++j) { const f32x4 w = *(const f32x4*)(p.in[25] + 4 * (lane + 64 * j)); f32x4 y = v[j] * r * w;
#ifdef PROBE_A_LO
                { const unsigned long long* TS = (const unsigned long long*)(ws + WS_CTL + 1024);
                  const float ta = (float)(long long)(__hip_atomic_load(TS + PROBE_A_HI, __ATOMIC_RELAXED, __HIP_MEMORY_SCOPE_AGENT) - __hip_atomic_load(TS + PROBE_A_LO, __ATOMIC_RELAXED, __HIP_MEMORY_SCOPE_AGENT)) * 0.01f;
                  const float tb = (float)(long long)(__hip_atomic_load(TS + PROBE_B_HI, __ATOMIC_RELAXED, __HIP_MEMORY_SCOPE_AGENT) - __hip_atomic_load(TS + PROBE_B_LO, __ATOMIC_RELAXED, __HIP_MEMORY_SCOPE_AGENT)) * 0.01f;
                  if (row < 4096) y = y * (1.0f + ta * 1e-4f);
                  if (row == 4096 && j == 0 && lane == 0) y[0] += tb * 0.01f; }
#endif
                *(f32x4*)(p.out + (size_t)row * DM + 4 * (lane + 64 * j)) = y; }
        } else {
            const int cond = row < 4096 ? 0 : (row < 5120 ? 1 : 2);
            const float* nw = p.in[which ? 7 : 6] + layer * DM; const float* mb = MOD + (size_t)(layer * 3 + cond) * 12288 + (which ? 6144 : 0);
#pragma unroll
            for (int j = 0; j < 8; ++j) { const int c = 4 * (lane + 64 * j); const f32x4 w = *(const f32x4*)(nw + c), sh = *(const f32x4*)(mb + c), sc = *(const f32x4*)(mb + 2048 + c);
                const f32x4 y = v[j] * r * w * (sc + 1.0f) + sh; v2u o; o.x = pk2(y[0], y[1]); o.y = pk2(y[2], y[3]); *(v2u*)(XN + (size_t)row * DM + c) = o; }
        }
    }
}

__device__ __forceinline__ bf16x8 as_frag(const v4u v) { return __builtin_bit_cast(bf16x8, v); }
__device__ __forceinline__ v4u pack8f(const f32x4 a, const f32x4 b) { v4u o; o.x = pk2(a[0], a[1]); o.y = pk2(a[2], a[3]); o.z = pk2(b[0], b[1]); o.w = pk2(b[2], b[3]); return o; }
#define MFMA16(a, b, c) __builtin_amdgcn_mfma_f32_16x16x32_bf16((a), (b), (c), 0, 0, 0)

#define INV_LD(i, j) (*(const LAS f32x4*)(As + (i) * 68 + 4 * (j)))
#define INV_SB() __builtin_amdgcn_sched_barrier(0)
__device__ __forceinline__ void tri_inverse_64(LAS float* As, const int lane) {
    f32x4 pa0, pa1, pa2, pa3, pa4, pa5, pa6, pa7, pb0, pb1, pb2, pb3, pb4, pb5, pb6, pb7, l0, l1, l2, l3, l4, l5, l6, l7;
    float x0, x1, x2, x3, x4, x5, x6, x7, x8, x9, x10, x11, x12, x13, x14, x15, x16, x17, x18, x19, x20, x21, x22, x23, x24, x25, x26, x27, x28, x29, x30, x31, x32, x33, x34, x35, x36, x37, x38, x39, x40, x41, x42, x43, x44, x45, x46, x47, x48, x49, x50, x51, x52, x53, x54, x55, x56, x57, x58, x59, x60, x61, x62, x63;
    { int li = lane; asm volatile("" : "+v"(li)); x0 = (li == 0) ? 1.f : 0.f; }
    pb0 = INV_LD(1, 0);
    pa0 = INV_LD(2, 0); INV_SB();
    { int li = lane; asm volatile("" : "+v"(li)); float a0 = (li == 1) ? 1.f : 0.f, a1 = 0.f, a2 = 0.f, a3 = 0.f; a0 -= pb0[0] * x0; x1 = (a0 + a1) + (a2 + a3); } INV_SB();
    pb0 = INV_LD(3, 0); INV_SB();
    { int li = lane; asm volatile("" : "+v"(li)); float a0 = (li == 2) ? 1.f : 0.f, a1 = 0.f, a2 = 0.f, a3 = 0.f; a0 -= pa0[0] * x0; a1 -= pa0[1] * x1; x2 = (a0 + a1) + (a2 + a3); } INV_SB();
    pa0 = INV_LD(4, 0); INV_SB();
    { int li = lane; asm volatile("" : "+v"(li)); float a0 = (li == 3) ? 1.f : 0.f, a1 = 0.f, a2 = 0.f, a3 = 0.f; a0 -= pb0[0] * x0; a1 -= pb0[1] * x1; a2 -= pb0[2] * x2; x3 = (a0 + a1) + (a2 + a3); } INV_SB();
    pb0 = INV_LD(5, 0); pb1 = INV_LD(5, 1); INV_SB();
    { int li = lane; asm volatile("" : "+v"(li)); float a0 = (li == 4) ? 1.f : 0.f, a1 = 0.f, a2 = 0.f, a3 = 0.f; a0 -= pa0[0] * x0; a1 -= pa0[1] * x1; a2 -= pa0[2] * x2; a3 -= pa0[3] * x3; x4 = (a0 + a1) + (a2 + a3); } INV_SB();
    pa0 = INV_LD(6, 0); pa1 = INV_LD(6, 1); INV_SB();
    { int li = lane; asm volatile("" : "+v"(li)); float a0 = (li == 5) ? 1.f : 0.f, a1 = 0.f, a2 = 0.f, a3 = 0.f; a0 -= pb0[0] * x0; a1 -= pb0[1] * x1; a2 -= pb0[2] * x2; a3 -= pb0[3] * x3; a0 -= pb1[0] * x4; x5 = (a0 + a1) + (a2 + a3); } INV_SB();
    pb0 = INV_LD(7, 0); pb1 = INV_LD(7, 1); INV_SB();
    { int li = lane; asm volatile("" : "+v"(li)); float a0 = (li == 6) ? 1.f : 0.f, a1 = 0.f, a2 = 0.f, a3 = 0.f; a0 -= pa0[0] * x0; a1 -= pa0[1] * x1; a2 -= pa0[2] * x2; a3 -= pa0[3] * x3; a0 -= pa1[0] * x4; a1 -= pa1[1] * x5; x6 = (a0 + a1) + (a2 + a3); } INV_SB();
    pa0 = INV_LD(8, 0); pa1 = INV_LD(8, 1); INV_SB();
    { int li = lane; asm volatile("" : "+v"(li)); float a0 = (li == 7) ? 1.f : 0.f, a1 = 0.f, a2 = 0.f, a3 = 0.f; a0 -= pb0[0] * x0; a1 -= pb0[1] * x1; a2 -= pb0[2] * x2; a3 -= pb0[3] * x3; a0 -= pb1[0] * x4; a1 -= pb1[1] * x5; a2 -= pb1[2] * x6; x7 = (a0 + a1) + (a2 + a3); } INV_SB();
    pb0 = INV_LD(9, 0); pb1 = INV_LD(9, 1); pb2 = INV_LD(9, 2); INV_SB();
    { int li = lane; asm volatile("" : "+v"(li)); float a0 = (li == 8) ? 1.f : 0.f, a1 = 0.f, a2 = 0.f, a3 = 0.f; a0 -= pa0[0] * x0; a1 -= pa0[1] * x1; a2 -= pa0[2] * x2; a3 -= pa0[3] * x3; a0 -= pa1[0] * x4; a1 -= pa1[1] * x5; a2 -= pa1[2] * x6; a3 -= pa1[3] * x7; x8 = (a0 + a1) + (a2 + a3); } INV_SB();
    pa0 = INV_LD(10, 0); pa1 = INV_LD(10, 1); pa2 = INV_LD(10, 2); INV_SB();
    { int li = lane; asm volatile("" : "+v"(li)); float a0 = (li == 9) ? 1.f : 0.f, a1 = 0.f, a2 = 0.f, a3 = 0.f; a0 -= pb0[0] * x0; a1 -= pb0[1] * x1; a2 -= pb0[2] * x2; a3 -= pb0[3] * x3; a0 -= pb1[0] * x4; a1 -= pb1[1] * x5; a2 -= pb1[2] * x6; a3 -= pb1[3] * x7; a0 -= pb2[0] * x8; x9 = (a0 + a1) + (a2 + a3); } INV_SB();
    pb0 = INV_LD(11, 0); pb1 = INV_LD(11, 1); pb2 = INV_LD(11, 2); INV_SB();
    { int li = lane; asm volatile("" : "+v"(li)); float a0 = (li == 10) ? 1.f : 0.f, a1 = 0.f, a2 = 0.f, a3 = 0.f; a0 -= pa0[0] * x0; a1 -= pa0[1] * x1; a2 -= pa0[2] * x2; a3 -= pa0[3] * x3; a0 -= pa1[0] * x4; a1 -= pa1[1] * x5; a2 -= pa1[2] * x6; a3 -= pa1[3] * x7; a0 -= pa2[0] * x8; a1 -= pa2[1] * x9; x10 = (a0 + a1) + (a2 + a3); } INV_SB();
    pa0 = INV_LD(12, 0); pa1 = INV_LD(12, 1); pa2 = INV_LD(12, 2); INV_SB();
    { int li = lane; asm volatile("" : "+v"(li)); float a0 = (li == 11) ? 1.f : 0.f, a1 = 0.f, a2 = 0.f, a3 = 0.f; a0 -= pb0[0] * x0; a1 -= pb0[1] * x1; a2 -= pb0[2] * x2; a3 -= pb0[3] * x3; a0 -= pb1[0] * x4; a1 -= pb1[1] * x5; a2 -= pb1[2] * x6; a3 -= pb1[3] * x7; a0 -= pb2[0] * x8; a1 -= pb2[1] * x9; a2 -= pb2[2] * x10; x11 = (a0 + a1) + (a2 + a3); } INV_SB();
    pb0 = INV_LD(13, 0); pb1 = INV_LD(13, 1); pb2 = INV_LD(13, 2); pb3 = INV_LD(13, 3); INV_SB();
    { int li = lane; asm volatile("" : "+v"(li)); float a0 = (li == 12) ? 1.f : 0.f, a1 = 0.f, a2 = 0.f, a3 = 0.f; a0 -= pa0[0] * x0; a1 -= pa0[1] * x1; a2 -= pa0[2] * x2; a3 -= pa0[3] * x3; a0 -= pa1[0] * x4; a1 -= pa1[1] * x5; a2 -= pa1[2] * x6; a3 -= pa1[3] * x7; a0 -= pa2[0] * x8; a1 -= pa2[1] * x9; a2 -= pa2[2] * x10; a3 -= pa2[3] * x11; x12 = (a0 + a1) + (a2 + a3); } INV_SB();
    pa0 = INV_LD(14, 0); pa1 = INV_LD(14, 1); pa2 = INV_LD(14, 2); pa3 = INV_LD(14, 3); INV_SB();
    { int li = lane; asm volatile("" : "+v"(li)); float a0 = (li == 13) ? 1.f : 0.f, a1 = 0.f, a2 = 0.f, a3 = 0.f; a0 -= pb0[0] * x0; a1 -= pb0[1] * x1; a2 -= pb0[2] * x2; a3 -= pb0[3] * x3; a0 -= pb1[0] * x4; a1 -= pb1[1] * x5; a2 -= pb1[2] * x6; a3 -= pb1[3] * x7; a0 -= pb2[0] * x8; a1 -= pb2[1] * x9; a2 -= pb2[2] * x10; a3 -= pb2[3] * x11; a0 -= pb3[0] * x12; x13 = (a0 + a1) + (a2 + a3); } INV_SB();
    pb0 = INV_LD(15, 0); pb1 = INV_LD(15, 1); pb2 = INV_LD(15, 2); pb3 = INV_LD(15, 3); INV_SB();
    { int li = lane; asm volatile("" : "+v"(li)); float a0 = (li == 14) ? 1.f : 0.f, a1 = 0.f, a2 = 0.f, a3 = 0.f; a0 -= pa0[0] * x0; a1 -= pa0[1] * x1; a2 -= pa0[2] * x2; a3 -= pa0[3] * x3; a0 -= pa1[0] * x4; a1 -= pa1[1] * x5; a2 -= pa1[2] * x6; a3 -= pa1[3] * x7; a0 -= pa2[0] * x8; a1 -= pa2[1] * x9; a2 -= pa2[2] * x10; a3 -= pa2[3] * x11; a0 -= pa3[0] * x12; a1 -= pa3[1] * x13; x14 = (a0 + a1) + (a2 + a3); } INV_SB();
    pa0 = INV_LD(16, 0); pa1 = INV_LD(16, 1); pa2 = INV_LD(16, 2); pa3 = INV_LD(16, 3); INV_SB();
    { int li = lane; asm volatile("" : "+v"(li)); float a0 = (li == 15) ? 1.f : 0.f, a1 = 0.f, a2 = 0.f, a3 = 0.f; a0 -= pb0[0] * x0; a1 -= pb0[1] * x1; a2 -= pb0[2] * x2; a3 -= pb0[3] * x3; a0 -= pb1[0] * x4; a1 -= pb1[1] * x5; a2 -= pb1[2] * x6; a3 -= pb1[3] * x7; a0 -= pb2[0] * x8; a1 -= pb2[1] * x9; a2 -= pb2[2] * x10; a3 -= pb2[3] * x11; a0 -= pb3[0] * x12; a1 -= pb3[1] * x13; a2 -= pb3[2] * x14; x15 = (a0 + a1) + (a2 + a3); } INV_SB();
    pb0 = INV_LD(17, 0); pb1 = INV_LD(17, 1); pb2 = INV_LD(17, 2); pb3 = INV_LD(17, 3); pb4 = INV_LD(17, 4); INV_SB();
    { int li = lane; asm volatile("" : "+v"(li)); float a0 = (li == 16) ? 1.f : 0.f, a1 = 0.f, a2 = 0.f, a3 = 0.f; a0 -= pa0[0] * x0; a1 -= pa0[1] * x1; a2 -= pa0[2] * x2; a3 -= pa0[3] * x3; a0 -= pa1[0] * x4; a1 -= pa1[1] * x5; a2 -= pa1[2] * x6; a3 -= pa1[3] * x7; a0 -= pa2[0] * x8; a1 -= pa2[1] * x9; a2 -= pa2[2] * x10; a3 -= pa2[3] * x11; a0 -= pa3[0] * x12; a1 -= pa3[1] * x13; a2 -= pa3[2] * x14; a3 -= pa3[3] * x15; x16 = (a0 + a1) + (a2 + a3); } INV_SB();
    pa0 = INV_LD(18, 0); pa1 = INV_LD(18, 1); pa2 = INV_LD(18, 2); pa3 = INV_LD(18, 3); pa4 = INV_LD(18, 4); INV_SB();
    { int li = lane; asm volatile("" : "+v"(li)); float a0 = (li == 17) ? 1.f : 0.f, a1 = 0.f, a2 = 0.f, a3 = 0.f; a0 -= pb0[0] * x0; a1 -= pb0[1] * x1; a2 -= pb0[2] * x2; a3 -= pb0[3] * x3; a0 -= pb1[0] * x4; a1 -= pb1[1] * x5; a2 -= pb1[2] * x6; a3 -= pb1[3] * x7; a0 -= pb2[0] * x8; a1 -= pb2[1] * x9; a2 -= pb2[2] * x10; a3 -= pb2[3] * x11; a0 -= pb3[0] * x12; a1 -= pb3[1] * x13; a2 -= pb3[2] * x14; a3 -= pb3[3] * x15; a0 -= pb4[0] * x16; x17 = (a0 + a1) + (a2 + a3); } INV_SB();
    pb0 = INV_LD(19, 0); pb1 = INV_LD(19, 1); pb2 = INV_LD(19, 2); pb3 = INV_LD(19, 3); pb4 = INV_LD(19, 4); INV_SB();
    { int li = lane; asm volatile("" : "+v"(li)); float a0 = (li == 18) ? 1.f : 0.f, a1 = 0.f, a2 = 0.f, a3 = 0.f; a0 -= pa0[0] * x0; a1 -= pa0[1] * x1; a2 -= pa0[2] * x2; a3 -= pa0[3] * x3; a0 -= pa1[0] * x4; a1 -= pa1[1] * x5; a2 -= pa1[2] * x6; a3 -= pa1[3] * x7; a0 -= pa2[0] * x8; a1 -= pa2[1] * x9; a2 -= pa2[2] * x10; a3 -= pa2[3] * x11; a0 -= pa3[0] * x12; a1 -= pa3[1] * x13; a2 -= pa3[2] * x14; a3 -= pa3[3] * x15; a0 -= pa4[0] * x16; a1 -= pa4[1] * x17; x18 = (a0 + a1) + (a2 + a3); } INV_SB();
    pa0 = INV_LD(20, 0); pa1 = INV_LD(20, 1); pa2 = INV_LD(20, 2); pa3 = INV_LD(20, 3); pa4 = INV_LD(20, 4); INV_SB();
    { int li = lane; asm volatile("" : "+v"(li)); float a0 = (li == 19) ? 1.f : 0.f, a1 = 0.f, a2 = 0.f, a3 = 0.f; a0 -= pb0[0] * x0; a1 -= pb0[1] * x1; a2 -= pb0[2] * x2; a3 -= pb0[3] * x3; a0 -= pb1[0] * x4; a1 -= pb1[1] * x5; a2 -= pb1[2] * x6; a3 -= pb1[3] * x7; a0 -= pb2[0] * x8; a1 -= pb2[1] * x9; a2 -= pb2[2] * x10; a3 -= pb2[3] * x11; a0 -= pb3[0] * x12; a1 -= pb3[1] * x13; a2 -= pb3[2] * x14; a3 -= pb3[3] * x15; a0 -= pb4[0] * x16; a1 -= pb4[1] * x17; a2 -= pb4[2] * x18; x19 = (a0 + a1) + (a2 + a3); } INV_SB();
    pb0 = INV_LD(21, 0); pb1 = INV_LD(21, 1); pb2 = INV_LD(21, 2); pb3 = INV_LD(21, 3); pb4 = INV_LD(21, 4); pb5 = INV_LD(21, 5); INV_SB();
    { int li = lane; asm volatile("" : "+v"(li)); float a0 = (li == 20) ? 1.f : 0.f, a1 = 0.f, a2 = 0.f, a3 = 0.f; a0 -= pa0[0] * x0; a1 -= pa0[1] * x1; a2 -= pa0[2] * x2; a3 -= pa0[3] * x3; a0 -= pa1[0] * x4; a1 -= pa1[1] * x5; a2 -= pa1[2] * x6; a3 -= pa1[3] * x7; a0 -= pa2[0] * x8; a1 -= pa2[1] * x9; a2 -= pa2[2] * x10; a3 -= pa2[3] * x11; a0 -= pa3[0] * x12; a1 -= pa3[1] * x13; a2 -= pa3[2] * x14; a3 -= pa3[3] * x15; a0 -= pa4[0] * x16; a1 -= pa4[1] * x17; a2 -= pa4[2] * x18; a3 -= pa4[3] * x19; x20 = (a0 + a1) + (a2 + a3); } INV_SB();
    pa0 = INV_LD(22, 0); pa1 = INV_LD(22, 1); pa2 = INV_LD(22, 2); pa3 = INV_LD(22, 3); pa4 = INV_LD(22, 4); pa5 = INV_LD(22, 5); INV_SB();
    { int li = lane; asm volatile("" : "+v"(li)); float a0 = (li == 21) ? 1.f : 0.f, a1 = 0.f, a2 = 0.f, a3 = 0.f; a0 -= pb0[0] * x0; a1 -= pb0[1] * x1; a2 -= pb0[2] * x2; a3 -= pb0[3] * x3; a0 -= pb1[0] * x4; a1 -= pb1[1] * x5; a2 -= pb1[2] * x6; a3 -= pb1[3] * x7; a0 -= pb2[0] * x8; a1 -= pb2[1] * x9; a2 -= pb2[2] * x10; a3 -= pb2[3] * x11; a0 -= pb3[0] * x12; a1 -= pb3[1] * x13; a2 -= pb3[2] * x14; a3 -= pb3[3] * x15; a0 -= pb4[0] * x16; a1 -= pb4[1] * x17; a2 -= pb4[2] * x18; a3 -= pb4[3] * x19; a0 -= pb5[0] * x20; x21 = (a0 + a1) + (a2 + a3); } INV_SB();
    pb0 = INV_LD(23, 0); pb1 = INV_LD(23, 1); pb2 = INV_LD(23, 2); pb3 = INV_LD(23, 3); pb4 = INV_LD(23, 4); pb5 = INV_LD(23, 5); INV_SB();
    { int li = lane; asm volatile("" : "+v"(li)); float a0 = (li == 22) ? 1.f : 0.f, a1 = 0.f, a2 = 0.f, a3 = 0.f; a0 -= pa0[0] * x0; a1 -= pa0[1] * x1; a2 -= pa0[2] * x2; a3 -= pa0[3] * x3; a0 -= pa1[0] * x4; a1 -= pa1[1] * x5; a2 -= pa1[2] * x6; a3 -= pa1[3] * x7; a0 -= pa2[0] * x8; a1 -= pa2[1] * x9; a2 -= pa2[2] * x10; a3 -= pa2[3] * x11; a0 -= pa3[0] * x12; a1 -= pa3[1] * x13; a2 -= pa3[2] * x14; a3 -= pa3[3] * x15; a0 -= pa4[0] * x16; a1 -= pa4[1] * x17; a2 -= pa4[2] * x18; a3 -= pa4[3] * x19; a0 -= pa5[0] * x20; a1 -= pa5[1] * x21; x22 = (a0 + a1) + (a2 + a3); } INV_SB();
    pa0 = INV_LD(24, 0); pa1 = INV_LD(24, 1); pa2 = INV_LD(24, 2); pa3 = INV_LD(24, 3); pa4 = INV_LD(24, 4); pa5 = INV_LD(24, 5); INV_SB();
    { int li = lane; asm volatile("" : "+v"(li)); float a0 = (li == 23) ? 1.f : 0.f, a1 = 0.f, a2 = 0.f, a3 = 0.f; a0 -= pb0[0] * x0; a1 -= pb0[1] * x1; a2 -= pb0[2] * x2; a3 -= pb0[3] * x3; a0 -= pb1[0] * x4; a1 -= pb1[1] * x5; a2 -= pb1[2] * x6; a3 -= pb1[3] * x7; a0 -= pb2[0] * x8; a1 -= pb2[1] * x9; a2 -= pb2[2] * x10; a3 -= pb2[3] * x11; a0 -= pb3[0] * x12; a1 -= pb3[1] * x13; a2 -= pb3[2] * x14; a3 -= pb3[3] * x15; a0 -= pb4[0] * x16; a1 -= pb4[1] * x17; a2 -= pb4[2] * x18; a3 -= pb4[3] * x19; a0 -= pb5[0] * x20; a1 -= pb5[1] * x21; a2 -= pb5[2] * x22; x23 = (a0 + a1) + (a2 + a3); } INV_SB();
    pb0 = INV_LD(25, 0); pb1 = INV_LD(25, 1); pb2 = INV_LD(25, 2); pb3 = INV_LD(25, 3); pb4 = INV_LD(25, 4); pb5 = INV_LD(25, 5); pb6 = INV_LD(25, 6); INV_SB();
    { int li = lane; asm volatile("" : "+v"(li)); float a0 = (li == 24) ? 1.f : 0.f, a1 = 0.f, a2 = 0.f, a3 = 0.f; a0 -= pa0[0] * x0; a1 -= pa0[1] * x1; a2 -= pa0[2] * x2; a3 -= pa0[3] * x3; a0 -= pa1[0] * x4; a1 -= pa1[1] * x5; a2 -= pa1[2] * x6; a3 -= pa1[3] * x7; a0 -= pa2[0] * x8; a1 -= pa2[1] * x9; a2 -= pa2[2] * x10; a3 -= pa2[3] * x11; a0 -= pa3[0] * x12; a1 -= pa3[1] * x13; a2 -= pa3[2] * x14; a3 -= pa3[3] * x15; a0 -= pa4[0] * x16; a1 -= pa4[1] * x17; a2 -= pa4[2] * x18; a3 -= pa4[3] * x19; a0 -= pa5[0] * x20; a1 -= pa5[1] * x21; a2 -= pa5[2] * x22; a3 -= pa5[3] * x23; x24 = (a0 + a1) + (a2 + a3); } INV_SB();
    pa0 = INV_LD(26, 0); pa1 = INV_LD(26, 1); pa2 = INV_LD(26, 2); pa3 = INV_LD(26, 3); pa4 = INV_LD(26, 4); pa5 = INV_LD(26, 5); pa6 = INV_LD(26, 6); INV_SB();
    { int li = lane; asm volatile("" : "+v"(li)); float a0 = (li == 25) ? 1.f : 0.f, a1 = 0.f, a2 = 0.f, a3 = 0.f; a0 -= pb0[0] * x0; a1 -= pb0[1] * x1; a2 -= pb0[2] * x2; a3 -= pb0[3] * x3; a0 -= pb1[0] * x4; a1 -= pb1[1] * x5; a2 -= pb1[2] * x6; a3 -= pb1[3] * x7; a0 -= pb2[0] * x8; a1 -= pb2[1] * x9; a2 -= pb2[2] * x10; a3 -= pb2[3] * x11; a0 -= pb3[0] * x12; a1 -= pb3[1] * x13; a2 -= pb3[2] * x14; a3 -= pb3[3] * x15; a0 -= pb4[0] * x16; a1 -= pb4[1] * x17; a2 -= pb4[2] * x18; a3 -= pb4[3] * x19; a0 -= pb5[0] * x20; a1 -= pb5[1] * x21; a2 -= pb5[2] * x22; a3 -= pb5[3] * x23; a0 -= pb6[0] * x24; x25 = (a0 + a1) + (a2 + a3); } INV_SB();
    pb0 = INV_LD(27, 0); pb1 = INV_LD(27, 1); pb2 = INV_LD(27, 2); pb3 = INV_LD(27, 3); pb4 = INV_LD(27, 4); pb5 = INV_LD(27, 5); pb6 = INV_LD(27, 6); INV_SB();
    { int li = lane; asm volatile("" : "+v"(li)); float a0 = (li == 26) ? 1.f : 0.f, a1 = 0.f, a2 = 0.f, a3 = 0.f; a0 -= pa0[0] * x0; a1 -= pa0[1] * x1; a2 -= pa0[2] * x2; a3 -= pa0[3] * x3; a0 -= pa1[0] * x4; a1 -= pa1[1] * x5; a2 -= pa1[2] * x6; a3 -= pa1[3] * x7; a0 -= pa2[0] * x8; a1 -= pa2[1] * x9; a2 -= pa2[2] * x10; a3 -= pa2[3] * x11; a0 -= pa3[0] * x12; a1 -= pa3[1] * x13; a2 -= pa3[2] * x14; a3 -= pa3[3] * x15; a0 -= pa4[0] * x16; a1 -= pa4[1] * x17; a2 -= pa4[2] * x18; a3 -= pa4[3] * x19; a0 -= pa5[0] * x20; a1 -= pa5[1] * x21; a2 -= pa5[2] * x22; a3 -= pa5[3] * x23; a0 -= pa6[0] * x24; a1 -= pa6[1] * x25; x26 = (a0 + a1) + (a2 + a3); } INV_SB();
    pa0 = INV_LD(28, 0); pa1 = INV_LD(28, 1); pa2 = INV_LD(28, 2); pa3 = INV_LD(28, 3); pa4 = INV_LD(28, 4); pa5 = INV_LD(28, 5); pa6 = INV_LD(28, 6); INV_SB();
    { int li = lane; asm volatile("" : "+v"(li)); float a0 = (li == 27) ? 1.f : 0.f, a1 = 0.f, a2 = 0.f, a3 = 0.f; a0 -= pb0[0] * x0; a1 -= pb0[1] * x1; a2 -= pb0[2] * x2; a3 -= pb0[3] * x3; a0 -= pb1[0] * x4; a1 -= pb1[1] * x5; a2 -= pb1[2] * x6; a3 -= pb1[3] * x7; a0 -= pb2[0] * x8; a1 -= pb2[1] * x9; a2 -= pb2[2] * x10; a3 -= pb2[3] * x11; a0 -= pb3[0] * x12; a1 -= pb3[1] * x13; a2 -= pb3[2] * x14; a3 -= pb3[3] * x15; a0 -= pb4[0] * x16; a1 -= pb4[1] * x17; a2 -= pb4[2] * x18; a3 -= pb4[3] * x19; a0 -= pb5[0] * x20; a1 -= pb5[1] * x21; a2 -= pb5[2] * x22; a3 -= pb5[3] * x23; a0 -= pb6[0] * x24; a1 -= pb6[1] * x25; a2 -= pb6[2] * x26; x27 = (a0 + a1) + (a2 + a3); } INV_SB();
    pb0 = INV_LD(29, 0); pb1 = INV_LD(29, 1); pb2 = INV_LD(29, 2); pb3 = INV_LD(29, 3); pb4 = INV_LD(29, 4); pb5 = INV_LD(29, 5); pb6 = INV_LD(29, 6); pb7 = INV_LD(29, 7); INV_SB();
    { int li = lane; asm volatile("" : "+v"(li)); float a0 = (li == 28) ? 1.f : 0.f, a1 = 0.f, a2 = 0.f, a3 = 0.f; a0 -= pa0[0] * x0; a1 -= pa0[1] * x1; a2 -= pa0[2] * x2; a3 -= pa0[3] * x3; a0 -= pa1[0] * x4; a1 -= pa1[1] * x5; a2 -= pa1[2] * x6; a3 -= pa1[3] * x7; a0 -= pa2[0] * x8; a1 -= pa2[1] * x9; a2 -= pa2[2] * x10; a3 -= pa2[3] * x11; a0 -= pa3[0] * x12; a1 -= pa3[1] * x13; a2 -= pa3[2] * x14; a3 -= pa3[3] * x15; a0 -= pa4[0] * x16; a1 -= pa4[1] * x17; a2 -= pa4[2] * x18; a3 -= pa4[3] * x19; a0 -= pa5[0] * x20; a1 -= pa5[1] * x21; a2 -= pa5[2] * x22; a3 -= pa5[3] * x23; a0 -= pa6[0] * x24; a1 -= pa6[1] * x25; a2 -= pa6[2] * x26; a3 -= pa6[3] * x27; x28 = (a0 + a1) + (a2 + a3); } INV_SB();
    pa0 = INV_LD(30, 0); pa1 = INV_LD(30, 1); pa2 = INV_LD(30, 2); pa3 = INV_LD(30, 3); pa4 = INV_LD(30, 4); pa5 = INV_LD(30, 5); pa6 = INV_LD(30, 6); pa7 = INV_LD(30, 7); INV_SB();
    { int li = lane; asm volatile("" : "+v"(li)); float a0 = (li == 29) ? 1.f : 0.f, a1 = 0.f, a2 = 0.f, a3 = 0.f; a0 -= pb0[0] * x0; a1 -= pb0[1] * x1; a2 -= pb0[2] * x2; a3 -= pb0[3] * x3; a0 -= pb1[0] * x4; a1 -= pb1[1] * x5; a2 -= pb1[2] * x6; a3 -= pb1[3] * x7; a0 -= pb2[0] * x8; a1 -= pb2[1] * x9; a2 -= pb2[2] * x10; a3 -= pb2[3] * x11; a0 -= pb3[0] * x12; a1 -= pb3[1] * x13; a2 -= pb3[2] * x14; a3 -= pb3[3] * x15; a0 -= pb4[0] * x16; a1 -= pb4[1] * x17; a2 -= pb4[2] * x18; a3 -= pb4[3] * x19; a0 -= pb5[0] * x20; a1 -= pb5[1] * x21; a2 -= pb5[2] * x22; a3 -= pb5[3] * x23; a0 -= pb6[0] * x24; a1 -= pb6[1] * x25; a2 -= pb6[2] * x26; a3 -= pb6[3] * x27; a0 -= pb7[0] * x28; x29 = (a0 + a1) + (a2 + a3); } INV_SB();
    pb0 = INV_LD(31, 0); pb1 = INV_LD(31, 1); pb2 = INV_LD(31, 2); pb3 = INV_LD(31, 3); pb4 = INV_LD(31, 4); pb5 = INV_LD(31, 5); pb6 = INV_LD(31, 6); pb7 = INV_LD(31, 7); INV_SB();
    { int li = lane; asm volatile("" : "+v"(li)); float a0 = (li == 30) ? 1.f : 0.f, a1 = 0.f, a2 = 0.f, a3 = 0.f; a0 -= pa0[0] * x0; a1 -= pa0[1] * x1; a2 -= pa0[2] * x2; a3 -= pa0[3] * x3; a0 -= pa1[0] * x4; a1 -= pa1[1] * x5; a2 -= pa1[2] * x6; a3 -= pa1[3] * x7; a0 -= pa2[0] * x8; a1 -= pa2[1] * x9; a2 -= pa2[2] * x10; a3 -= pa2[3] * x11; a0 -= pa3[0] * x12; a1 -= pa3[1] * x13; a2 -= pa3[2] * x14; a3 -= pa3[3] * x15; a0 -= pa4[0] * x16; a1 -= pa4[1] * x17; a2 -= pa4[2] * x18; a3 -= pa4[3] * x19; a0 -= pa5[0] * x20; a1 -= pa5[1] * x21; a2 -= pa5[2] * x22; a3 -= pa5[3] * x23; a0 -= pa6[0] * x24; a1 -= pa6[1] * x25; a2 -= pa6[2] * x26; a3 -= pa6[3] * x27; a0 -= pa7[0] * x28; a1 -= pa7[1] * x29; x30 = (a0 + a1) + (a2 + a3); } INV_SB();
    pa0 = INV_LD(32, 0); pa1 = INV_LD(32, 1); pa2 = INV_LD(32, 2); pa3 = INV_LD(32, 3); pa4 = INV_LD(32, 4); pa5 = INV_LD(32, 5); pa6 = INV_LD(32, 6); pa7 = INV_LD(32, 7); INV_SB();
    { int li = lane; asm volatile("" : "+v"(li)); float a0 = (li == 31) ? 1.f : 0.f, a1 = 0.f, a2 = 0.f, a3 = 0.f; a0 -= pb0[0] * x0; a1 -= pb0[1] * x1; a2 -= pb0[2] * x2; a3 -= pb0[3] * x3; a0 -= pb1[0] * x4; a1 -= pb1[1] * x5; a2 -= pb1[2] * x6; a3 -= pb1[3] * x7; a0 -= pb2[0] * x8; a1 -= pb2[1] * x9; a2 -= pb2[2] * x10; a3 -= pb2[3] * x11; a0 -= pb3[0] * x12; a1 -= pb3[1] * x13; a2 -= pb3[2] * x14; a3 -= pb3[3] * x15; a0 -= pb4[0] * x16; a1 -= pb4[1] * x17; a2 -= pb4[2] * x18; a3 -= pb4[3] * x19; a0 -= pb5[0] * x20; a1 -= pb5[1] * x21; a2 -= pb5[2] * x22; a3 -= pb5[3] * x23; a0 -= pb6[0] * x24; a1 -= pb6[1] * x25; a2 -= pb6[2] * x26; a3 -= pb6[3] * x27; a0 -= pb7[0] * x28; a1 -= pb7[1] * x29; a2 -= pb7[2] * x30; x31 = (a0 + a1) + (a2 + a3); } INV_SB();
    pb0 = INV_LD(33, 0); pb1 = INV_LD(33, 1); pb2 = INV_LD(33, 2); pb3 = INV_LD(33, 3); pb4 = INV_LD(33, 4); pb5 = INV_LD(33, 5); pb6 = INV_LD(33, 6); pb7 = INV_LD(33, 7); INV_SB();
    { int li = lane; asm volatile("" : "+v"(li)); float a0 = (li == 32) ? 1.f : 0.f, a1 = 0.f, a2 = 0.f, a3 = 0.f; a0 -= pa0[0] * x0; a1 -= pa0[1] * x1; a2 -= pa0[2] * x2; a3 -= pa0[3] * x3; a0 -= pa1[0] * x4; a1 -= pa1[1] * x5; a2 -= pa1[2] * x6; a3 -= pa1[3] * x7; a0 -= pa2[0] * x8; a1 -= pa2[1] * x9; a2 -= pa2[2] * x10; a3 -= pa2[3] * x11; a0 -= pa3[0] * x12; a1 -= pa3[1] * x13; a2 -= pa3[2] * x14; a3 -= pa3[3] * x15; a0 -= pa4[0] * x16; a1 -= pa4[1] * x17; a2 -= pa4[2] * x18; a3 -= pa4[3] * x19; a0 -= pa5[0] * x20; a1 -= pa5[1] * x21; a2 -= pa5[2] * x22; a3 -= pa5[3] * x23; a0 -= pa6[0] * x24; a1 -= pa6[1] * x25; a2 -= pa6[2] * x26; a3 -= pa6[3] * x27; a0 -= pa7[0] * x28; a1 -= pa7[1] * x29; a2 -= pa7[2] * x30; a3 -= pa7[3] * x31; x32 = (a0 + a1) + (a2 + a3); } INV_SB();
    l0 = INV_LD(33, 8); pa0 = INV_LD(34, 0); pa1 = INV_LD(34, 1); pa2 = INV_LD(34, 2); pa3 = INV_LD(34, 3); pa4 = INV_LD(34, 4); pa5 = INV_LD(34, 5); pa6 = INV_LD(34, 6); pa7 = INV_LD(34, 7); INV_SB();
    { int li = lane; asm volatile("" : "+v"(li)); float a0 = (li == 33) ? 1.f : 0.f, a1 = 0.f, a2 = 0.f, a3 = 0.f; a0 -= pb0[0] * x0; a1 -= pb0[1] * x1; a2 -= pb0[2] * x2; a3 -= pb0[3] * x3; a0 -= pb1[0] * x4; a1 -= pb1[1] * x5; a2 -= pb1[2] * x6; a3 -= pb1[3] * x7; a0 -= pb2[0] * x8; a1 -= pb2[1] * x9; a2 -= pb2[2] * x10; a3 -= pb2[3] * x11; a0 -= pb3[0] * x12; a1 -= pb3[1] * x13; a2 -= pb3[2] * x14; a3 -= pb3[3] * x15; a0 -= pb4[0] * x16; a1 -= pb4[1] * x17; a2 -= pb4[2] * x18; a3 -= pb4[3] * x19; a0 -= pb5[0] * x20; a1 -= pb5[1] * x21; a2 -= pb5[2] * x22; a3 -= pb5[3] * x23; a0 -= pb6[0] * x24; a1 -= pb6[1] * x25; a2 -= pb6[2] * x26; a3 -= pb6[3] * x27; a0 -= pb7[0] * x28; a1 -= pb7[1] * x29; a2 -= pb7[2] * x30; a3 -= pb7[3] * x31; a0 -= l0[0] * x32; x33 = (a0 + a1) + (a2 + a3); } INV_SB();
    l0 = INV_LD(34, 8); pb0 = INV_LD(35, 0); pb1 = INV_LD(35, 1); pb2 = INV_LD(35, 2); pb3 = INV_LD(35, 3); pb4 = INV_LD(35, 4); pb5 = INV_LD(35, 5); pb6 = INV_LD(35, 6); pb7 = INV_LD(35, 7); INV_SB();
    { int li = lane; asm volatile("" : "+v"(li)); float a0 = (li == 34) ? 1.f : 0.f, a1 = 0.f, a2 = 0.f, a3 = 0.f; a0 -= pa0[0] * x0; a1 -= pa0[1] * x1; a2 -= pa0[2] * x2; a3 -= pa0[3] * x3; a0 -= pa1[0] * x4; a1 -= pa1[1] * x5; a2 -= pa1[2] * x6; a3 -= pa1[3] * x7; a0 -= pa2[0] * x8; a1 -= pa2[1] * x9; a2 -= pa2[2] * x10; a3 -= pa2[3] * x11; a0 -= pa3[0] * x12; a1 -= pa3[1] * x13; a2 -= pa3[2] * x14; a3 -= pa3[3] * x15; a0 -= pa4[0] * x16; a1 -= pa4[1] * x17; a2 -= pa4[2] * x18; a3 -= pa4[3] * x19; a0 -= pa5[0] * x20; a1 -= pa5[1] * x21; a2 -= pa5[2] * x22; a3 -= pa5[3] * x23; a0 -= pa6[0] * x24; a1 -= pa6[1] * x25; a2 -= pa6[2] * x26; a3 -= pa6[3] * x27; a0 -= pa7[0] * x28; a1 -= pa7[1] * x29; a2 -= pa7[2] * x30; a3 -= pa7[3] * x31; a0 -= l0[0] * x32; a1 -= l0[1] * x33; x34 = (a0 + a1) + (a2 + a3); } INV_SB();
    l0 = INV_LD(35, 8); pa0 = INV_LD(36, 0); pa1 = INV_LD(36, 1); pa2 = INV_LD(36, 2); pa3 = INV_LD(36, 3); pa4 = INV_LD(36, 4); pa5 = INV_LD(36, 5); pa6 = INV_LD(36, 6); pa7 = INV_LD(36, 7); INV_SB();
    { int li = lane; asm volatile("" : "+v"(li)); float a0 = (li == 35) ? 1.f : 0.f, a1 = 0.f, a2 = 0.f, a3 = 0.f; a0 -= pb0[0] * x0; a1 -= pb0[1] * x1; a2 -= pb0[2] * x2; a3 -= pb0[3] * x3; a0 -= pb1[0] * x4; a1 -= pb1[1] * x5; a2 -= pb1[2] * x6; a3 -= pb1[3] * x7; a0 -= pb2[0] * x8; a1 -= pb2[1] * x9; a2 -= pb2[2] * x10; a3 -= pb2[3] * x11; a0 -= pb3[0] * x12; a1 -= pb3[1] * x13; a2 -= pb3[2] * x14; a3 -= pb3[3] * x15; a0 -= pb4[0] * x16; a1 -= pb4[1] * x17; a2 -= pb4[2] * x18; a3 -= pb4[3] * x19; a0 -= pb5[0] * x20; a1 -= pb5[1] * x21; a2 -= pb5[2] * x22; a3 -= pb5[3] * x23; a0 -= pb6[0] * x24; a1 -= pb6[1] * x25; a2 -= pb6[2] * x26; a3 -= pb6[3] * x27; a0 -= pb7[0] * x28; a1 -= pb7[1] * x29; a2 -= pb7[2] * x30; a3 -= pb7[3] * x31; a0 -= l0[0] * x32; a1 -= l0[1] * x33; a2 -= l0[2] * x34; x35 = (a0 + a1) + (a2 + a3); } INV_SB();
    l0 = INV_LD(36, 8); pb0 = INV_LD(37, 0); pb1 = INV_LD(37, 1); pb2 = INV_LD(37, 2); pb3 = INV_LD(37, 3); pb4 = INV_LD(37, 4); pb5 = INV_LD(37, 5); pb6 = INV_LD(37, 6); pb7 = INV_LD(37, 7); INV_SB();
    { int li = lane; asm volatile("" : "+v"(li)); float a0 = (li == 36) ? 1.f : 0.f, a1 = 0.f, a2 = 0.f, a3 = 0.f; a0 -= pa0[0] * x0; a1 -= pa0[1] * x1; a2 -= pa0[2] * x2; a3 -= pa0[3] * x3; a0 -= pa1[0] * x4; a1 -= pa1[1] * x5; a2 -= pa1[2] * x6; a3 -= pa1[3] * x7; a0 -= pa2[0] * x8; a1 -= pa2[1] * x9; a2 -= pa2[2] * x10; a3 -= pa2[3] * x11; a0 -= pa3[0] * x12; a1 -= pa3[1] * x13; a2 -= pa3[2] * x14; a3 -= pa3[3] * x15; a0 -= pa4[0] * x16; a1 -= pa4[1] * x17; a2 -= pa4[2] * x18; a3 -= pa4[3] * x19; a0 -= pa5[0] * x20; a1 -= pa5[1] * x21; a2 -= pa5[2] * x22; a3 -= pa5[3] * x23; a0 -= pa6[0] * x24; a1 -= pa6[1] * x25; a2 -= pa6[2] * x26; a3 -= pa6[3] * x27; a0 -= pa7[0] * x28; a1 -= pa7[1] * x29; a2 -= pa7[2] * x30; a3 -= pa7[3] * x31; a0 -= l0[0] * x32; a1 -= l0[1] * x33; a2 -= l0[2] * x34; a3 -= l0[3] * x35; x36 = (a0 + a1) + (a2 + a3); } INV_SB();
    l0 = INV_LD(37, 8); l1 = INV_LD(37, 9); pa0 = INV_LD(38, 0); pa1 = INV_LD(38, 1); pa2 = INV_LD(38, 2); pa3 = INV_LD(38, 3); pa4 = INV_LD(38, 4); pa5 = INV_LD(38, 5); pa6 = INV_LD(38, 6); pa7 = INV_LD(38, 7); INV_SB();
    { int li = lane; asm volatile("" : "+v"(li)); float a0 = (li == 37) ? 1.f : 0.f, a1 = 0.f, a2 = 0.f, a3 = 0.f; a0 -= pb0[0] * x0; a1 -= pb0[1] * x1; a2 -= pb0[2] * x2; a3 -= pb0[3] * x3; a0 -= pb1[0] * x4; a1 -= pb1[1] * x5; a2 -= pb1[2] * x6; a3 -= pb1[3] * x7; a0 -= pb2[0] * x8; a1 -= pb2[1] * x9; a2 -= pb2[2] * x10; a3 -= pb2[3] * x11; a0 -= pb3[0] * x12; a1 -= pb3[1] * x13; a2 -= pb3[2] * x14; a3 -= pb3[3] * x15; a0 -= pb4[0] * x16; a1 -= pb4[1] * x17; a2 -= pb4[2] * x18; a3 -= pb4[3] * x19; a0 -= pb5[0] * x20; a1 -= pb5[1] * x21; a2 -= pb5[2] * x22; a3 -= pb5[3] * x23; a0 -= pb6[0] * x24; a1 -= pb6[1] * x25; a2 -= pb6[2] * x26; a3 -= pb6[3] * x27; a0 -= pb7[0] * x28; a1 -= pb7[1] * x29; a2 -= pb7[2] * x30; a3 -= pb7[3] * x31; a0 -= l0[0] * x32; a1 -= l0[1] * x33; a2 -= l0[2] * x34; a3 -= l0[3] * x35; a0 -= l1[0] * x36; x37 = (a0 + a1) + (a2 + a3); } INV_SB();
    l0 = INV_LD(38, 8); l1 = INV_LD(38, 9); pb0 = INV_LD(39, 0); pb1 = INV_LD(39, 1); pb2 = INV_LD(39, 2); pb3 = INV_LD(39, 3); pb4 = INV_LD(39, 4); pb5 = INV_LD(39, 5); pb6 = INV_LD(39, 6); pb7 = INV_LD(39, 7); INV_SB();
    { int li = lane; asm volatile("" : "+v"(li)); float a0 = (li == 38) ? 1.f : 0.f, a1 = 0.f, a2 = 0.f, a3 = 0.f; a0 -= pa0[0] * x0; a1 -= pa0[1] * x1; a2 -= pa0[2] * x2; a3 -= pa0[3] * x3; a0 -= pa1[0] * x4; a1 -= pa1[1] * x5; a2 -= pa1[2] * x6; a3 -= pa1[3] * x7; a0 -= pa2[0] * x8; a1 -= pa2[1] * x9; a2 -= pa2[2] * x10; a3 -= pa2[3] * x11; a0 -= pa3[0] * x12; a1 -= pa3[1] * x13; a2 -= pa3[2] * x14; a3 -= pa3[3] * x15; a0 -= pa4[0] * x16; a1 -= pa4[1] * x17; a2 -= pa4[2] * x18; a3 -= pa4[3] * x19; a0 -= pa5[0] * x20; a1 -= pa5[1] * x21; a2 -= pa5[2] * x22; a3 -= pa5[3] * x23; a0 -= pa6[0] * x24; a1 -= pa6[1] * x25; a2 -= pa6[2] * x26; a3 -= pa6[3] * x27; a0 -= pa7[0] * x28; a1 -= pa7[1] * x29; a2 -= pa7[2] * x30; a3 -= pa7[3] * x31; a0 -= l0[0] * x32; a1 -= l0[1] * x33; a2 -= l0[2] * x34; a3 -= l0[3] * x35; a0 -= l1[0] * x36; a1 -= l1[1] * x37; x38 = (a0 + a1) + (a2 + a3); } INV_SB();
    l0 = INV_LD(39, 8); l1 = INV_LD(39, 9); pa0 = INV_LD(40, 0); pa1 = INV_LD(40, 1); pa2 = INV_LD(40, 2); pa3 = INV_LD(40, 3); pa4 = INV_LD(40, 4); pa5 = INV_LD(40, 5); pa6 = INV_LD(40, 6); pa7 = INV_LD(40, 7); INV_SB();
    { int li = lane; asm volatile("" : "+v"(li)); float a0 = (li == 39) ? 1.f : 0.f, a1 = 0.f, a2 = 0.f, a3 = 0.f; a0 -= pb0[0] * x0; a1 -= pb0[1] * x1; a2 -= pb0[2] * x2; a3 -= pb0[3] * x3; a0 -= pb1[0] * x4; a1 -= pb1[1] * x5; a2 -= pb1[2] * x6; a3 -= pb1[3] * x7; a0 -= pb2[0] * x8; a1 -= pb2[1] * x9; a2 -= pb2[2] * x10; a3 -= pb2[3] * x11; a0 -= pb3[0] * x12; a1 -= pb3[1] * x13; a2 -= pb3[2] * x14; a3 -= pb3[3] * x15; a0 -= pb4[0] * x16; a1 -= pb4[1] * x17; a2 -= pb4[2] * x18; a3 -= pb4[3] * x19; a0 -= pb5[0] * x20; a1 -= pb5[1] * x21; a2 -= pb5[2] * x22; a3 -= pb5[3] * x23; a0 -= pb6[0] * x24; a1 -= pb6[1] * x25; a2 -= pb6[2] * x26; a3 -= pb6[3] * x27; a0 -= pb7[0] * x28; a1 -= pb7[1] * x29; a2 -= pb7[2] * x30; a3 -= pb7[3] * x31; a0 -= l0[0] * x32; a1 -= l0[1] * x33; a2 -= l0[2] * x34; a3 -= l0[3] * x35; a0 -= l1[0] * x36; a1 -= l1[1] * x37; a2 -= l1[2] * x38; x39 = (a0 + a1) + (a2 + a3); } INV_SB();
    l0 = INV_LD(40, 8); l1 = INV_LD(40, 9); pb0 = INV_LD(41, 0); pb1 = INV_LD(41, 1); pb2 = INV_LD(41, 2); pb3 = INV_LD(41, 3); pb4 = INV_LD(41, 4); pb5 = INV_LD(41, 5); pb6 = INV_LD(41, 6); pb7 = INV_LD(41, 7); INV_SB();
    { int li = lane; asm volatile("" : "+v"(li)); float a0 = (li == 40) ? 1.f : 0.f, a1 = 0.f, a2 = 0.f, a3 = 0.f; a0 -= pa0[0] * x0; a1 -= pa0[1] * x1; a2 -= pa0[2] * x2; a3 -= pa0[3] * x3; a0 -= pa1[0] * x4; a1 -= pa1[1] * x5; a2 -= pa1[2] * x6; a3 -= pa1[3] * x7; a0 -= pa2[0] * x8; a1 -= pa2[1] * x9; a2 -= pa2[2] * x10; a3 -= pa2[3] * x11; a0 -= pa3[0] * x12; a1 -= pa3[1] * x13; a2 -= pa3[2] * x14; a3 -= pa3[3] * x15; a0 -= pa4[0] * x16; a1 -= pa4[1] * x17; a2 -= pa4[2] * x18; a3 -= pa4[3] * x19; a0 -= pa5[0] * x20; a1 -= pa5[1] * x21; a2 -= pa5[2] * x22; a3 -= pa5[3] * x23; a0 -= pa6[0] * x24; a1 -= pa6[1] * x25; a2 -= pa6[2] * x26; a3 -= pa6[3] * x27; a0 -= pa7[0] * x28; a1 -= pa7[1] * x29; a2 -= pa7[2] * x30; a3 -= pa7[3] * x31; a0 -= l0[0] * x32; a1 -= l0[1] * x33; a2 -= l0[2] * x34; a3 -= l0[3] * x35; a0 -= l1[0] * x36; a1 -= l1[1] * x37; a2 -= l1[2] * x38; a3 -= l1[3] * x39; x40 = (a0 + a1) + (a2 + a3); } INV_SB();
    l0 = INV_LD(41, 8); l1 = INV_LD(41, 9); l2 = INV_LD(41, 10); pa0 = INV_LD(42, 0); pa1 = INV_LD(42, 1); pa2 = INV_LD(42, 2); pa3 = INV_LD(42, 3); pa4 = INV_LD(42, 4); pa5 = INV_LD(42, 5); pa6 = INV_LD(42, 6); pa7 = INV_LD(42, 7); INV_SB();
    { int li = lane; asm volatile("" : "+v"(li)); float a0 = (li == 41) ? 1.f : 0.f, a1 = 0.f, a2 = 0.f, a3 = 0.f; a0 -= pb0[0] * x0; a1 -= pb0[1] * x1; a2 -= pb0[2] * x2; a3 -= pb0[3] * x3; a0 -= pb1[0] * x4; a1 -= pb1[1] * x5; a2 -= pb1[2] * x6; a3 -= pb1[3] * x7; a0 -= pb2[0] * x8; a1 -= pb2[1] * x9; a2 -= pb2[2] * x10; a3 -= pb2[3] * x11; a0 -= pb3[0] * x12; a1 -= pb3[1] * x13; a2 -= pb3[2] * x14; a3 -= pb3[3] * x15; a0 -= pb4[0] * x16; a1 -= pb4[1] * x17; a2 -= pb4[2] * x18; a3 -= pb4[3] * x19; a0 -= pb5[0] * x20; a1 -= pb5[1] * x21; a2 -= pb5[2] * x22; a3 -= pb5[3] * x23; a0 -= pb6[0] * x24; a1 -= pb6[1] * x25; a2 -= pb6[2] * x26; a3 -= pb6[3] * x27; a0 -= pb7[0] * x28; a1 -= pb7[1] * x29; a2 -= pb7[2] * x30; a3 -= pb7[3] * x31; a0 -= l0[0] * x32; a1 -= l0[1] * x33; a2 -= l0[2] * x34; a3 -= l0[3] * x35; a0 -= l1[0] * x36; a1 -= l1[1] * x37; a2 -= l1[2] * x38; a3 -= l1[3] * x39; a0 -= l2[0] * x40; x41 = (a0 + a1) + (a2 + a3); } INV_SB();
    l0 = INV_LD(42, 8); l1 = INV_LD(42, 9); l2 = INV_LD(42, 10); pb0 = INV_LD(43, 0); pb1 = INV_LD(43, 1); pb2 = INV_LD(43, 2); pb3 = INV_LD(43, 3); pb4 = INV_LD(43, 4); pb5 = INV_LD(43, 5); pb6 = INV_LD(43, 6); pb7 = INV_LD(43, 7); INV_SB();
    { int li = lane; asm volatile("" : "+v"(li)); float a0 = (li == 42) ? 1.f : 0.f, a1 = 0.f, a2 = 0.f, a3 = 0.f; a0 -= pa0[0] * x0; a1 -= pa0[1] * x1; a2 -= pa0[2] * x2; a3 -= pa0[3] * x3; a0 -= pa1[0] * x4; a1 -= pa1[1] * x5; a2 -= pa1[2] * x6; a3 -= pa1[3] * x7; a0 -= pa2[0] * x8; a1 -= pa2[1] * x9; a2 -= pa2[2] * x10; a3 -= pa2[3] * x11; a0 -= pa3[0] * x12; a1 -= pa3[1] * x13; a2 -= pa3[2] * x14; a3 -= pa3[3] * x15; a0 -= pa4[0] * x16; a1 -= pa4[1] * x17; a2 -= pa4[2] * x18; a3 -= pa4[3] * x19; a0 -= pa5[0] * x20; a1 -= pa5[1] * x21; a2 -= pa5[2] * x22; a3 -= pa5[3] * x23; a0 -= pa6[0] * x24; a1 -= pa6[1] * x25; a2 -= pa6[2] * x26; a3 -= pa6[3] * x27; a0 -= pa7[0] * x28; a1 -= pa7[1] * x29; a2 -= pa7[2] * x30; a3 -= pa7[3] * x31; a0 -= l0[0] * x32; a1 -= l0[1] * x33; a2 -= l0[2] * x34; a3 -= l0[3] * x35; a0 -= l1[0] * x36; a1 -= l1[1] * x37; a2 -= l1[2] * x38; a3 -= l1[3] * x39; a0 -= l2[0] * x40; a1 -= l2[1] * x41; x42 = (a0 + a1) + (a2 + a3); } INV_SB();
    l0 = INV_LD(43, 8); l1 = INV_LD(43, 9); l2 = INV_LD(43, 10); pa0 = INV_LD(44, 0); pa1 = INV_LD(44, 1); pa2 = INV_LD(44, 2); pa3 = INV_LD(44, 3); pa4 = INV_LD(44, 4); pa5 = INV_LD(44, 5); pa6 = INV_LD(44, 6); pa7 = INV_LD(44, 7); INV_SB();
    { int li = lane; asm volatile("" : "+v"(li)); float a0 = (li == 43) ? 1.f : 0.f, a1 = 0.f, a2 = 0.f, a3 = 0.f; a0 -= pb0[0] * x0; a1 -= pb0[1] * x1; a2 -= pb0[2] * x2; a3 -= pb0[3] * x3; a0 -= pb1[0] * x4; a1 -= pb1[1] * x5; a2 -= pb1[2] * x6; a3 -= pb1[3] * x7; a0 -= pb2[0] * x8; a1 -= pb2[1] * x9; a2 -= pb2[2] * x10; a3 -= pb2[3] * x11; a0 -= pb3[0] * x12; a1 -= pb3[1] * x13; a2 -= pb3[2] * x14; a3 -= pb3[3] * x15; a0 -= pb4[0] * x16; a1 -= pb4[1] * x17; a2 -= pb4[2] * x18; a3 -= pb4[3] * x19; a0 -= pb5[0] * x20; a1 -= pb5[1] * x21; a2 -= pb5[2] * x22; a3 -= pb5[3] * x23; a0 -= pb6[0] * x24; a1 -= pb6[1] * x25; a2 -= pb6[2] * x26; a3 -= pb6[3] * x27; a0 -= pb7[0] * x28; a1 -= pb7[1] * x29; a2 -= pb7[2] * x30; a3 -= pb7[3] * x31; a0 -= l0[0] * x32; a1 -= l0[1] * x33; a2 -= l0[2] * x34; a3 -= l0[3] * x35; a0 -= l1[0] * x36; a1 -= l1[1] * x37; a2 -= l1[2] * x38; a3 -= l1[3] * x39; a0 -= l2[0] * x40; a1 -= l2[1] * x41; a2 -= l2[2] * x42; x43 = (a0 + a1) + (a2 + a3); } INV_SB();
    l0 = INV_LD(44, 8); l1 = INV_LD(44, 9); l2 = INV_LD(44, 10); pb0 = INV_LD(45, 0); pb1 = INV_LD(45, 1); pb2 = INV_LD(45, 2); pb3 = INV_LD(45, 3); pb4 = INV_LD(45, 4); pb5 = INV_LD(45, 5); pb6 = INV_LD(45, 6); pb7 = INV_LD(45, 7); INV_SB();
    { int li = lane; asm volatile("" : "+v"(li)); float a0 = (li == 44) ? 1.f : 0.f, a1 = 0.f, a2 = 0.f, a3 = 0.f; a0 -= pa0[0] * x0; a1 -= pa0[1] * x1; a2 -= pa0[2] * x2; a3 -= pa0[3] * x3; a0 -= pa1[0] * x4; a1 -= pa1[1] * x5; a2 -= pa1[2] * x6; a3 -= pa1[3] * x7; a0 -= pa2[0] * x8; a1 -= pa2[1] * x9; a2 -= pa2[2] * x10; a3 -= pa2[3] * x11; a0 -= pa3[0] * x12; a1 -= pa3[1] * x13; a2 -= pa3[2] * x14; a3 -= pa3[3] * x15; a0 -= pa4[0] * x16; a1 -= pa4[1] * x17; a2 -= pa4[2] * x18; a3 -= pa4[3] * x19; a0 -= pa5[0] * x20; a1 -= pa5[1] * x21; a2 -= pa5[2] * x22; a3 -= pa5[3] * x23; a0 -= pa6[0] * x24; a1 -= pa6[1] * x25; a2 -= pa6[2] * x26; a3 -= pa6[3] * x27; a0 -= pa7[0] * x28; a1 -= pa7[1] * x29; a2 -= pa7[2] * x30; a3 -= pa7[3] * x31; a0 -= l0[0] * x32; a1 -= l0[1] * x33; a2 -= l0[2] * x34; a3 -= l0[3] * x35; a0 -= l1[0] * x36; a1 -= l1[1] * x37; a2 -= l1[2] * x38; a3 -= l1[3] * x39; a0 -= l2[0] * x40; a1 -= l2[1] * x41; a2 -= l2[2] * x42; a3 -= l2[3] * x43; x44 = (a0 + a1) + (a2 + a3); } INV_SB();
    l0 = INV_LD(45, 8); l1 = INV_LD(45, 9); l2 = INV_LD(45, 10); l3 = INV_LD(45, 11); pa0 = INV_LD(46, 0); pa1 = INV_LD(46, 1); pa2 = INV_LD(46, 2); pa3 = INV_LD(46, 3); pa4 = INV_LD(46, 4); pa5 = INV_LD(46, 5); pa6 = INV_LD(46, 6); pa7 = INV_LD(46, 7); INV_SB();
    { int li = lane; asm volatile("" : "+v"(li)); float a0 = (li == 45) ? 1.f : 0.f, a1 = 0.f, a2 = 0.f, a3 = 0.f; a0 -= pb0[0] * x0; a1 -= pb0[1] * x1; a2 -= pb0[2] * x2; a3 -= pb0[3] * x3; a0 -= pb1[0] * x4; a1 -= pb1[1] * x5; a2 -= pb1[2] * x6; a3 -= pb1[3] * x7; a0 -= pb2[0] * x8; a1 -= pb2[1] * x9; a2 -= pb2[2] * x10; a3 -= pb2[3] * x11; a0 -= pb3[0] * x12; a1 -= pb3[1] * x13; a2 -= pb3[2] * x14; a3 -= pb3[3] * x15; a0 -= pb4[0] * x16; a1 -= pb4[1] * x17; a2 -= pb4[2] * x18; a3 -= pb4[3] * x19; a0 -= pb5[0] * x20; a1 -= pb5[1] * x21; a2 -= pb5[2] * x22; a3 -= pb5[3] * x23; a0 -= pb6[0] * x24; a1 -= pb6[1] * x25; a2 -= pb6[2] * x26; a3 -= pb6[3] * x27; a0 -= pb7[0] * x28; a1 -= pb7[1] * x29; a2 -= pb7[2] * x30; a3 -= pb7[3] * x31; a0 -= l0[0] * x32; a1 -= l0[1] * x33; a2 -= l0[2] * x34; a3 -= l0[3] * x35; a0 -= l1[0] * x36; a1 -= l1[1] * x37; a2 -= l1[2] * x38; a3 -= l1[3] * x39; a0 -= l2[0] * x40; a1 -= l2[1] * x41; a2 -= l2[2] * x42; a3 -= l2[3] * x43; a0 -= l3[0] * x44; x45 = (a0 + a1) + (a2 + a3); } INV_SB();
    l0 = INV_LD(46, 8); l1 = INV_LD(46, 9); l2 = INV_LD(46, 10); l3 = INV_LD(46, 11); pb0 = INV_LD(47, 0); pb1 = INV_LD(47, 1); pb2 = INV_LD(47, 2); pb3 = INV_LD(47, 3); pb4 = INV_LD(47, 4); pb5 = INV_LD(47, 5); pb6 = INV_LD(47, 6); pb7 = INV_LD(47, 7); INV_SB();
    { int li = lane; asm volatile("" : "+v"(li)); float a0 = (li == 46) ? 1.f : 0.f, a1 = 0.f, a2 = 0.f, a3 = 0.f; a0 -= pa0[0] * x0; a1 -= pa0[1] * x1; a2 -= pa0[2] * x2; a3 -= pa0[3] * x3; a0 -= pa1[0] * x4; a1 -= pa1[1] * x5; a2 -= pa1[2] * x6; a3 -= pa1[3] * x7; a0 -= pa2[0] * x8; a1 -= pa2[1] * x9; a2 -= pa2[2] * x10; a3 -= pa2[3] * x11; a0 -= pa3[0] * x12; a1 -= pa3[1] * x13; a2 -= pa3[2] * x14; a3 -= pa3[3] * x15; a0 -= pa4[0] * x16; a1 -= pa4[1] * x17; a2 -= pa4[2] * x18; a3 -= pa4[3] * x19; a0 -= pa5[0] * x20; a1 -= pa5[1] * x21; a2 -= pa5[2] * x22; a3 -= pa5[3] * x23; a0 -= pa6[0] * x24; a1 -= pa6[1] * x25; a2 -= pa6[2] * x26; a3 -= pa6[3] * x27; a0 -= pa7[0] * x28; a1 -= pa7[1] * x29; a2 -= pa7[2] * x30; a3 -= pa7[3] * x31; a0 -= l0[0] * x32; a1 -= l0[1] * x33; a2 -= l0[2] * x34; a3 -= l0[3] * x35; a0 -= l1[0] * x36; a1 -= l1[1] * x37; a2 -= l1[2] * x38; a3 -= l1[3] * x39; a0 -= l2[0] * x40; a1 -= l2[1] * x41; a2 -= l2[2] * x42; a3 -= l2[3] * x43; a0 -= l3[0] * x44; a1 -= l3[1] * x45; x46 = (a0 + a1) + (a2 + a3); } INV_SB();
    l0 = INV_LD(47, 8); l1 = INV_LD(47, 9); l2 = INV_LD(47, 10); l3 = INV_LD(47, 11); pa0 = INV_LD(48, 0); pa1 = INV_LD(48, 1); pa2 = INV_LD(48, 2); pa3 = INV_LD(48, 3); pa4 = INV_LD(48, 4); pa5 = INV_LD(48, 5); pa6 = INV_LD(48, 6); pa7 = INV_LD(48, 7); INV_SB();
    { int li = lane; asm volatile("" : "+v"(li)); float a0 = (li == 47) ? 1.f : 0.f, a1 = 0.f, a2 = 0.f, a3 = 0.f; a0 -= pb0[0] * x0; a1 -= pb0[1] * x1; a2 -= pb0[2] * x2; a3 -= pb0[3] * x3; a0 -= pb1[0] * x4; a1 -= pb1[1] * x5; a2 -= pb1[2] * x6; a3 -= pb1[3] * x7; a0 -= pb2[0] * x8; a1 -= pb2[1] * x9; a2 -= pb2[2] * x10; a3 -= pb2[3] * x11; a0 -= pb3[0] * x12; a1 -= pb3[1] * x13; a2 -= pb3[2] * x14; a3 -= pb3[3] * x15; a0 -= pb4[0] * x16; a1 -= pb4[1] * x17; a2 -= pb4[2] * x18; a3 -= pb4[3] * x19; a0 -= pb5[0] * x20; a1 -= pb5[1] * x21; a2 -= pb5[2] * x22; a3 -= pb5[3] * x23; a0 -= pb6[0] * x24; a1 -= pb6[1] * x25; a2 -= pb6[2] * x26; a3 -= pb6[3] * x27; a0 -= pb7[0] * x28; a1 -= pb7[1] * x29; a2 -= pb7[2] * x30; a3 -= pb7[3] * x31; a0 -= l0[0] * x32; a1 -= l0[1] * x33; a2 -= l0[2] * x34; a3 -= l0[3] * x35; a0 -= l1[0] * x36; a1 -= l1[1] * x37; a2 -= l1[2] * x38; a3 -= l1[3] * x39; a0 -= l2[0] * x40; a1 -= l2[1] * x41; a2 -= l2[2] * x42; a3 -= l2[3] * x43; a0 -= l3[0] * x44; a1 -= l3[1] * x45; a2 -= l3[2] * x46; x47 = (a0 + a1) + (a2 + a3); } INV_SB();
    l0 = INV_LD(48, 8); l1 = INV_LD(48, 9); l2 = INV_LD(48, 10); l3 = INV_LD(48, 11); pb0 = INV_LD(49, 0); pb1 = INV_LD(49, 1); pb2 = INV_LD(49, 2); pb3 = INV_LD(49, 3); pb4 = INV_LD(49, 4); pb5 = INV_LD(49, 5); pb6 = INV_LD(49, 6); pb7 = INV_LD(49, 7); INV_SB();
    { int li = lane; asm volatile("" : "+v"(li)); float a0 = (li == 48) ? 1.f : 0.f, a1 = 0.f, a2 = 0.f, a3 = 0.f; a0 -= pa0[0] * x0; a1 -= pa0[1] * x1; a2 -= pa0[2] * x2; a3 -= pa0[3] * x3; a0 -= pa1[0] * x4; a1 -= pa1[1] * x5; a2 -= pa1[2] * x6; a3 -= pa1[3] * x7; a0 -= pa2[0] * x8; a1 -= pa2[1] * x9; a2 -= pa2[2] * x10; a3 -= pa2[3] * x11; a0 -= pa3[0] * x12; a1 -= pa3[1] * x13; a2 -= pa3[2] * x14; a3 -= pa3[3] * x15; a0 -= pa4[0] * x16; a1 -= pa4[1] * x17; a2 -= pa4[2] * x18; a3 -= pa4[3] * x19; a0 -= pa5[0] * x20; a1 -= pa5[1] * x21; a2 -= pa5[2] * x22; a3 -= pa5[3] * x23; a0 -= pa6[0] * x24; a1 -= pa6[1] * x25; a2 -= pa6[2] * x26; a3 -= pa6[3] * x27; a0 -= pa7[0] * x28; a1 -= pa7[1] * x29; a2 -= pa7[2] * x30; a3 -= pa7[3] * x31; a0 -= l0[0] * x32; a1 -= l0[1] * x33; a2 -= l0[2] * x34; a3 -= l0[3] * x35; a0 -= l1[0] * x36; a1 -= l1[1] * x37; a2 -= l1[2] * x38; a3 -= l1[3] * x39; a0 -= l2[0] * x40; a1 -= l2[1] * x41; a2 -= l2[2] * x42; a3 -= l2[3] * x43; a0 -= l3[0] * x44; a1 -= l3[1] * x45; a2 -= l3[2] * x46; a3 -= l3[3] * x47; x48 = (a0 + a1) + (a2 + a3); } INV_SB();
    l0 = INV_LD(49, 8); l1 = INV_LD(49, 9); l2 = INV_LD(49, 10); l3 = INV_LD(49, 11); l4 = INV_LD(49, 12); pa0 = INV_LD(50, 0); pa1 = INV_LD(50, 1); pa2 = INV_LD(50, 2); pa3 = INV_LD(50, 3); pa4 = INV_LD(50, 4); pa5 = INV_LD(50, 5); pa6 = INV_LD(50, 6); pa7 = INV_LD(50, 7); INV_SB();
    { int li = lane; asm volatile("" : "+v"(li)); float a0 = (li == 49) ? 1.f : 0.f, a1 = 0.f, a2 = 0.f, a3 = 0.f; a0 -= pb0[0] * x0; a1 -= pb0[1] * x1; a2 -= pb0[2] * x2; a3 -= pb0[3] * x3; a0 -= pb1[0] * x4; a1 -= pb1[1] * x5; a2 -= pb1[2] * x6; a3 -= pb1[3] * x7; a0 -= pb2[0] * x8; a1 -= pb2[1] * x9; a2 -= pb2[2] * x10; a3 -= pb2[3] * x11; a0 -= pb3[0] * x12; a1 -= pb3[1] * x13; a2 -= pb3[2] * x14; a3 -= pb3[3] * x15; a0 -= pb4[0] * x16; a1 -= pb4[1] * x17; a2 -= pb4[2] * x18; a3 -= pb4[3] * x19; a0 -= pb5[0] * x20; a1 -= pb5[1] * x21; a2 -= pb5[2] * x22; a3 -= pb5[3] * x23; a0 -= pb6[0] * x24; a1 -= pb6[1] * x25; a2 -= pb6[2] * x26; a3 -= pb6[3] * x27; a0 -= pb7[0] * x28; a1 -= pb7[1] * x29; a2 -= pb7[2] * x30; a3 -= pb7[3] * x31; a0 -= l0[0] * x32; a1 -= l0[1] * x33; a2 -= l0[2] * x34; a3 -= l0[3] * x35; a0 -= l1[0] * x36; a1 -= l1[1] * x37; a2 -= l1[2] * x38; a3 -= l1[3] * x39; a0 -= l2[0] * x40; a1 -= l2[1] * x41; a2 -= l2[2] * x42; a3 -= l2[3] * x43; a0 -= l3[0] * x44; a1 -= l3[1] * x45; a2 -= l3[2] * x46; a3 -= l3[3] * x47; a0 -= l4[0] * x48; x49 = (a0 + a1) + (a2 + a3); } INV_SB();
    l0 = INV_LD(50, 8); l1 = INV_LD(50, 9); l2 = INV_LD(50, 10); l3 = INV_LD(50, 11); l4 = INV_LD(50, 12); pb0 = INV_LD(51, 0); pb1 = INV_LD(51, 1); pb2 = INV_LD(51, 2); pb3 = INV_LD(51, 3); pb4 = INV_LD(51, 4); pb5 = INV_LD(51, 5); pb6 = INV_LD(51, 6); pb7 = INV_LD(51, 7); INV_SB();
    { int li = lane; asm volatile("" : "+v"(li)); float a0 = (li == 50) ? 1.f : 0.f, a1 = 0.f, a2 = 0.f, a3 = 0.f; a0 -= pa0[0] * x0; a1 -= pa0[1] * x1; a2 -= pa0[2] * x2; a3 -= pa0[3] * x3; a0 -= pa1[0] * x4; a1 -= pa1[1] * x5; a2 -= pa1[2] * x6; a3 -= pa1[3] * x7; a0 -= pa2[0] * x8; a1 -= pa2[1] * x9; a2 -= pa2[2] * x10; a3 -= pa2[3] * x11; a0 -= pa3[0] * x12; a1 -= pa3[1] * x13; a2 -= pa3[2] * x14; a3 -= pa3[3] * x15; a0 -= pa4[0] * x16; a1 -= pa4[1] * x17; a2 -= pa4[2] * x18; a3 -= pa4[3] * x19; a0 -= pa5[0] * x20; a1 -= pa5[1] * x21; a2 -= pa5[2] * x22; a3 -= pa5[3] * x23; a0 -= pa6[0] * x24; a1 -= pa6[1] * x25; a2 -= pa6[2] * x26; a3 -= pa6[3] * x27; a0 -= pa7[0] * x28; a1 -= pa7[1] * x29; a2 -= pa7[2] * x30; a3 -= pa7[3] * x31; a0 -= l0[0] * x32; a1 -= l0[1] * x33; a2 -= l0[2] * x34; a3 -= l0[3] * x35; a0 -= l1[0] * x36; a1 -= l1[1] * x37; a2 -= l1[2] * x38; a3 -= l1[3] * x39; a0 -= l2[0] * x40; a1 -= l2[1] * x41; a2 -= l2[2] * x42; a3 -= l2[3] * x43; a0 -= l3[0] * x44; a1 -= l3[1] * x45; a2 -= l3[2] * x46; a3 -= l3[3] * x47; a0 -= l4[0] * x48; a1 -= l4[1] * x49; x50 = (a0 + a1) + (a2 + a3); } INV_SB();
    l0 = INV_LD(51, 8); l1 = INV_LD(51, 9); l2 = INV_LD(51, 10); l3 = INV_LD(51, 11); l4 = INV_LD(51, 12); pa0 = INV_LD(52, 0); pa1 = INV_LD(52, 1); pa2 = INV_LD(52, 2); pa3 = INV_LD(52, 3); pa4 = INV_LD(52, 4); pa5 = INV_LD(52, 5); pa6 = INV_LD(52, 6); pa7 = INV_LD(52, 7); INV_SB();
    { int li = lane; asm volatile("" : "+v"(li)); float a0 = (li == 51) ? 1.f : 0.f, a1 = 0.f, a2 = 0.f, a3 = 0.f; a0 -= pb0[0] * x0; a1 -= pb0[1] * x1; a2 -= pb0[2] * x2; a3 -= pb0[3] * x3; a0 -= pb1[0] * x4; a1 -= pb1[1] * x5; a2 -= pb1[2] * x6; a3 -= pb1[3] * x7; a0 -= pb2[0] * x8; a1 -= pb2[1] * x9; a2 -= pb2[2] * x10; a3 -= pb2[3] * x11; a0 -= pb3[0] * x12; a1 -= pb3[1] * x13; a2 -= pb3[2] * x14; a3 -= pb3[3] * x15; a0 -= pb4[0] * x16; a1 -= pb4[1] * x17; a2 -= pb4[2] * x18; a3 -= pb4[3] * x19; a0 -= pb5[0] * x20; a1 -= pb5[1] * x21; a2 -= pb5[2] * x22; a3 -= pb5[3] * x23; a0 -= pb6[0] * x24; a1 -= pb6[1] * x25; a2 -= pb6[2] * x26; a3 -= pb6[3] * x27; a0 -= pb7[0] * x28; a1 -= pb7[1] * x29; a2 -= pb7[2] * x30; a3 -= pb7[3] * x31; a0 -= l0[0] * x32; a1 -= l0[1] * x33; a2 -= l0[2] * x34; a3 -= l0[3] * x35; a0 -= l1[0] * x36; a1 -= l1[1] * x37; a2 -= l1[2] * x38; a3 -= l1[3] * x39; a0 -= l2[0] * x40; a1 -= l2[1] * x41; a2 -= l2[2] * x42; a3 -= l2[3] * x43; a0 -= l3[0] * x44; a1 -= l3[1] * x45; a2 -= l3[2] * x46; a3 -= l3[3] * x47; a0 -= l4[0] * x48; a1 -= l4[1] * x49; a2 -= l4[2] * x50; x51 = (a0 + a1) + (a2 + a3); } INV_SB();
    l0 = INV_LD(52, 8); l1 = INV_LD(52, 9); l2 = INV_LD(52, 10); l3 = INV_LD(52, 11); l4 = INV_LD(52, 12); pb0 = INV_LD(53, 0); pb1 = INV_LD(53, 1); pb2 = INV_LD(53, 2); pb3 = INV_LD(53, 3); pb4 = INV_LD(53, 4); pb5 = INV_LD(53, 5); pb6 = INV_LD(53, 6); pb7 = INV_LD(53, 7); INV_SB();
    { int li = lane; asm volatile("" : "+v"(li)); float a0 = (li == 52) ? 1.f : 0.f, a1 = 0.f, a2 = 0.f, a3 = 0.f; a0 -= pa0[0] * x0; a1 -= pa0[1] * x1; a2 -= pa0[2] * x2; a3 -= pa0[3] * x3; a0 -= pa1[0] * x4; a1 -= pa1[1] * x5; a2 -= pa1[2] * x6; a3 -= pa1[3] * x7; a0 -= pa2[0] * x8; a1 -= pa2[1] * x9; a2 -= pa2[2] * x10; a3 -= pa2[3] * x11; a0 -= pa3[0] * x12; a1 -= pa3[1] * x13; a2 -= pa3[2] * x14; a3 -= pa3[3] * x15; a0 -= pa4[0] * x16; a1 -= pa4[1] * x17; a2 -= pa4[2] * x18; a3 -= pa4[3] * x19; a0 -= pa5[0] * x20; a1 -= pa5[1] * x21; a2 -= pa5[2] * x22; a3 -= pa5[3] * x23; a0 -= pa6[0] * x24; a1 -= pa6[1] * x25; a2 -= pa6[2] * x26; a3 -= pa6[3] * x27; a0 -= pa7[0] * x28; a1 -= pa7[1] * x29; a2 -= pa7[2] * x30; a3 -= pa7[3] * x31; a0 -= l0[0] * x32; a1 -= l0[1] * x33; a2 -= l0[2] * x34; a3 -= l0[3] * x35; a0 -= l1[0] * x36; a1 -= l1[1] * x37; a2 -= l1[2] * x38; a3 -= l1[3] * x39; a0 -= l2[0] * x40; a1 -= l2[1] * x41; a2 -= l2[2] * x42; a3 -= l2[3] * x43; a0 -= l3[0] * x44; a1 -= l3[1] * x45; a2 -= l3[2] * x46; a3 -= l3[3] * x47; a0 -= l4[0] * x48; a1 -= l4[1] * x49; a2 -= l4[2] * x50; a3 -= l4[3] * x51; x52 = (a0 + a1) + (a2 + a3); } INV_SB();
    l0 = INV_LD(53, 8); l1 = INV_LD(53, 9); l2 = INV_LD(53, 10); l3 = INV_LD(53, 11); l4 = INV_LD(53, 12); l5 = INV_LD(53, 13); pa0 = INV_LD(54, 0); pa1 = INV_LD(54, 1); pa2 = INV_LD(54, 2); pa3 = INV_LD(54, 3); pa4 = INV_LD(54, 4); pa5 = INV_LD(54, 5); pa6 = INV_LD(54, 6); pa7 = INV_LD(54, 7); INV_SB();
    { int li = lane; asm volatile("" : "+v"(li)); float a0 = (li == 53) ? 1.f : 0.f, a1 = 0.f, a2 = 0.f, a3 = 0.f; a0 -= pb0[0] * x0; a1 -= pb0[1] * x1; a2 -= pb0[2] * x2; a3 -= pb0[3] * x3; a0 -= pb1[0] * x4; a1 -= pb1[1] * x5; a2 -= pb1[2] * x6; a3 -= pb1[3] * x7; a0 -= pb2[0] * x8; a1 -= pb2[1] * x9; a2 -= pb2[2] * x10; a3 -= pb2[3] * x11; a0 -= pb3[0] * x12; a1 -= pb3[1] * x13; a2 -= pb3[2] * x14; a3 -= pb3[3] * x15; a0 -= pb4[0] * x16; a1 -= pb4[1] * x17; a2 -= pb4[2] * x18; a3 -= pb4[3] * x19; a0 -= pb5[0] * x20; a1 -= pb5[1] * x21; a2 -= pb5[2] * x22; a3 -= pb5[3] * x23; a0 -= pb6[0] * x24; a1 -= pb6[1] * x25; a2 -= pb6[2] * x26; a3 -= pb6[3] * x27; a0 -= pb7[0] * x28; a1 -= pb7[1] * x29; a2 -= pb7[2] * x30; a3 -= pb7[3] * x31; a0 -= l0[0] * x32; a1 -= l0[1] * x33; a2 -= l0[2] * x34; a3 -= l0[3] * x35; a0 -= l1[0] * x36; a1 -= l1[1] * x37; a2 -= l1[2] * x38; a3 -= l1[3] * x39; a0 -= l2[0] * x40; a1 -= l2[1] * x41; a2 -= l2[2] * x42; a3 -= l2[3] * x43; a0 -= l3[0] * x44; a1 -= l3[1] * x45; a2 -= l3[2] * x46; a3 -= l3[3] * x47; a0 -= l4[0] * x48; a1 -= l4[1] * x49; a2 -= l4[2] * x50; a3 -= l4[3] * x51; a0 -= l5[0] * x52; x53 = (a0 + a1) + (a2 + a3); } INV_SB();
    l0 = INV_LD(54, 8); l1 = INV_LD(54, 9); l2 = INV_LD(54, 10); l3 = INV_LD(54, 11); l4 = INV_LD(54, 12); l5 = INV_LD(54, 13); pb0 = INV_LD(55, 0); pb1 = INV_LD(55, 1); pb2 = INV_LD(55, 2); pb3 = INV_LD(55, 3); pb4 = INV_LD(55, 4); pb5 = INV_LD(55, 5); pb6 = INV_LD(55, 6); pb7 = INV_LD(55, 7); INV_SB();
    { int li = lane; asm volatile("" : "+v"(li)); float a0 = (li == 54) ? 1.f : 0.f, a1 = 0.f, a2 = 0.f, a3 = 0.f; a0 -= pa0[0] * x0; a1 -= pa0[1] * x1; a2 -= pa0[2] * x2; a3 -= pa0[3] * x3; a0 -= pa1[0] * x4; a1 -= pa1[1] * x5; a2 -= pa1[2] * x6; a3 -= pa1[3] * x7; a0 -= pa2[0] * x8; a1 -= pa2[1] * x9; a2 -= pa2[2] * x10; a3 -= pa2[3] * x11; a0 -= pa3[0] * x12; a1 -= pa3[1] * x13; a2 -= pa3[2] * x14; a3 -= pa3[3] * x15; a0 -= pa4[0] * x16; a1 -= pa4[1] * x17; a2 -= pa4[2] * x18; a3 -= pa4[3] * x19; a0 -= pa5[0] * x20; a1 -= pa5[1] * x21; a2 -= pa5[2] * x22; a3 -= pa5[3] * x23; a0 -= pa6[0] * x24; a1 -= pa6[1] * x25; a2 -= pa6[2] * x26; a3 -= pa6[3] * x27; a0 -= pa7[0] * x28; a1 -= pa7[1] * x29; a2 -= pa7[2] * x30; a3 -= pa7[3] * x31; a0 -= l0[0] * x32; a1 -= l0[1] * x33; a2 -= l0[2] * x34; a3 -= l0[3] * x35; a0 -= l1[0] * x36; a1 -= l1[1] * x37; a2 -= l1[2] * x38; a3 -= l1[3] * x39; a0 -= l2[0] * x40; a1 -= l2[1] * x41; a2 -= l2[2] * x42; a3 -= l2[3] * x43; a0 -= l3[0] * x44; a1 -= l3[1] * x45; a2 -= l3[2] * x46; a3 -= l3[3] * x47; a0 -= l4[0] * x48; a1 -= l4[1] * x49; a2 -= l4[2] * x50; a3 -= l4[3] * x51; a0 -= l5[0] * x52; a1 -= l5[1] * x53; x54 = (a0 + a1) + (a2 + a3); } INV_SB();
    l0 = INV_LD(55, 8); l1 = INV_LD(55, 9); l2 = INV_LD(55, 10); l3 = INV_LD(55, 11); l4 = INV_LD(55, 12); l5 = INV_LD(55, 13); pa0 = INV_LD(56, 0); pa1 = INV_LD(56, 1); pa2 = INV_LD(56, 2); pa3 = INV_LD(56, 3); pa4 = INV_LD(56, 4); pa5 = INV_LD(56, 5); pa6 = INV_LD(56, 6); pa7 = INV_LD(56, 7); INV_SB();
    { int li = lane; asm volatile("" : "+v"(li)); float a0 = (li == 55) ? 1.f : 0.f, a1 = 0.f, a2 = 0.f, a3 = 0.f; a0 -= pb0[0] * x0; a1 -= pb0[1] * x1; a2 -= pb0[2] * x2; a3 -= pb0[3] * x3; a0 -= pb1[0] * x4; a1 -= pb1[1] * x5; a2 -= pb1[2] * x6; a3 -= pb1[3] * x7; a0 -= pb2[0] * x8; a1 -= pb2[1] * x9; a2 -= pb2[2] * x10; a3 -= pb2[3] * x11; a0 -= pb3[0] * x12; a1 -= pb3[1] * x13; a2 -= pb3[2] * x14; a3 -= pb3[3] * x15; a0 -= pb4[0] * x16; a1 -= pb4[1] * x17; a2 -= pb4[2] * x18; a3 -= pb4[3] * x19; a0 -= pb5[0] * x20; a1 -= pb5[1] * x21; a2 -= pb5[2] * x22; a3 -= pb5[3] * x23; a0 -= pb6[0] * x24; a1 -= pb6[1] * x25; a2 -= pb6[2] * x26; a3 -= pb6[3] * x27; a0 -= pb7[0] * x28; a1 -= pb7[1] * x29; a2 -= pb7[2] * x30; a3 -= pb7[3] * x31; a0 -= l0[0] * x32; a1 -= l0[1] * x33; a2 -= l0[2] * x34; a3 -= l0[3] * x35; a0 -= l1[0] * x36; a1 -= l1[1] * x37; a2 -= l1[2] * x38; a3 -= l1[3] * x39; a0 -= l2[0] * x40; a1 -= l2[1] * x41; a2 -= l2[2] * x42; a3 -= l2[3] * x43; a0 -= l3[0] * x44; a1 -= l3[1] * x45; a2 -= l3[2] * x46; a3 -= l3[3] * x47; a0 -= l4[0] * x48; a1 -= l4[1] * x49; a2 -= l4[2] * x50; a3 -= l4[3] * x51; a0 -= l5[0] * x52; a1 -= l5[1] * x53; a2 -= l5[2] * x54; x55 = (a0 + a1) + (a2 + a3); } INV_SB();
    l0 = INV_LD(56, 8); l1 = INV_LD(56, 9); l2 = INV_LD(56, 10); l3 = INV_LD(56, 11); l4 = INV_LD(56, 12); l5 = INV_LD(56, 13); pb0 = INV_LD(57, 0); pb1 = INV_LD(57, 1); pb2 = INV_LD(57, 2); pb3 = INV_LD(57, 3); pb4 = INV_LD(57, 4); pb5 = INV_LD(57, 5); pb6 = INV_LD(57, 6); pb7 = INV_LD(57, 7); INV_SB();
    { int li = lane; asm volatile("" : "+v"(li)); float a0 = (li == 56) ? 1.f : 0.f, a1 = 0.f, a2 = 0.f, a3 = 0.f; a0 -= pa0[0] * x0; a1 -= pa0[1] * x1; a2 -= pa0[2] * x2; a3 -= pa0[3] * x3; a0 -= pa1[0] * x4; a1 -= pa1[1] * x5; a2 -= pa1[2] * x6; a3 -= pa1[3] * x7; a0 -= pa2[0] * x8; a1 -= pa2[1] * x9; a2 -= pa2[2] * x10; a3 -= pa2[3] * x11; a0 -= pa3[0] * x12; a1 -= pa3[1] * x13; a2 -= pa3[2] * x14; a3 -= pa3[3] * x15; a0 -= pa4[0] * x16; a1 -= pa4[1] * x17; a2 -= pa4[2] * x18; a3 -= pa4[3] * x19; a0 -= pa5[0] * x20; a1 -= pa5[1] * x21; a2 -= pa5[2] * x22; a3 -= pa5[3] * x23; a0 -= pa6[0] * x24; a1 -= pa6[1] * x25; a2 -= pa6[2] * x26; a3 -= pa6[3] * x27; a0 -= pa7[0] * x28; a1 -= pa7[1] * x29; a2 -= pa7[2] * x30; a3 -= pa7[3] * x31; a0 -= l0[0] * x32; a1 -= l0[1] * x33; a2 -= l0[2] * x34; a3 -= l0[3] * x35; a0 -= l1[0] * x36; a1 -= l1[1] * x37; a2 -= l1[2] * x38; a3 -= l1[3] * x39; a0 -= l2[0] * x40; a1 -= l2[1] * x41; a2 -= l2[2] * x42; a3 -= l2[3] * x43; a0 -= l3[0] * x44; a1 -= l3[1] * x45; a2 -= l3[2] * x46; a3 -= l3[3] * x47; a0 -= l4[0] * x48; a1 -= l4[1] * x49; a2 -= l4[2] * x50; a3 -= l4[3] * x51; a0 -= l5[0] * x52; a1 -= l5[1] * x53; a2 -= l5[2] * x54; a3 -= l5[3] * x55; x56 = (a0 + a1) + (a2 + a3); } INV_SB();
    l0 = INV_LD(57, 8); l1 = INV_LD(57, 9); l2 = INV_LD(57, 10); l3 = INV_LD(57, 11); l4 = INV_LD(57, 12); l5 = INV_LD(57, 13); l6 = INV_LD(57, 14); pa0 = INV_LD(58, 0); pa1 = INV_LD(58, 1); pa2 = INV_LD(58, 2); pa3 = INV_LD(58, 3); pa4 = INV_LD(58, 4); pa5 = INV_LD(58, 5); pa6 = INV_LD(58, 6); pa7 = INV_LD(58, 7); INV_SB();
    { int li = lane; asm volatile("" : "+v"(li)); float a0 = (li == 57) ? 1.f : 0.f, a1 = 0.f, a2 = 0.f, a3 = 0.f; a0 -= pb0[0] * x0; a1 -= pb0[1] * x1; a2 -= pb0[2] * x2; a3 -= pb0[3] * x3; a0 -= pb1[0] * x4; a1 -= pb1[1] * x5; a2 -= pb1[2] * x6; a3 -= pb1[3] * x7; a0 -= pb2[0] * x8; a1 -= pb2[1] * x9; a2 -= pb2[2] * x10; a3 -= pb2[3] * x11; a0 -= pb3[0] * x12; a1 -= pb3[1] * x13; a2 -= pb3[2] * x14; a3 -= pb3[3] * x15; a0 -= pb4[0] * x16; a1 -= pb4[1] * x17; a2 -= pb4[2] * x18; a3 -= pb4[3] * x19; a0 -= pb5[0] * x20; a1 -= pb5[1] * x21; a2 -= pb5[2] * x22; a3 -= pb5[3] * x23; a0 -= pb6[0] * x24; a1 -= pb6[1] * x25; a2 -= pb6[2] * x26; a3 -= pb6[3] * x27; a0 -= pb7[0] * x28; a1 -= pb7[1] * x29; a2 -= pb7[2] * x30; a3 -= pb7[3] * x31; a0 -= l0[0] * x32; a1 -= l0[1] * x33; a2 -= l0[2] * x34; a3 -= l0[3] * x35; a0 -= l1[0] * x36; a1 -= l1[1] * x37; a2 -= l1[2] * x38; a3 -= l1[3] * x39; a0 -= l2[0] * x40; a1 -= l2[1] * x41; a2 -= l2[2] * x42; a3 -= l2[3] * x43; a0 -= l3[0] * x44; a1 -= l3[1] * x45; a2 -= l3[2] * x46; a3 -= l3[3] * x47; a0 -= l4[0] * x48; a1 -= l4[1] * x49; a2 -= l4[2] * x50; a3 -= l4[3] * x51; a0 -= l5[0] * x52; a1 -= l5[1] * x53; a2 -= l5[2] * x54; a3 -= l5[3] * x55; a0 -= l6[0] * x56; x57 = (a0 + a1) + (a2 + a3); } INV_SB();
    l0 = INV_LD(58, 8); l1 = INV_LD(58, 9); l2 = INV_LD(58, 10); l3 = INV_LD(58, 11); l4 = INV_LD(58, 12); l5 = INV_LD(58, 13); l6 = INV_LD(58, 14); pb0 = INV_LD(59, 0); pb1 = INV_LD(59, 1); pb2 = INV_LD(59, 2); pb3 = INV_LD(59, 3); pb4 = INV_LD(59, 4); pb5 = INV_LD(59, 5); pb6 = INV_LD(59, 6); pb7 = INV_LD(59, 7); INV_SB();
    { int li = lane; asm volatile("" : "+v"(li)); float a0 = (li == 58) ? 1.f : 0.f, a1 = 0.f, a2 = 0.f, a3 = 0.f; a0 -= pa0[0] * x0; a1 -= pa0[1] * x1; a2 -= pa0[2] * x2; a3 -= pa0[3] * x3; a0 -= pa1[0] * x4; a1 -= pa1[1] * x5; a2 -= pa1[2] * x6; a3 -= pa1[3] * x7; a0 -= pa2[0] * x8; a1 -= pa2[1] * x9; a2 -= pa2[2] * x10; a3 -= pa2[3] * x11; a0 -= pa3[0] * x12; a1 -= pa3[1] * x13; a2 -= pa3[2] * x14; a3 -= pa3[3] * x15; a0 -= pa4[0] * x16; a1 -= pa4[1] * x17; a2 -= pa4[2] * x18; a3 -= pa4[3] * x19; a0 -= pa5[0] * x20; a1 -= pa5[1] * x21; a2 -= pa5[2] * x22; a3 -= pa5[3] * x23; a0 -= pa6[0] * x24; a1 -= pa6[1] * x25; a2 -= pa6[2] * x26; a3 -= pa6[3] * x27; a0 -= pa7[0] * x28; a1 -= pa7[1] * x29; a2 -= pa7[2] * x30; a3 -= pa7[3] * x31; a0 -= l0[0] * x32; a1 -= l0[1] * x33; a2 -= l0[2] * x34; a3 -= l0[3] * x35; a0 -= l1[0] * x36; a1 -= l1[1] * x37; a2 -= l1[2] * x38; a3 -= l1[3] * x39; a0 -= l2[0] * x40; a1 -= l2[1] * x41; a2 -= l2[2] * x42; a3 -= l2[3] * x43; a0 -= l3[0] * x44; a1 -= l3[1] * x45; a2 -= l3[2] * x46; a3 -= l3[3] * x47; a0 -= l4[0] * x48; a1 -= l4[1] * x49; a2 -= l4[2] * x50; a3 -= l4[3] * x51; a0 -= l5[0] * x52; a1 -= l5[1] * x53; a2 -= l5[2] * x54; a3 -= l5[3] * x55; a0 -= l6[0] * x56; a1 -= l6[1] * x57; x58 = (a0 + a1) + (a2 + a3); } INV_SB();
    l0 = INV_LD(59, 8); l1 = INV_LD(59, 9); l2 = INV_LD(59, 10); l3 = INV_LD(59, 11); l4 = INV_LD(59, 12); l5 = INV_LD(59, 13); l6 = INV_LD(59, 14); pa0 = INV_LD(60, 0); pa1 = INV_LD(60, 1); pa2 = INV_LD(60, 2); pa3 = INV_LD(60, 3); pa4 = INV_LD(60, 4); pa5 = INV_LD(60, 5); pa6 = INV_LD(60, 6); pa7 = INV_LD(60, 7); INV_SB();
    { int li = lane; asm volatile("" : "+v"(li)); float a0 = (li == 59) ? 1.f : 0.f, a1 = 0.f, a2 = 0.f, a3 = 0.f; a0 -= pb0[0] * x0; a1 -= pb0[1] * x1; a2 -= pb0[2] * x2; a3 -= pb0[3] * x3; a0 -= pb1[0] * x4; a1 -= pb1[1] * x5; a2 -= pb1[2] * x6; a3 -= pb1[3] * x7; a0 -= pb2[0] * x8; a1 -= pb2[1] * x9; a2 -= pb2[2] * x10; a3 -= pb2[3] * x11; a0 -= pb3[0] * x12; a1 -= pb3[1] * x13; a2 -= pb3[2] * x14; a3 -= pb3[3] * x15; a0 -= pb4[0] * x16; a1 -= pb4[1] * x17; a2 -= pb4[2] * x18; a3 -= pb4[3] * x19; a0 -= pb5[0] * x20; a1 -= pb5[1] * x21; a2 -= pb5[2] * x22; a3 -= pb5[3] * x23; a0 -= pb6[0] * x24; a1 -= pb6[1] * x25; a2 -= pb6[2] * x26; a3 -= pb6[3] * x27; a0 -= pb7[0] * x28; a1 -= pb7[1] * x29; a2 -= pb7[2] * x30; a3 -= pb7[3] * x31; a0 -= l0[0] * x32; a1 -= l0[1] * x33; a2 -= l0[2] * x34; a3 -= l0[3] * x35; a0 -= l1[0] * x36; a1 -= l1[1] * x37; a2 -= l1[2] * x38; a3 -= l1[3] * x39; a0 -= l2[0] * x40; a1 -= l2[1] * x41; a2 -= l2[2] * x42; a3 -= l2[3] * x43; a0 -= l3[0] * x44; a1 -= l3[1] * x45; a2 -= l3[2] * x46; a3 -= l3[3] * x47; a0 -= l4[0] * x48; a1 -= l4[1] * x49; a2 -= l4[2] * x50; a3 -= l4[3] * x51; a0 -= l5[0] * x52; a1 -= l5[1] * x53; a2 -= l5[2] * x54; a3 -= l5[3] * x55; a0 -= l6[0] * x56; a1 -= l6[1] * x57; a2 -= l6[2] * x58; x59 = (a0 + a1) + (a2 + a3); } INV_SB();
    l0 = INV_LD(60, 8); l1 = INV_LD(60, 9); l2 = INV_LD(60, 10); l3 = INV_LD(60, 11); l4 = INV_LD(60, 12); l5 = INV_LD(60, 13); l6 = INV_LD(60, 14); pb0 = INV_LD(61, 0); pb1 = INV_LD(61, 1); pb2 = INV_LD(61, 2); pb3 = INV_LD(61, 3); pb4 = INV_LD(61, 4); pb5 = INV_LD(61, 5); pb6 = INV_LD(61, 6); pb7 = INV_LD(61, 7); INV_SB();
    { int li = lane; asm volatile("" : "+v"(li)); float a0 = (li == 60) ? 1.f : 0.f, a1 = 0.f, a2 = 0.f, a3 = 0.f; a0 -= pa0[0] * x0; a1 -= pa0[1] * x1; a2 -= pa0[2] * x2; a3 -= pa0[3] * x3; a0 -= pa1[0] * x4; a1 -= pa1[1] * x5; a2 -= pa1[2] * x6; a3 -= pa1[3] * x7; a0 -= pa2[0] * x8; a1 -= pa2[1] * x9; a2 -= pa2[2] * x10; a3 -= pa2[3] * x11; a0 -= pa3[0] * x12; a1 -= pa3[1] * x13; a2 -= pa3[2] * x14; a3 -= pa3[3] * x15; a0 -= pa4[0] * x16; a1 -= pa4[1] * x17; a2 -= pa4[2] * x18; a3 -= pa4[3] * x19; a0 -= pa5[0] * x20; a1 -= pa5[1] * x21; a2 -= pa5[2] * x22; a3 -= pa5[3] * x23; a0 -= pa6[0] * x24; a1 -= pa6[1] * x25; a2 -= pa6[2] * x26; a3 -= pa6[3] * x27; a0 -= pa7[0] * x28; a1 -= pa7[1] * x29; a2 -= pa7[2] * x30; a3 -= pa7[3] * x31; a0 -= l0[0] * x32; a1 -= l0[1] * x33; a2 -= l0[2] * x34; a3 -= l0[3] * x35; a0 -= l1[0] * x36; a1 -= l1[1] * x37; a2 -= l1[2] * x38; a3 -= l1[3] * x39; a0 -= l2[0] * x40; a1 -= l2[1] * x41; a2 -= l2[2] * x42; a3 -= l2[3] * x43; a0 -= l3[0] * x44; a1 -= l3[1] * x45; a2 -= l3[2] * x46; a3 -= l3[3] * x47; a0 -= l4[0] * x48; a1 -= l4[1] * x49; a2 -= l4[2] * x50; a3 -= l4[3] * x51; a0 -= l5[0] * x52; a1 -= l5[1] * x53; a2 -= l5[2] * x54; a3 -= l5[3] * x55; a0 -= l6[0] * x56; a1 -= l6[1] * x57; a2 -= l6[2] * x58; a3 -= l6[3] * x59; x60 = (a0 + a1) + (a2 + a3); } INV_SB();
    l0 = INV_LD(61, 8); l1 = INV_LD(61, 9); l2 = INV_LD(61, 10); l3 = INV_LD(61, 11); l4 = INV_LD(61, 12); l5 = INV_LD(61, 13); l6 = INV_LD(61, 14); l7 = INV_LD(61, 15); pa0 = INV_LD(62, 0); pa1 = INV_LD(62, 1); pa2 = INV_LD(62, 2); pa3 = INV_LD(62, 3); pa4 = INV_LD(62, 4); pa5 = INV_LD(62, 5); pa6 = INV_LD(62, 6); pa7 = INV_LD(62, 7); INV_SB();
    { int li = lane; asm volatile("" : "+v"(li)); float a0 = (li == 61) ? 1.f : 0.f, a1 = 0.f, a2 = 0.f, a3 = 0.f; a0 -= pb0[0] * x0; a1 -= pb0[1] * x1; a2 -= pb0[2] * x2; a3 -= pb0[3] * x3; a0 -= pb1[0] * x4; a1 -= pb1[1] * x5; a2 -= pb1[2] * x6; a3 -= pb1[3] * x7; a0 -= pb2[0] * x8; a1 -= pb2[1] * x9; a2 -= pb2[2] * x10; a3 -= pb2[3] * x11; a0 -= pb3[0] * x12; a1 -= pb3[1] * x13; a2 -= pb3[2] * x14; a3 -= pb3[3] * x15; a0 -= pb4[0] * x16; a1 -= pb4[1] * x17; a2 -= pb4[2] * x18; a3 -= pb4[3] * x19; a0 -= pb5[0] * x20; a1 -= pb5[1] * x21; a2 -= pb5[2] * x22; a3 -= pb5[3] * x23; a0 -= pb6[0] * x24; a1 -= pb6[1] * x25; a2 -= pb6[2] * x26; a3 -= pb6[3] * x27; a0 -= pb7[0] * x28; a1 -= pb7[1] * x29; a2 -= pb7[2] * x30; a3 -= pb7[3] * x31; a0 -= l0[0] * x32; a1 -= l0[1] * x33; a2 -= l0[2] * x34; a3 -= l0[3] * x35; a0 -= l1[0] * x36; a1 -= l1[1] * x37; a2 -= l1[2] * x38; a3 -= l1[3] * x39; a0 -= l2[0] * x40; a1 -= l2[1] * x41; a2 -= l2[2] * x42; a3 -= l2[3] * x43; a0 -= l3[0] * x44; a1 -= l3[1] * x45; a2 -= l3[2] * x46; a3 -= l3[3] * x47; a0 -= l4[0] * x48; a1 -= l4[1] * x49; a2 -= l4[2] * x50; a3 -= l4[3] * x51; a0 -= l5[0] * x52; a1 -= l5[1] * x53; a2 -= l5[2] * x54; a3 -= l5[3] * x55; a0 -= l6[0] * x56; a1 -= l6[1] * x57; a2 -= l6[2] * x58; a3 -= l6[3] * x59; a0 -= l7[0] * x60; x61 = (a0 + a1) + (a2 + a3); } INV_SB();
    l0 = INV_LD(62, 8); l1 = INV_LD(62, 9); l2 = INV_LD(62, 10); l3 = INV_LD(62, 11); l4 = INV_LD(62, 12); l5 = INV_LD(62, 13); l6 = INV_LD(62, 14); l7 = INV_LD(62, 15); pb0 = INV_LD(63, 0); pb1 = INV_LD(63, 1); pb2 = INV_LD(63, 2); pb3 = INV_LD(63, 3); pb4 = INV_LD(63, 4); pb5 = INV_LD(63, 5); pb6 = INV_LD(63, 6); pb7 = INV_LD(63, 7); INV_SB();
    { int li = lane; asm volatile("" : "+v"(li)); float a0 = (li == 62) ? 1.f : 0.f, a1 = 0.f, a2 = 0.f, a3 = 0.f; a0 -= pa0[0] * x0; a1 -= pa0[1] * x1; a2 -= pa0[2] * x2; a3 -= pa0[3] * x3; a0 -= pa1[0] * x4; a1 -= pa1[1] * x5; a2 -= pa1[2] * x6; a3 -= pa1[3] * x7; a0 -= pa2[0] * x8; a1 -= pa2[1] * x9; a2 -= pa2[2] * x10; a3 -= pa2[3] * x11; a0 -= pa3[0] * x12; a1 -= pa3[1] * x13; a2 -= pa3[2] * x14; a3 -= pa3[3] * x15; a0 -= pa4[0] * x16; a1 -= pa4[1] * x17; a2 -= pa4[2] * x18; a3 -= pa4[3] * x19; a0 -= pa5[0] * x20; a1 -= pa5[1] * x21; a2 -= pa5[2] * x22; a3 -= pa5[3] * x23; a0 -= pa6[0] * x24; a1 -= pa6[1] * x25; a2 -= pa6[2] * x26; a3 -= pa6[3] * x27; a0 -= pa7[0] * x28; a1 -= pa7[1] * x29; a2 -= pa7[2] * x30; a3 -= pa7[3] * x31; a0 -= l0[0] * x32; a1 -= l0[1] * x33; a2 -= l0[2] * x34; a3 -= l0[3] * x35; a0 -= l1[0] * x36; a1 -= l1[1] * x37; a2 -= l1[2] * x38; a3 -= l1[3] * x39; a0 -= l2[0] * x40; a1 -= l2[1] * x41; a2 -= l2[2] * x42; a3 -= l2[3] * x43; a0 -= l3[0] * x44; a1 -= l3[1] * x45; a2 -= l3[2] * x46; a3 -= l3[3] * x47; a0 -= l4[0] * x48; a1 -= l4[1] * x49; a2 -= l4[2] * x50; a3 -= l4[3] * x51; a0 -= l5[0] * x52; a1 -= l5[1] * x53; a2 -= l5[2] * x54; a3 -= l5[3] * x55; a0 -= l6[0] * x56; a1 -= l6[1] * x57; a2 -= l6[2] * x58; a3 -= l6[3] * x59; a0 -= l7[0] * x60; a1 -= l7[1] * x61; x62 = (a0 + a1) + (a2 + a3); } INV_SB();
    l0 = INV_LD(63, 8); l1 = INV_LD(63, 9); l2 = INV_LD(63, 10); l3 = INV_LD(63, 11); l4 = INV_LD(63, 12); l5 = INV_LD(63, 13); l6 = INV_LD(63, 14); l7 = INV_LD(63, 15); INV_SB();
    { int li = lane; asm volatile("" : "+v"(li)); float a0 = (li == 63) ? 1.f : 0.f, a1 = 0.f, a2 = 0.f, a3 = 0.f; a0 -= pb0[0] * x0; a1 -= pb0[1] * x1; a2 -= pb0[2] * x2; a3 -= pb0[3] * x3; a0 -= pb1[0] * x4; a1 -= pb1[1] * x5; a2 -= pb1[2] * x6; a3 -= pb1[3] * x7; a0 -= pb2[0] * x8; a1 -= pb2[1] * x9; a2 -= pb2[2] * x10; a3 -= pb2[3] * x11; a0 -= pb3[0] * x12; a1 -= pb3[1] * x13; a2 -= pb3[2] * x14; a3 -= pb3[3] * x15; a0 -= pb4[0] * x16; a1 -= pb4[1] * x17; a2 -= pb4[2] * x18; a3 -= pb4[3] * x19; a0 -= pb5[0] * x20; a1 -= pb5[1] * x21; a2 -= pb5[2] * x22; a3 -= pb5[3] * x23; a0 -= pb6[0] * x24; a1 -= pb6[1] * x25; a2 -= pb6[2] * x26; a3 -= pb6[3] * x27; a0 -= pb7[0] * x28; a1 -= pb7[1] * x29; a2 -= pb7[2] * x30; a3 -= pb7[3] * x31; a0 -= l0[0] * x32; a1 -= l0[1] * x33; a2 -= l0[2] * x34; a3 -= l0[3] * x35; a0 -= l1[0] * x36; a1 -= l1[1] * x37; a2 -= l1[2] * x38; a3 -= l1[3] * x39; a0 -= l2[0] * x40; a1 -= l2[1] * x41; a2 -= l2[2] * x42; a3 -= l2[3] * x43; a0 -= l3[0] * x44; a1 -= l3[1] * x45; a2 -= l3[2] * x46; a3 -= l3[3] * x47; a0 -= l4[0] * x48; a1 -= l4[1] * x49; a2 -= l4[2] * x50; a3 -= l4[3] * x51; a0 -= l5[0] * x52; a1 -= l5[1] * x53; a2 -= l5[2] * x54; a3 -= l5[3] * x55; a0 -= l6[0] * x56; a1 -= l6[1] * x57; a2 -= l6[2] * x58; a3 -= l6[3] * x59; a0 -= l7[0] * x60; a1 -= l7[1] * x61; a2 -= l7[2] * x62; x63 = (a0 + a1) + (a2 + a3); } INV_SB();
    asm volatile("s_waitcnt lgkmcnt(0)" ::: "memory");
    As[0 * 65 + lane] = x0; As[1 * 65 + lane] = x1; As[2 * 65 + lane] = x2; As[3 * 65 + lane] = x3; As[4 * 65 + lane] = x4; As[5 * 65 + lane] = x5; As[6 * 65 + lane] = x6; As[7 * 65 + lane] = x7;
    As[8 * 65 + lane] = x8; As[9 * 65 + lane] = x9; As[10 * 65 + lane] = x10; As[11 * 65 + lane] = x11; As[12 * 65 + lane] = x12; As[13 * 65 + lane] = x13; As[14 * 65 + lane] = x14; As[15 * 65 + lane] = x15;
    As[16 * 65 + lane] = x16; As[17 * 65 + lane] = x17; As[18 * 65 + lane] = x18; As[19 * 65 + lane] = x19; As[20 * 65 + lane] = x20; As[21 * 65 + lane] = x21; As[22 * 65 + lane] = x22; As[23 * 65 + lane] = x23;
    As[24 * 65 + lane] = x24; As[25 * 65 + lane] = x25; As[26 * 65 + lane] = x26; As[27 * 65 + lane] = x27; As[28 * 65 + lane] = x28; As[29 * 65 + lane] = x29; As[30 * 65 + lane] = x30; As[31 * 65 + lane] = x31;
    As[32 * 65 + lane] = x32; As[33 * 65 + lane] = x33; As[34 * 65 + lane] = x34; As[35 * 65 + lane] = x35; As[36 * 65 + lane] = x36; As[37 * 65 + lane] = x37; As[38 * 65 + lane] = x38; As[39 * 65 + lane] = x39;
    As[40 * 65 + lane] = x40; As[41 * 65 + lane] = x41; As[42 * 65 + lane] = x42; As[43 * 65 + lane] = x43; As[44 * 65 + lane] = x44; As[45 * 65 + lane] = x45; As[46 * 65 + lane] = x46; As[47 * 65 + lane] = x47;
    As[48 * 65 + lane] = x48; As[49 * 65 + lane] = x49; As[50 * 65 + lane] = x50; As[51 * 65 + lane] = x51; As[52 * 65 + lane] = x52; As[53 * 65 + lane] = x53; As[54 * 65 + lane] = x54; As[55 * 65 + lane] = x55;
    As[56 * 65 + lane] = x56; As[57 * 65 + lane] = x57; As[58 * 65 + lane] = x58; As[59 * 65 + lane] = x59; As[60 * 65 + lane] = x60; As[61 * 65 + lane] = x61; As[62 * 65 + lane] = x62; As[63 * 65 + lane] = x63;
    asm volatile("s_waitcnt lgkmcnt(0)" ::: "memory");
}
__device__ __forceinline__ void dnf_load_x(const bf16* QKV, int u, int tid, unsigned (&xr)[36]) {
    const int c = u >> 4, kh = u & 15;
    int s0, s1; if (c < 64) { s0 = (c >> 2) * 256; s1 = s0 + 256; } else { s0 = 4096 + ((c - 64) >> 4) * 1024; s1 = s0 + 1024; }
    const int cp = tid & 255, th = tid >> 8;
    const int gcol = cp < 64 ? kh * 128 + 2 * cp : (cp < 128 ? 2048 + kh * 128 + 2 * (cp - 64) : 4096 + kh * 256 + 2 * (cp - 128));
    const int r0 = c * 64 + th * 32 - 2;
#pragma unroll
    for (int i = 0; i < 36; ++i) { const int rr = r0 + i; const bool ok = rr >= s0 && rr < s1; const unsigned v = *(const unsigned*)(QKV + (size_t)(ok ? rr : s0) * 8192 + gcol); xr[i] = ok ? v : 0u; }
}
__device__ __forceinline__ void phase_dn_front(const Params& p, LAS unsigned char* lds, int tid0, int lane0, int wave, int vcu, int G) {
    unsigned char* ws = p.ws; const int fl = p.flags;
    LAS float* XQK = (LAS float*)lds;
    LAS bf16* XV = (LAS bf16*)(lds + 66560);
    LAS float* Gm = (LAS float*)lds; LAS float* Pm = Gm + 64 * 65;
    LAS float* As = (LAS float*)(lds + 33280) + (wave & 3) * (64 * 68);
    LAS v4u* FB = (LAS v4u*)(lds + 105472);
    LAS float* RN = (LAS float*)(lds + 138240);
    LAS float* gcs = (LAS float*)(lds + 138752); LAS float* bes = gcs + 256;
    const bf16* QKV = (const bf16*)(ws + WS_QKV); const float* cw = p.in[11];
    const float* AB = (const float*)(ws + WS_AB); float* VEC = (float*)(ws + WS_VEC);
    unsigned xr[36]; float w0[5], w1[5];
    if (vcu < 1536) dnf_load_x(QKV, vcu, tid0, xr);
    for (int u = vcu; u < 1536; u += G) {
        const int c = u >> 4, kh = u & 15;
        int tid_o = tid0; asm volatile("" : "+v"(tid_o));
        const int tid = tid_o, lane = tid & 63, c16 = lane & 15, q4 = lane >> 4;
        if (!(fl & 4)) {
            const int cp = tid & 255, th = tid >> 8;
            int gcol, lcol; if (cp < 64) { gcol = kh * 128 + 2 * cp; lcol = 2 * cp; } else if (cp < 128) { gcol = 2048 + kh * 128 + 2 * (cp - 64); lcol = 128 + 2 * (cp - 64); } else { gcol = 4096 + kh * 256 + 2 * (cp - 128); lcol = 2 * (cp - 128); }
            if ((G & 15) != 0 || u == vcu) {
#pragma unroll
                for (int j = 0; j < 5; ++j) { w0[j] = cw[j * 8192 + gcol]; w1[j] = cw[j * 8192 + gcol + 1]; } }
#pragma unroll
            for (int i = 0; i < 32; ++i) {
                float a0 = 0.f, a1 = 0.f;
#pragma unroll
                for (int j = 0; j < 5; ++j) { a0 += w0[j] * bflo(xr[i + j]); a1 += w1[j] * bfhi(xr[i + j]); }
                a0 = silu_f(a0); a1 = silu_f(a1);
                const int t = th * 32 + i;
                if (cp < 128) *(LAS f32x2*)(XQK + t * 260 + lcol) = (f32x2){a0, a1}; else *(LAS unsigned*)(XV + t * 264 + lcol) = pk2(a0, a1);
            }
        }
        __syncthreads();
        if (!(fl & 4))
        { float ra[8][4];
#pragma unroll
          for (int tt = 0; tt < 8; ++tt) { const LAS float* r = XQK + (wave * 8 + tt) * 260; ra[tt][0] = r[lane]; ra[tt][1] = r[64 + lane]; ra[tt][2] = r[128 + lane]; ra[tt][3] = r[192 + lane]; }
          __builtin_amdgcn_sched_barrier(0);
          float sq[8], sk[8];
#pragma unroll
          for (int tt = 0; tt < 8; ++tt) { sq[tt] = ra[tt][0] * ra[tt][0] + ra[tt][1] * ra[tt][1]; sk[tt] = ra[tt][2] * ra[tt][2] + ra[tt][3] * ra[tt][3]; }
#pragma unroll
          for (int o = 1; o < 64; o <<= 1) {
#pragma unroll
              for (int tt = 0; tt < 8; ++tt) { sq[tt] += __shfl_xor(sq[tt], o); sk[tt] += __shfl_xor(sk[tt], o); } }
#pragma unroll
          for (int tt = 0; tt < 8; ++tt) if (lane == tt) { const int t = wave * 8 + tt; RN[t] = (1.0f / sqrtf(sq[tt] + 1e-6f)) * 0.08838834764831845f; RN[64 + t] = 1.0f / sqrtf(sk[tt] + 1e-6f); } }
        __syncthreads();
        if (!(fl & 2)) {
            v4u* KAo = (v4u*)(ws + WS_KA) + (size_t)u * 1024; v4u* QAo = (v4u*)(ws + WS_QA) + (size_t)u * 1024; v4u* KTo = (v4u*)(ws + WS_KT) + (size_t)u * 1024;
            v4u* VTo = (v4u*)(ws + WS_VT) + (size_t)(c * 32 + 2 * kh) * 1024;
            for (int pi = tid; pi < 1024; pi += 512) {
                const int mt = pi >> 8, ks = (pi >> 6) & 3, ln = pi & 63, t = 16 * mt + (ln & 15), kq = ln >> 4;
                const LAS float* rq = XQK + t * 260 + 32 * ks + 4 * kq;
                const v4u oq = pack8f(*(const LAS f32x4*)rq * RN[t], *(const LAS f32x4*)(rq + 16) * RN[t]);
                const v4u ok = pack8f(*(const LAS f32x4*)(rq + 128) * RN[64 + t], *(const LAS f32x4*)(rq + 144) * RN[64 + t]);
                QAo[pi] = oq; KAo[pi] = ok; FB[pi] = ok; FB[1024 + pi] = oq;
            }
            for (int pi = tid; pi < 1024; pi += 512) {
                const int mt = pi >> 7, ks = (pi >> 6) & 1, ln = pi & 63, dk = 16 * mt + (ln & 15), kq = ln >> 4, tb = 32 * ks + 4 * kq;
                float e[8], rn[8];
#pragma unroll
                for (int j = 0; j < 8; ++j) { const int t = tb + 16 * (j >> 2) + (j & 3); e[j] = XQK[t * 260 + 128 + dk]; rn[j] = RN[64 + t]; }
                __builtin_amdgcn_sched_barrier(0);
#pragma unroll
                for (int j = 0; j < 8; ++j) e[j] *= rn[j];
                v4u o; o.x = pk2(e[0], e[1]); o.y = pk2(e[2], e[3]); o.z = pk2(e[4], e[5]); o.w = pk2(e[6], e[7]); KTo[pi] = o;
            }
            for (int pi = tid; pi < 2048; pi += 512) {
                const int e2 = pi >> 10, q = pi & 1023, sl = q >> 7, hf = (q >> 6) & 1, ln = q & 63, dv = 16 * sl + (ln & 15), qq = ln >> 4;
                unsigned e[8];
#pragma unroll
                for (int j = 0; j < 8; ++j) { const int t = 16 * (2 * hf + (j >> 2)) + 4 * qq + (j & 3); e[j] = XV[t * 264 + e2 * 128 + dv]; }
                __builtin_amdgcn_sched_barrier(0);
                v4u o; o.x = e[0] | (e[1] << 16); o.y = e[2] | (e[3] << 16); o.z = e[4] | (e[5] << 16); o.w = e[6] | (e[7] << 16); VTo[pi] = o;
            }
            if (wave < 4) {
                const int su = wave, d = su & 1, h = 2 * kh + (su >> 1); const size_t row = (size_t)64 * c + lane;
                const float a = AB[row * 128 + d * 64 + h], b = AB[row * 128 + d * 64 + 32 + h];
                const float x = a + p.in[13][d * 32 + h], sp = x > 20.f ? x : log1pf(expf(x));
                const float lg = -expf(p.in[12][d * 32 + h]) * sp, beta = 1.0f / (1.0f + expf(-b));
                float pre = lg;
#pragma unroll
                for (int o = 1; o < 64; o <<= 1) { const float v = __shfl_up(pre, o); if (lane >= o) pre += v; }
                const float total = __shfl(pre, 63);
                const float gc = d ? (total - pre + lg) : pre;
                gcs[su * 64 + lane] = gc; bes[su * 64 + lane] = beta;
                float* V = VEC + (size_t)((c * 32 + h) * 2 + d) * 192; V[lane] = expf(gc); V[64 + lane] = expf(total - gc); if (lane == 0) V[128] = expf(total);
            }
        }
        __syncthreads();
        if (!(fl & 8)) {
            const int mat = wave >> 2, mt = wave & 3;
            bf16x8 af[4];
#pragma unroll
            for (int ks = 0; ks < 4; ++ks) af[ks] = as_frag(FB[(mat ? 1024 : 0) + (mt * 4 + ks) * 64 + lane]);
            LAS float* M = mat ? Pm : Gm;
#pragma unroll
            for (int nt = 0; nt < 4; ++nt) { f32x4 acc = {0.f, 0.f, 0.f, 0.f};
#pragma unroll
                for (int ks = 0; ks < 4; ++ks) acc = MFMA16(af[ks], as_frag(FB[(nt * 4 + ks) * 64 + lane]), acc);
#pragma unroll
                for (int r = 0; r < 4; ++r) M[(16 * mt + 4 * q4 + r) * 65 + 16 * nt + c16] = acc[r]; }
        }
        __syncthreads();
        if (fl & 1) { } else if (wave < 4) {
            const int su = wave, d = su & 1, h = 2 * kh + (su >> 1);
            const LAS float* gc_ = gcs + su * 64; const LAS float* be_ = bes + su * 64;
            { const int j = d ? 63 - lane : lane; const float gcj = gc_[j];
#pragma unroll
              for (int b0 = 0; b0 < 64; b0 += 16) { float gi[16], bi[16], gm[16];
#pragma unroll
                  for (int k = 0; k < 16; ++k) { const int ip = b0 + k, i = d ? 63 - ip : ip; gi[k] = gc_[i]; bi[k] = be_[i]; gm[k] = Gm[i * 65 + j]; }
                  __builtin_amdgcn_sched_barrier(0);
#pragma unroll
                  for (int k = 0; k < 16; ++k) { const int ip = b0 + k; As[ip * 68 + lane] = (lane < ip) ? bi[k] * gm[k] * __expf(fminf(gi[k] - gcj, 0.f)) : 0.f; }
                  __builtin_amdgcn_sched_barrier(0); } }
            LDS_WAIT();
            tri_inverse_64(As, lane);
            if (u + G < 1536) dnf_load_x(QKV, u + G, tid, xr);
            int c16b = c16, q4b = q4; asm volatile("" : "+v"(c16b), "+v"(q4b));
            v4u* TBo = (v4u*)(ws + WS_TB) + (size_t)((c * 32 + h) * 2 + d) * 512 + 16 * q4b + c16b;
#pragma unroll
            for (int ps = 0; ps < 8; ++ps) { const int mt = ps >> 1, ks = ps & 1, i = 16 * mt + c16b, ip = d ? 63 - i : i; float e[8];
                float bb[8];
#pragma unroll
                for (int k = 0; k < 8; ++k) { const int cc = 32 * ks + 16 * (k >> 2) + 4 * q4b + (k & 3), cp = d ? 63 - cc : cc; e[k] = As[ip * 65 + cp]; bb[k] = be_[cc]; }
                __builtin_amdgcn_sched_barrier(0);
#pragma unroll
                for (int k = 0; k < 8; ++k) e[k] *= bb[k];
                v4u o; o.x = pk2(e[0], e[1]); o.y = pk2(e[2], e[3]); o.z = pk2(e[4], e[5]); o.w = pk2(e[6], e[7]); TBo[ps * 64] = o; asm volatile("" ::: "memory"); }
        } else {
            const int su = wave - 4, d = su & 1, h = 2 * kh + (su >> 1);
            if (u + G < 1536) dnf_load_x(QKV, u + G, tid, xr);
            const LAS float* gc_ = gcs + su * 64;
            v4u* INo = (v4u*)(ws + WS_IN) + (size_t)((c * 32 + h) * 2 + d) * 512 + lane;
#pragma unroll
            for (int ps = 0; ps < 8; ++ps) { const int mt = ps >> 1, ks = ps & 1, i = 16 * mt + c16; const float gci = gc_[i]; float e[8];
                float gj[8];
#pragma unroll
                for (int k = 0; k < 8; ++k) { const int jn = 32 * ks + 16 * (k >> 2) + 4 * q4 + (k & 3); e[k] = Pm[i * 65 + jn]; gj[k] = gc_[jn]; }
                __builtin_amdgcn_sched_barrier(0);
#pragma unroll
                for (int k = 0; k < 8; ++k) { const int jn = 32 * ks + 16 * (k >> 2) + 4 * q4 + (k & 3); const bool ok = d ? (jn >= i) : (jn <= i);
                    e[k] = ok ? e[k] * __expf(fminf(gci - gj[k], 0.f)) : 0.f; }
                v4u o; o.x = pk2(e[0], e[1]); o.y = pk2(e[2], e[3]); o.z = pk2(e[4], e[5]); o.w = pk2(e[6], e[7]); INo[ps * 64] = o; asm volatile("" ::: "memory"); }
        }
        __syncthreads();
    }
}

#ifndef DQ_SYNC
#define DQ_SYNC 0
#endif
constexpr int DQ_BUF = 50176, DQ_QA = 0, DQ_KT = 16384, DQ_TB = 32768, DQ_IN = 40960, DQ_VEC = 49152, DQ_KA = 2 * DQ_BUF, DQ_V = DQ_KA + 16384;
struct DnStep { int c, h, d; };
__device__ __forceinline__ void dq_group(int gi, int& lat, int& seq, int& h, int& d) { lat = gi < 128; const int gj = lat ? gi : gi - 128; seq = lat ? 16 + (gj >> 6) : (gj >> 6); h = (gj >> 1) & 31; d = gj & 1; }
__device__ __forceinline__ int dq_chunk(int lat, int seq, int d, int n) { const int nch = lat ? 16 : 4, cbase = lat ? 64 + 16 * (seq - 16) : 4 * seq; return cbase + (d ? nch - 1 - n : n); }
#define DMA16(gsrc, ldst) __builtin_amdgcn_global_load_lds((const unsigned*)(gsrc), (LAS unsigned*)(ldst), 16, 0, 0)
__device__ __forceinline__ void dq_issue_db(unsigned char* ws, LAS unsigned char* buf, const DnStep st, int wave, int lane) {
    const int kh = st.h >> 1; const size_t ck = (size_t)(st.c * 16 + kh) * 16384, chd = (size_t)((st.c * 32 + st.h) * 2 + st.d);
    const unsigned char* qa = ws + WS_QA + ck + lane * 16; const unsigned char* kt = ws + WS_KT + ck + lane * 16;
    const unsigned char* tb = ws + WS_TB + chd * 8192 + lane * 16; const unsigned char* in = ws + WS_IN + chd * 8192 + lane * 16;
#pragma unroll
    for (int i = 0; i < 2; ++i) { const int pc = wave + 8 * i; DMA16(qa + pc * 1024, buf + DQ_QA + pc * 1024); DMA16(kt + pc * 1024, buf + DQ_KT + pc * 1024); }
    DMA16(tb + wave * 1024, buf + DQ_TB + wave * 1024); DMA16(in + wave * 1024, buf + DQ_IN + wave * 1024);
    if (wave == 0) DMA16(ws + WS_VEC + chd * 768 + lane * 16, buf + DQ_VEC);
}
__device__ __forceinline__ void dq_issue_sb(unsigned char* ws, LAS unsigned char* lds, const DnStep st, int wave, int lane) {
    const int kh = st.h >> 1; const unsigned char* ka = ws + WS_KA + (size_t)(st.c * 16 + kh) * 16384 + lane * 16;
    const unsigned char* vt = ws + WS_VT + (size_t)(st.c * 32 + st.h) * 16384 + wave * 2048 + lane * 16;
#pragma unroll
    for (int i = 0; i < 2; ++i) { const int pc = wave + 8 * i; DMA16(ka + pc * 1024, lds + DQ_KA + pc * 1024); DMA16(vt + i * 1024, lds + DQ_V + wave * 2048 + i * 1024); }
}
__device__ __forceinline__ bf16x8 pack2(const f32x4 a, const f32x4 b) { return __builtin_bit_cast(bf16x8, pack8f(a, b)); }
__device__ __forceinline__ void phase_dn_seq(const Params& p, LAS unsigned char* lds, int lane, int wave, int vcu, int G) {
    unsigned char* ws = p.ws;
    const int c16 = lane & 15, q4 = lane >> 4;
    const int total_groups = (G == 256) ? (vcu < 128 ? 3 : 6) : ((1152 - vcu + G - 1) / G);
#define DQ_GROUP_AT(gp) ((G == 256) ? (vcu < 128 ? ((gp) == 0 ? vcu : 128 + 2 * vcu + (gp) - 1) : 384 + 6 * (vcu - 128) + (gp)) : vcu + (gp) * G)
    int gpos = 0, gi = DQ_GROUP_AT(0), n = 0, lat = 0, seq = 0, h = 0, d = 0, nch = 0;
    if (total_groups <= 0 || gi >= 1152) return;
    dq_group(gi, lat, seq, h, d); nch = lat ? 16 : 4;
    DnStep cur{dq_chunk(lat, seq, d, 0), h, d};
    dq_issue_db(ws, lds, cur, wave, lane); dq_issue_sb(ws, lds, cur, wave, lane);
    asm volatile("s_waitcnt vmcnt(0)\n\ts_barrier" ::: "memory");
    f32x4 S[8];
    int par = 0;
    for (;;) {
        if (n == 0) {
            if (lat) { const float* stp = p.in[d ? 3 : 2] + (size_t)((seq - 16) * 32 + h) * 16384 + 16 * wave + c16;
#pragma unroll
                for (int dt = 0; dt < 8; ++dt)
#pragma unroll
                    for (int r = 0; r < 4; ++r) S[dt][r] = stp[(16 * dt + 4 * q4 + r) * 128];
            } else {
#pragma unroll
                for (int dt = 0; dt < 8; ++dt) S[dt] = (f32x4){0.f, 0.f, 0.f, 0.f}; }
        }
        int n_gpos = gpos, n_gi = gi, n_n = n + 1, n_lat = lat, n_seq = seq, n_h = h, n_d = d; bool has_next = true;
        if (n_n == nch) { n_n = 0; n_gpos = gpos + 1; if (n_gpos >= total_groups) has_next = false; else { n_gi = DQ_GROUP_AT(n_gpos); dq_group(n_gi, n_lat, n_seq, n_h, n_d); } }
        const DnStep nxt{has_next ? dq_chunk(n_lat, n_seq, n_d, n_n) : cur.c, n_h, n_d};
        LAS unsigned char* buf = lds + par * DQ_BUF;
#if DQ_SYNC
        if (n != 0 || gpos != 0) { dq_issue_db(ws, buf, cur, wave, lane); dq_issue_sb(ws, lds, cur, wave, lane); asm volatile("s_waitcnt vmcnt(0)\n\ts_barrier" ::: "memory"); }
#endif
        bf16x8 Sb[4];
#pragma unroll
        for (int ks = 0; ks < 4; ++ks) Sb[ks] = pack2(S[2 * ks], S[2 * ks + 1]);
        if (has_next && !DQ_SYNC) dq_issue_db(ws, lds + (par ^ 1) * DQ_BUF, nxt, wave, lane);
        const LAS float* vec = (const LAS float*)(buf + DQ_VEC);
        f32x4 R[4];
        { const v4u v0 = *(const LAS v4u*)(lds + DQ_V + wave * 2048 + lane * 16), v1 = *(const LAS v4u*)(lds + DQ_V + wave * 2048 + 1024 + lane * 16);
          const f32x4 V[4] = {{bflo(v0.x), bfhi(v0.x), bflo(v0.y), bfhi(v0.y)}, {bflo(v0.z), bfhi(v0.z), bflo(v0.w), bfhi(v0.w)}, {bflo(v1.x), bfhi(v1.x), bflo(v1.y), bfhi(v1.y)}, {bflo(v1.z), bfhi(v1.z), bflo(v1.w), bfhi(v1.w)}};
#pragma unroll
          for (int mt = 0; mt < 4; ++mt) { f32x4 acc = {0.f, 0.f, 0.f, 0.f};
#pragma unroll
              for (int ks = 0; ks < 4; ++ks) acc = MFMA16(as_frag(*(const LAS v4u*)(lds + DQ_KA + ((mt * 4 + ks) * 64 + lane) * 16)), Sb[ks], acc);
              const f32x4 eg = *(const LAS f32x4*)(vec + 16 * mt + 4 * q4);
              R[mt] = V[mt] - eg * acc; } }
        const bf16x8 Rb[2] = {pack2(R[0], R[1]), pack2(R[2], R[3])};
        asm volatile("s_waitcnt lgkmcnt(0)\n\ts_barrier" ::: "memory");
        if (has_next && !DQ_SYNC) dq_issue_sb(ws, lds, nxt, wave, lane);
        f32x4 vn[4];
#pragma unroll
        for (int mt = 0; mt < 4; ++mt) { f32x4 acc = {0.f, 0.f, 0.f, 0.f};
#pragma unroll
            for (int ks = 0; ks < 2; ++ks) acc = MFMA16(as_frag(*(const LAS v4u*)(buf + DQ_TB + ((mt * 2 + ks) * 64 + lane) * 16)), Rb[ks], acc);
            vn[mt] = acc; }
        const bf16x8 vb[2] = {pack2(vn[0], vn[1]), pack2(vn[2], vn[3])};
#pragma unroll
        for (int mt = 0; mt < 4; ++mt) vn[mt] = vn[mt] * *(const LAS f32x4*)(vec + 64 + 16 * mt + 4 * q4);
        const bf16x8 vd[2] = {pack2(vn[0], vn[1]), pack2(vn[2], vn[3])};
        { bf16* op = (bf16*)(ws + WS_QKV) + (size_t)cur.d * MROWS * 4096 + (size_t)(64 * cur.c + 4 * q4) * 4096 + cur.h * 128 + 16 * wave + c16;
#pragma unroll
          for (int mt = 0; mt < 4; ++mt) { f32x4 acc = {0.f, 0.f, 0.f, 0.f};
#pragma unroll
              for (int ks = 0; ks < 4; ++ks) acc = MFMA16(as_frag(*(const LAS v4u*)(buf + DQ_QA + ((mt * 4 + ks) * 64 + lane) * 16)), Sb[ks], acc);
              acc = acc * *(const LAS f32x4*)(vec + 16 * mt + 4 * q4);
#pragma unroll
              for (int ks = 0; ks < 2; ++ks) acc = MFMA16(as_frag(*(const LAS v4u*)(buf + DQ_IN + ((mt * 2 + ks) * 64 + lane) * 16)), vb[ks], acc);
#pragma unroll
              for (int r = 0; r < 4; ++r) op[(size_t)(16 * mt + r) * 4096] = (bf16)f2bf(acc[r]); } }
        { const float egl = vec[128];
#pragma unroll
          for (int dt = 0; dt < 8; ++dt) { f32x4 acc = S[dt] * egl;
#pragma unroll
              for (int ks = 0; ks < 2; ++ks) acc = MFMA16(as_frag(*(const LAS v4u*)(buf + DQ_KT + ((dt * 2 + ks) * 64 + lane) * 16)), vd[ks], acc);
              S[dt] = acc; } }
        if (n + 1 == nch && !lat) {
            float* so = p.out + (d ? OUT_SB : OUT_SF) + (size_t)(seq * 32 + h) * 16384 + 16 * wave + c16;
#pragma unroll
            for (int dt = 0; dt < 8; ++dt)
#pragma unroll
                for (int r = 0; r < 4; ++r) so[(16 * dt + 4 * q4 + r) * 128] = S[dt][r]; }
        asm volatile("s_waitcnt vmcnt(0) lgkmcnt(0)\n\ts_barrier" ::: "memory");
        if (!has_next) break;
        gpos = n_gpos; gi = n_gi; n = n_n; lat = n_lat; seq = n_seq; h = n_h; d = n_d; nch = lat ? 16 : 4; cur = nxt; par ^= 1;
    }
}

__device__ __forceinline__ void phase_combine(const Params& p, int lane, int wave, int vcu, int G) {
    unsigned char* ws = p.ws;
    const bf16* OF = (const bf16*)(ws + WS_QKV); const bf16* OB = OF + (size_t)MROWS * 4096; const bf16* Z = (const bf16*)(ws + WS_Z); bf16* OG = (bf16*)(ws + WS_KA);
    const int gw = vcu * NWAVES + wave, NGW = G * NWAVES, half = lane >> 5, l32 = lane & 31;
    const f32x4 nw = *(const f32x4*)(p.in[14] + 4 * l32);
    for (int it = gw; it < MROWS * 16; it += NGW) {
        const int row = it >> 4, hv = (it & 15) * 2 + half; const size_t off = (size_t)row * 4096 + hv * 128 + 4 * l32;
        const v2u a = *(const v2u*)(OF + off), b = *(const v2u*)(OB + off), z = *(const v2u*)(Z + off);
        f32x4 o = {bflo(a.x) + bflo(b.x), bfhi(a.x) + bfhi(b.x), bflo(a.y) + bflo(b.y), bfhi(a.y) + bfhi(b.y)};
        float ss = (o[0] * o[0] + o[1] * o[1]) + (o[2] * o[2] + o[3] * o[3]);
#pragma unroll
        for (int m = 1; m < 32; m <<= 1) ss += __shfl_xor(ss, m);
        const float r = 1.0f / sqrtf(ss * (1.0f / 128.0f) + 1e-6f);
        const f32x4 zz = {silu_f(bflo(z.x)), silu_f(bfhi(z.x)), silu_f(bflo(z.y)), silu_f(bfhi(z.y))};
        const f32x4 y = o * r * nw * zz; v2u w; w.x = pk2(y[0], y[1]); w.y = pk2(y[2], y[3]); *(v2u*)(OG + off) = w;
    }
}

__device__ __forceinline__ void phase_spatial(const Params& p, LAS unsigned char* lds, int tid, int lane, int wave, int vcu, int G) {
    unsigned char* ws = p.ws;
    LAS bf16* VL = (LAS bf16*)lds;
    LAS float* RS = (LAS float*)(lds + 67584);
    const bf16* H = (const bf16*)(ws + WS_QKV); bf16* UV = (bf16*)(ws + WS_Z); const float* STATS = (const float*)(ws + WS_STATS);
    for (int u = vcu; u < 768; u += G) {
        const int tc = u >> 4, g = u & 15;
        __syncthreads();
        { const int q = tid >> 2, part = tid & 3; const f32x2* st = (const f32x2*)(STATS + (size_t)(128 * tc + q) * 128) + part * 16; float s1 = 0.f, s2 = 0.f;
#pragma unroll
            for (int i = 0; i < 16; ++i) { const f32x2 x = st[i]; s1 += x[0]; s2 += x[1]; }
            s1 += __shfl_xor(s1, 1); s1 += __shfl_xor(s1, 2); s2 += __shfl_xor(s2, 1); s2 += __shfl_xor(s2, 2);
            const float mu = s1 * (1.0f / 4096.0f), var = s2 * (1.0f / 4096.0f) - mu * mu;
            if (part == 0) { RS[2 * q] = mu; RS[2 * q + 1] = 1.0f / sqrtf(fmaxf(var, 0.f) + 1e-6f); } }
        __syncthreads();
        for (int pi = tid; pi < 4096; pi += 512) { const int q = pi >> 5, c8 = pi & 31;
            const v4u raw = *(const v4u*)(H + (size_t)(128 * tc + q) * 8192 + 4096 + 256 * g + 8 * c8);
            const float mu = RS[2 * q], rs = RS[2 * q + 1];
            const float* lw = p.in[18] + 256 * g + 8 * c8; const float* lb = p.in[19] + 256 * g + 8 * c8;
            const f32x4 w0 = *(const f32x4*)lw, w1 = *(const f32x4*)(lw + 4), b0 = *(const f32x4*)lb, b1 = *(const f32x4*)(lb + 4);
            const f32x4 x0 = {bflo(raw.x), bfhi(raw.x), bflo(raw.y), bfhi(raw.y)}, x1 = {bflo(raw.z), bfhi(raw.z), bflo(raw.w), bfhi(raw.w)};
            const f32x4 y0 = (x0 - mu) * rs * w0 + b0, y1 = (x1 - mu) * rs * w1 + b1;
            v4u o; o.x = pk2(y0[0], y0[1]); o.y = pk2(y0[2], y0[3]); o.z = pk2(y1[0], y1[1]); o.w = pk2(y1[2], y1[3]);
            *(LAS v4u*)(VL + q * 264 + 8 * c8) = o; }
        __syncthreads();
        const int col = 32 * wave + (lane & 31), hh = lane >> 5;
        bf16x8 bfr[8];
#pragma unroll
        for (int s = 0; s < 8; ++s) {
#pragma unroll
            for (int e = 0; e < 8; ++e) bfr[s][e] = (short)VL[(16 * s + 8 * hh + e) * 264 + col]; }
        f32x16 acc[4];
#pragma unroll
        for (int rb = 0; rb < 4; ++rb)
#pragma unroll
            for (int e = 0; e < 16; ++e) acc[rb][e] = 0.f;
        const bf16* Wb = (const bf16*)(ws + WS_WSB) + (size_t)g * 16384;
#pragma unroll
        for (int rb = 0; rb < 4; ++rb)
#pragma unroll
            for (int s = 0; s < 8; ++s) { const bf16x8 a = *(const bf16x8*)(Wb + (32 * rb + (lane & 31)) * 128 + 16 * s + 8 * hh); acc[rb] = __builtin_amdgcn_mfma_f32_32x32x16_bf16(a, bfr[s], acc[rb], 0, 0, 0); }
        const float* bs = p.in[21] + g * 128;
#pragma unroll
        for (int rb = 0; rb < 4; ++rb)
#pragma unroll
            for (int e = 0; e < 16; ++e) { const int pr = 32 * rb + (e & 3) + 8 * (e >> 2) + 4 * hh; const size_t row = (size_t)(128 * tc + pr);
                const float val = acc[rb][e] + bs[pr]; const float uu = bf2f(H[row * 8192 + 256 * g + col]); UV[row * 4096 + 256 * g + col] = (bf16)f2bf(uu * val); }
    }
}

#define XB_TMO      128
#define XB_XCNT(j)  (256  + 64 * (j))
#define XB_XSUB(j)  (1280 + 64 * (j))
#define XB_XGEN(j)  (2304 + 64 * (j))
#define XB_TOP      3328
#define XB_TOPGEN   3392
#define XCD_BAR_WORDS 3456
#define XB_SPIN_CAP (1u << 18)

__device__ __forceinline__ unsigned xb_ld(unsigned* p)              { return __hip_atomic_load(p, __ATOMIC_RELAXED, __HIP_MEMORY_SCOPE_AGENT); }
__device__ __forceinline__ unsigned xb_add(unsigned* p, unsigned v) { return __hip_atomic_fetch_add(p, v, __ATOMIC_RELAXED, __HIP_MEMORY_SCOPE_AGENT); }
__device__ __forceinline__ unsigned xb_xcc_id() { return (unsigned)__builtin_amdgcn_s_getreg((3 << 11) | 20) & 0xFu; }
#define XB_SPIN(cond, bar) do { unsigned _sp = 0; while (cond) { __builtin_amdgcn_s_sleep(1); \
    if ((++_sp & 255u) == 0u) { if (xb_ld(&(bar)[XB_TMO])) break; if (_sp > XB_SPIN_CAP) { atomicAdd(&(bar)[XB_TMO], 1u); break; } } } } while (0)

struct XcdBarrier {
    unsigned* bar; unsigned x;
    volatile LAS unsigned* st;
};

__device__ __forceinline__ XcdBarrier xcd_barrier_post(unsigned* bar, volatile LAS unsigned* st) {
    XcdBarrier b; b.bar = bar; b.x = xb_xcc_id(); b.st = st;
    if (threadIdx.x == 0) (void)xb_add(&bar[XB_XCNT(b.x)], 1u);
    return b;
}
__device__ __forceinline__ void xcd_barrier_complete(unsigned* bar, unsigned x, unsigned& nloc, unsigned& nx) {
    const unsigned G = gridDim.x * gridDim.y * gridDim.z;
    unsigned sum, cnt, mine, sp = 0u;
    for (;;) {
        sum = 0u; cnt = 0u; mine = 0u;
#pragma unroll
        for (unsigned j = 0; j < 16; ++j) { const unsigned c = xb_ld(&bar[XB_XCNT(j)]); sum += c; cnt += (c > 0u) ? 1u : 0u; mine = (j == x) ? c : mine; }
        if (sum == G) break;
        __builtin_amdgcn_s_sleep(1);
        if ((++sp & 255u) == 0u) { if (xb_ld(&bar[XB_TMO])) break; if (sp > XB_SPIN_CAP) { atomicAdd(&bar[XB_TMO], 1u); break; } }
    }
    nloc = mine > 0u ? mine : 1u; nx = cnt > 0u ? cnt : 1u;
}

__device__ __forceinline__ void xcd_barrier(const XcdBarrier& b) {
    asm volatile("s_waitcnt vmcnt(0)" ::: "memory");
    __syncthreads();
    if (threadIdx.x == 0) {
        unsigned* bar = b.bar;
        __builtin_amdgcn_s_waitcnt(0);
        unsigned nloc = b.st[0], nx = b.st[1];
        if (nloc == 0u) { xcd_barrier_complete(bar, b.x, nloc, nx); b.st[0] = nloc; b.st[1] = nx; }
        const unsigned old = xb_add(&bar[XB_XSUB(b.x)], 1u);
        const unsigned gen = old / nloc;
        if (old + 1u == (gen + 1u) * nloc) {
            __builtin_amdgcn_fence(__ATOMIC_RELEASE, "agent");
            asm volatile("s_waitcnt vmcnt(0)" ::: "memory");
            const unsigned og = xb_add(&bar[XB_TOP], 1u);
            const unsigned tg = og / nx;
            if (og + 1u == (tg + 1u) * nx) xb_add(&bar[XB_TOPGEN], 1u);
            else XB_SPIN(xb_ld(&bar[XB_TOPGEN]) == tg, bar);
            __builtin_amdgcn_fence(__ATOMIC_ACQUIRE, "agent");
            xb_add(&bar[XB_XGEN(b.x)], 1u);
            asm volatile("s_waitcnt vmcnt(0)" ::: "memory");
        } else {
            XB_SPIN(xb_ld(&bar[XB_XGEN(b.x)]) == gen, bar);
            __builtin_amdgcn_fence(__ATOMIC_ACQUIRE, "agent");
            asm volatile("s_waitcnt vmcnt(0)" ::: "memory");
        }
    }
    __syncthreads();
}

constexpr int XB_LDS_OFF = LDS_BYTES - 256, CW_BAR = 4096;
__device__ __forceinline__ int rep_opaque(int v) { if (v == 0) return 0; asm volatile("" : "+s"(v)); return v; }
#ifndef DN_NAIVE
#define DN_NAIVE 0
#endif
#ifndef USE_CG_SYNC
#define USE_CG_SYNC 0
#endif
constexpr int NPHASE = 19;
__global__ void __launch_bounds__(NWAVES * 64, 2) mega_fwd(Params p) {
    extern __shared__ __attribute__((aligned(16))) unsigned char lds_raw[];
    LAS unsigned char* lds = (LAS unsigned char*)lds_raw;
    const int tid = threadIdx.x, lane = tid & 63, wave = __builtin_amdgcn_readfirstlane(tid >> 6);
    const int G = gridDim.x, bx = blockIdx.x, vcu = (G % 8 == 0) ? (bx % 8) * (G / 8) + bx / 8 : bx;
    unsigned char* ws = p.ws;
    const int lo = p.ph_lo, hi = p.ph_hi;
    XcdBarrier bar; bar.bar = (unsigned*)(ws + WS_CTL) + CW_BAR; bar.x = 0; bar.st = (volatile LAS unsigned*)(lds + XB_LDS_OFF);
    if (!USE_CG_SYNC && hi - lo > 1) {
        if (tid < 64) ((volatile LAS unsigned*)(lds + XB_LDS_OFF))[tid] = 0u;
        __syncthreads();
        bar = xcd_barrier_post((unsigned*)(ws + WS_CTL) + CW_BAR, (volatile LAS unsigned*)(lds + XB_LDS_OFF));
    }
#ifndef PH_MASK
#define PH_MASK 0xFFFFFFFFu
#endif
#ifndef REP_MASK
#define REP_MASK 0u
#endif
#ifndef HOST_REP_MASK
#define HOST_REP_MASK 0u
#endif
#ifndef HOST_VAR_FLAGS
#define HOST_VAR_FLAGS 0
#endif
#define REP(k) ((int)((REP_MASK >> (k)) & 1u))
#define IN(k) (((PH_MASK >> (k)) & 1u) && lo <= (k) && (k) < hi)
#define SEAM(k) do { if (IN(k) && (IN((k) + 1) || ((k) == 3 && IN(5)))) { if (USE_CG_SYNC) cg::this_grid().sync(); else xcd_barrier(bar); } STAMP((k) + 1); } while (0)
#ifdef PROBE_A_LO
    unsigned long long* TS = (unsigned long long*)(ws + WS_CTL + 1024);
#define STAMP(k) do { if (bx == 0 && tid == 0) __hip_atomic_store(TS + (k), __builtin_amdgcn_s_memrealtime(), __ATOMIC_RELAXED, __HIP_MEMORY_SCOPE_AGENT); } while (0)
#else
#define STAMP(k) do { } while (0)
#endif
    const float* MOD = (const float*)(ws + WS_MOD); const float* ZG = (const float*)(ws + WS_CTL + 65536);
    bf16* XN = (bf16*)(ws + WS_XN); float* X = (float*)(ws + WS_X); bf16* Hb = (bf16*)(ws + WS_QKV);

    STAMP(0);
    if (IN(0)) _Pragma("nounroll") for (int rep_ = 0, nrep_ = rep_opaque(REP(0)); rep_ <= nrep_; ++rep_) { phase_prologue(p, lds, tid, lane, wave, vcu, G); } SEAM(0);
    if (IN(1)) _Pragma("nounroll") for (int rep_ = 0, nrep_ = rep_opaque(REP(1)); rep_ <= nrep_; ++rep_) { phase_norm<0>(p, 0, 0, lane, wave, vcu, G); } SEAM(1);
    if (IN(2)) _Pragma("nounroll") for (int rep_ = 0, nrep_ = rep_opaque(REP(2)); rep_ <= nrep_; ++rep_) { pg8::Gemm g{XN, (const bf16*)(ws + WS_WIN), MROWS, NPROJ_PAD, 2048}; pg8::StaticOrder S; S.init(MROWS, NPROJ_PAD, G, bx);
        pg8::EpiProj E{(bf16*)(ws + WS_QKV), (bf16*)(ws + WS_Z), (float*)(ws + WS_AB)};
        pg8::gemm_phase<pg8::EpiProj, pg8::StaticOrder, true, true>(lds, g, S, E); } SEAM(2);
    if (IN(3)) _Pragma("nounroll") for (int rep_ = 0, nrep_ = rep_opaque(REP(3)); rep_ <= nrep_; ++rep_) { phase_dn_front(p, lds, tid, lane, wave, vcu, G); } SEAM(3);
    if (IN(5)) _Pragma("nounroll") for (int rep_ = 0, nrep_ = rep_opaque(REP(5)); rep_ <= nrep_; ++rep_) { phase_dn_seq(p, lds, lane, wave, vcu, G); } SEAM(5);
    if (IN(6)) _Pragma("nounroll") for (int rep_ = 0, nrep_ = rep_opaque(REP(6)); rep_ <= nrep_; ++rep_) { phase_combine(p, lane, wave, vcu, G); } SEAM(6);
    if (IN(7)) _Pragma("nounroll") for (int rep_ = 0, nrep_ = rep_opaque(REP(7)); rep_ <= nrep_; ++rep_) { pg8::Gemm g{(const bf16*)(ws + WS_KA), (const bf16*)(ws + WS_WOUT), MROWS, 2048, 4096}; pg8::StaticOrder S; S.init(MROWS, 2048, G, bx);
        pg8::EpiRes E{X, rep_ ? ZG : MOD + 4096};
        pg8::gemm_phase<pg8::EpiRes, pg8::StaticOrder, true, true>(lds, g, S, E); } SEAM(7);
    if (IN(8)) _Pragma("nounroll") for (int rep_ = 0, nrep_ = rep_opaque(REP(8)); rep_ <= nrep_; ++rep_) { phase_norm<1>(p, 0, 1, lane, wave, vcu, G); } SEAM(8);
    if (IN(9)) _Pragma("nounroll") for (int rep_ = 0, nrep_ = rep_opaque(REP(9)); rep_ <= nrep_; ++rep_) { pg8::Gemm g{XN, (const bf16*)(ws + WS_WFF1), MROWS, 8192, 2048}; pg8::StaticOrder S; S.init(MROWS, 8192, G, bx);
        pg8::EpiAct<0> E{Hb, nullptr, nullptr};
        pg8::gemm_phase<pg8::EpiAct<0>, pg8::StaticOrder, true, true>(lds, g, S, E); } SEAM(9);
    if (IN(10)) _Pragma("nounroll") for (int rep_ = 0, nrep_ = rep_opaque(REP(10)); rep_ <= nrep_; ++rep_) { pg8::Gemm g{Hb, (const bf16*)(ws + WS_WFF2), MROWS, 2048, 8192}; pg8::StaticOrder S; S.init(MROWS, 2048, G, bx);
        pg8::EpiRes E{X, rep_ ? ZG : MOD + 10240};
        pg8::gemm_phase<pg8::EpiRes, pg8::StaticOrder, true, true>(lds, g, S, E); } SEAM(10);
    if (IN(11)) _Pragma("nounroll") for (int rep_ = 0, nrep_ = rep_opaque(REP(11)); rep_ <= nrep_; ++rep_) { phase_norm<1>(p, 1, 0, lane, wave, vcu, G); } SEAM(11);
    if (IN(12)) _Pragma("nounroll") for (int rep_ = 0, nrep_ = rep_opaque(REP(12)); rep_ <= nrep_; ++rep_) { pg8::Gemm g{XN, (const bf16*)(ws + WS_WCMIN), MROWS, 8192, 2048}; pg8::StaticOrder S; S.init(MROWS, 8192, G, bx);
        pg8::EpiAct<1> E{Hb, p.in[17], (float*)(ws + WS_STATS)};
        pg8::gemm_phase<pg8::EpiAct<1>, pg8::StaticOrder, true, true>(lds, g, S, E); } SEAM(12);
    if (IN(13)) _Pragma("nounroll") for (int rep_ = 0, nrep_ = rep_opaque(REP(13)); rep_ <= nrep_; ++rep_) { phase_spatial(p, lds, tid, lane, wave, vcu, G); } SEAM(13);
    if (IN(14)) _Pragma("nounroll") for (int rep_ = 0, nrep_ = rep_opaque(REP(14)); rep_ <= nrep_; ++rep_) { pg8::Gemm g{(const bf16*)(ws + WS_Z), (const bf16*)(ws + WS_WCMOUT), MROWS, 2048, 4096}; pg8::StaticOrder S; S.init(MROWS, 2048, G, bx);
        pg8::EpiRes E{X, rep_ ? ZG : MOD + 3 * 12288 + 4096};
        pg8::gemm_phase<pg8::EpiRes, pg8::StaticOrder, true, true>(lds, g, S, E); } SEAM(14);
    if (IN(15)) _Pragma("nounroll") for (int rep_ = 0, nrep_ = rep_opaque(REP(15)); rep_ <= nrep_; ++rep_) { phase_norm<1>(p, 1, 1, lane, wave, vcu, G); } SEAM(15);
    if (IN(16)) _Pragma("nounroll") for (int rep_ = 0, nrep_ = rep_opaque(REP(16)); rep_ <= nrep_; ++rep_) { pg8::Gemm g{XN, (const bf16*)(ws + WS_WFF1) + (size_t)2048 * 8192, MROWS, 8192, 2048}; pg8::StaticOrder S; S.init(MROWS, 8192, G, bx);
        pg8::EpiAct<0> E{Hb, nullptr, nullptr};
        pg8::gemm_phase<pg8::EpiAct<0>, pg8::StaticOrder, true, true>(lds, g, S, E); } SEAM(16);
    if (IN(17)) _Pragma("nounroll") for (int rep_ = 0, nrep_ = rep_opaque(REP(17)); rep_ <= nrep_; ++rep_) { pg8::Gemm g{Hb, (const bf16*)(ws + WS_WFF2) + (size_t)2048 * 8192, MROWS, 2048, 8192}; pg8::StaticOrder S; S.init(MROWS, 2048, G, bx);
        pg8::EpiRes E{X, rep_ ? ZG : MOD + 3 * 12288 + 10240};
        pg8::gemm_phase<pg8::EpiRes, pg8::StaticOrder, true, true>(lds, g, S, E); } SEAM(17);
    if (IN(18)) _Pragma("nounroll") for (int rep_ = 0, nrep_ = rep_opaque(REP(18)); rep_ <= nrep_; ++rep_) { phase_norm<2>(p, 0, 0, lane, wave, vcu, G); }
#undef IN
#undef SEAM
}

extern "C" void kernel_launch(void* const* d_in, const int* in_sizes, int n_in, void* d_out, int out_size, void* d_ws, size_t ws_size, hipStream_t stream) {
    static int grid = 0;
    if (grid == 0) {
        if (n_in != 26 || ws_size < WS_END) { fprintf(stderr, "kernel_launch: expected 26 inputs and >= %zu bytes of workspace; got %d, %zu\n", (size_t)WS_END, n_in, ws_size); grid = -1; return; }
        int dev = 0, cus = 0, per_cu = 0;
        if (hipGetDevice(&dev) != hipSuccess || hipDeviceGetAttribute(&cus, hipDeviceAttributeMultiprocessorCount, dev) != hipSuccess) { grid = -1; return; }
        if (hipFuncSetAttribute((const void*)mega_fwd, hipFuncAttributeMaxDynamicSharedMemorySize, LDS_BYTES) != hipSuccess) { fprintf(stderr, "kernel_launch: hipFuncSetAttribute failed\n"); grid = -1; return; }
        if (hipOccupancyMaxActiveBlocksPerMultiprocessor(&per_cu, (const void*)mega_fwd, NWAVES * 64, LDS_BYTES) != hipSuccess || per_cu < 1) { fprintf(stderr, "kernel_launch: occupancy query reports %d blocks per CU\n", per_cu); (void)hipGetLastError(); per_cu = 1; }
        grid = cus;
    }
    if (grid < 0) return;
    if (hipMemsetAsync((char*)d_ws + WS_CTL, 0, REP_MASK ? 262144 : 65536, stream) != hipSuccess) { fprintf(stderr, "kernel_launch: hipMemsetAsync failed\n"); return; }
    Params a{};
    for (int i = 0; i < 26; ++i) a.in[i] = (const float*)d_in[i];
    a.out = (float*)d_out; a.ws = (unsigned char*)d_ws;
#if MK_PER_PHASE
    for (int ph = 0; ph < NPHASE; ++ph) { if (ph == 4) continue; a.ph_lo = ph; a.ph_hi = ph + 1; for (int r = 0; r <= (int)((HOST_REP_MASK >> ph) & 1u); ++r) { a.flags = (r == 0 && ((HOST_REP_MASK >> ph) & 1u)) ? HOST_VAR_FLAGS : 0; hipLaunchKernelGGL(mega_fwd, dim3(grid), dim3(NWAVES * 64), LDS_BYTES, stream, a); } }
#else
    a.ph_lo = 0; a.ph_hi = NPHASE;
    void* args[] = {&a};
    hipError_t e = hipLaunchCooperativeKernel((const void*)mega_fwd, dim3(grid), dim3(NWAVES * 64), args, LDS_BYTES, stream);
    if (e != hipSuccess) fprintf(stderr, "kernel_launch: cooperative launch failed: %s (grid %d)\n", hipGetErrorString(e), grid);
#endif
}
```

```cpp
#include <hip/hip_runtime.h>
#include <hip/hip_cooperative_groups.h>
#include <cstdio>
#include <cstdint>
namespace cg = cooperative_groups;
#ifndef MK_PER_PHASE
#define MK_PER_PHASE 0
#endif
namespace pg8 {
#define PG8_LAS __attribute__((address_space(3)))
typedef unsigned short bf16_t;
typedef short bf16x8 __attribute__((ext_vector_type(8)));
typedef float f32x4 __attribute__((ext_vector_type(4)));
typedef unsigned u32x4 __attribute__((ext_vector_type(4)));
constexpr int BM = 256, BK = 64, HALF = 128, HTB = HALF * BK * 2  , STAGE_BYTES = 8 * HTB, NXCD = 8, WGM = 8;

__host__ __device__ __forceinline__ int lds_byte(int r, int c) { const int st = (r >> 4) * 2 + (c >> 5), rr = r & 15, cc = c & 31, ob = rr * 64 + cc * 2; return st * 1024 + (ob ^ (((ob >> 9) & 1) << 5)); }
__host__ __device__ __forceinline__ void stage_rc(int b, int& R, int& C) { const int st = b / 1024, sb = b % 1024, swz = sb ^ (((sb >> 9) & 1) << 5); R = (st >> 1) * 16 + swz / 64; C = (st & 1) * 32 + (swz % 64) / 2; }
__host__ __device__ __forceinline__ int perm32(int rho) { const int n = rho >> 4, i = rho & 15; return 8 * (i >> 2) + 4 * n + (i & 3); }

struct Unit { int pm, pn; };
struct Gemm { const bf16_t* A; const bf16_t* Bt; int M, N, K; };

struct StaticOrder {
    int nM, nN, nwg, G, c;
    __host__ __device__ void init(int M, int N, int G_, int c_) { nM = M / BM; nN = N / BM; nwg = nM * nN; G = G_; c = c_; }
    __host__ __device__ bool next(int i, Unit& u) const {
        const long L = (long)i * G + c; if (L >= nwg) return false;
        int wgid = (int)L; { const int q = nwg / NXCD, r = nwg % NXCD, xcd = wgid % NXCD, off = wgid / NXCD; wgid = (xcd < r ? xcd * (q + 1) : r * (q + 1) + (xcd - r) * q) + off; }
        const int nig = WGM * nN, gid = wgid / nig, fm = gid * WGM, gsz = (nM - fm) < WGM ? (nM - fm) : WGM;
        u.pm = fm + ((wgid % nig) % gsz); u.pn = (wgid % nig) / gsz; return true;
    }
    __device__ __forceinline__ void a_ready(const Unit&) const {}
    __device__ __forceinline__ void done(const Unit&) const {}
};

typedef float f32x2_t __attribute__((ext_vector_type(2))); typedef __bf16 bf16x2_t __attribute__((ext_vector_type(2)));
__device__ __forceinline__ unsigned cvt_pk_bf16(float lo, float hi) { const f32x2_t v = {lo, hi}; const bf16x2_t b = __builtin_convertvector(v, bf16x2_t); return __builtin_bit_cast(unsigned, b); }
__device__ __forceinline__ u32x4 pack8(const f32x4 v0, const f32x4 v1) { u32x4 w; w.x = cvt_pk_bf16(v0[0], v0[1]); w.y = cvt_pk_bf16(v0[2], v0[3]); w.z = cvt_pk_bf16(v1[0], v1[1]); w.w = cvt_pk_bf16(v1[2], v1[3]); return w; }
__device__ __forceinline__ float gelu_tanh(float x) {
    const float u = 0.7978845608028654f * (x + 0.044715f * x * x * x);
    const float e = __builtin_amdgcn_exp2f(-2.0f * 1.4426950408889634f * u);
    return x * __builtin_amdgcn_rcpf(1.0f + e);
}
struct EpiProj {
    static constexpr bool PERM = true, AFTER_DRAIN = false;
    bf16_t* QKV; bf16_t* Z; float* AB;
    __device__ __forceinline__ void operator()(const f32x4 (&acc)[2][2][4][2], const Unit& u, int wr, int wc, int fr, int fq) const {
        const int row0 = u.pm * BM + wr * 64 + fr, cin = wc * 32 + 8 * fq;
        if (u.pn < 32) {
#pragma unroll
            for (int bj = 0; bj < 2; ++bj) { const int kh = u.pn < 16 ? 2 * (u.pn & 7) + bj : u.pn - 16, dcol = (u.pn < 8 ? 0 : (u.pn < 16 ? 128 : 256 + bj * HALF)) + cin;
                bf16_t* base = QKV + (size_t)kh * 6144 * 512 + dcol;
#pragma unroll
                for (int ai = 0; ai < 2; ++ai)
#pragma unroll
                    for (int m = 0; m < 4; ++m) *(u32x4*)(base + (size_t)(row0 + ai * HALF + m * 16) * 512) = pack8(acc[ai][bj][m][0], acc[ai][bj][m][1]); }
        } else if (u.pn < 48) {
            const int colt = (u.pn - 32) * BM;
#pragma unroll
            for (int ai = 0; ai < 2; ++ai)
#pragma unroll
                for (int m = 0; m < 4; ++m) { bf16_t* rowp = Z + (size_t)(row0 + ai * HALF + m * 16) * 4096 + colt + cin;
#pragma unroll
                    for (int bj = 0; bj < 2; ++bj) *(u32x4*)(rowp + bj * HALF) = pack8(acc[ai][bj][m][0], acc[ai][bj][m][1]); }
        } else {
#pragma unroll
            for (int ai = 0; ai < 2; ++ai)
#pragma unroll
                for (int m = 0; m < 4; ++m) { float* rowp = AB + (size_t)(row0 + ai * HALF + m * 16) * 128 + cin;
                    *(f32x4*)(rowp) = acc[ai][0][m][0]; *(f32x4*)(rowp + 4) = acc[ai][0][m][1]; }
        }
    }
};
struct EpiRes {
    static constexpr bool PERM = false, AFTER_DRAIN = false;
    float* X; const float* gate;
    __device__ __forceinline__ void operator()(const f32x4 (&acc)[2][2][4][2], const Unit& u, int wr, int wc, int fr, int fq) const {
        const int cond = u.pm < 16 ? 0 : (u.pm < 20 ? 1 : 2);
        const int row0 = u.pm * BM + wr * 64 + fr, col0 = u.pn * BM + wc * 32 + 4 * fq;
        const float* gp = gate + cond * 12288 + col0;
        f32x4 gv[2][2];
#pragma unroll
        for (int bj = 0; bj < 2; ++bj)
#pragma unroll
            for (int n = 0; n < 2; ++n) gv[bj][n] = *(const f32x4*)(gp + bj * HALF + n * 16);
#pragma unroll
        for (int ai = 0; ai < 2; ++ai)
#pragma unroll
            for (int m = 0; m < 4; ++m) { float* xp = X + (size_t)(row0 + ai * HALF + m * 16) * 2048 + col0;
#pragma unroll
                for (int bj = 0; bj < 2; ++bj)
#pragma unroll
                    for (int n = 0; n < 2; ++n) { f32x4 x = *(const f32x4*)(xp + bj * HALF + n * 16); x = x + gv[bj][n] * acc[ai][bj][m][n]; *(f32x4*)(xp + bj * HALF + n * 16) = x; } }
    }
};
template <int ACT> struct EpiAct {
    static constexpr bool PERM = true, AFTER_DRAIN = false;
    bf16_t* H; const float* bias; float* stats;
    __device__ __forceinline__ void operator()(const f32x4 (&acc)[2][2][4][2], const Unit& u, int wr, int wc, int fr, int fq) const {
        const int row0 = u.pm * BM + wr * 64 + fr, col0 = u.pn * BM + wc * 32 + 8 * fq;
        f32x4 bv[2][2];
#pragma unroll
        for (int bj = 0; bj < 2; ++bj)
#pragma unroll
            for (int n = 0; n < 2; ++n) bv[bj][n] = (ACT == 1) ? *(const f32x4*)(bias + col0 + bj * HALF + 4 * n) : (f32x4){0.f, 0.f, 0.f, 0.f};
#pragma unroll
        for (int ai = 0; ai < 2; ++ai)
#pragma unroll
            for (int m = 0; m < 4; ++m) { const int row = row0 + ai * HALF + m * 16; bf16_t* rowp = H + (size_t)row * 8192 + col0; float s1 = 0.f, s2 = 0.f;
#pragma unroll
                for (int bj = 0; bj < 2; ++bj) { f32x4 v0 = acc[ai][bj][m][0] + bv[bj][0], v1 = acc[ai][bj][m][1] + bv[bj][1];
#pragma unroll
                    for (int e = 0; e < 4; ++e) {
                        if (ACT == 0) { const float a = fmaxf(v0[e], 0.f), b = fmaxf(v1[e], 0.f); v0[e] = a * a; v1[e] = b * b; }
                        else { v0[e] = gelu_tanh(v0[e]); v1[e] = gelu_tanh(v1[e]); s1 += v0[e] + v1[e]; s2 += v0[e] * v0[e] + v1[e] * v1[e]; } }
                    *(u32x4*)(rowp + bj * HALF) = pack8(v0, v1); }
                if (ACT == 1) { if (u.pn >= 16) { s1 += __shfl_xor(s1, 16); s1 += __shfl_xor(s1, 32); s2 += __shfl_xor(s2, 16); s2 += __shfl_xor(s2, 32);
                    if (fq == 0) { typedef float f32x2 __attribute__((ext_vector_type(2))); *(f32x2*)(stats + (size_t)row * 128 + ((u.pn - 16) * 4 + wc) * 2) = (f32x2){s1, s2}; } } }
            }
    }
};

template <class Epi, class Sched, bool ALIGN_EPI = false, bool SP2 = false>
__device__ __forceinline__ void gemm_phase(PG8_LAS unsigned char* lds, const Gemm g, const Sched& S, const Epi& E) {
    const int tid = threadIdx.x, wid = __builtin_amdgcn_readfirstlane(tid >> 6), lane = tid & 63, wr = wid >> 2, wc = wid & 3, fr = lane & 15, fq = lane >> 4;
    const int K = g.K, nt = K / BK;
    unsigned voffA[2], voffB[2];
#pragma unroll
    for (int i = 0; i < 2; ++i) { int R, C; stage_rc(tid * 16 + i * 8192, R, C); const int Rb = Epi::PERM ? ((R & ~31) + perm32(R & 31)) : R;
        voffA[i] = (unsigned)(R * K + C) * 2u; voffB[i] = (unsigned)(Rb * K + C) * 2u; }
    const size_t kstep = (size_t)(BK * 2);
    const size_t hstep = (size_t)HALF * K * 2;
    const size_t tstep = 2 * hstep;
    const unsigned ldsw = (unsigned)wid * 1024u;
    const int aoff = lds_byte(wr * 64 + fr, fq * 8), boff = lds_byte(wc * 32 + fr, fq * 8);
#define PG8_SA(b, h) (((b) * 2 + (h)) * HTB)
#define PG8_SB(b, h) ((4 + (b) * 2 + (h)) * HTB)
#define PG8_STAGE(bufoff, gbase, voff) do { _Pragma("unroll") for (int _i = 0; _i < 2; ++_i) \
        __builtin_amdgcn_global_load_lds((const unsigned*)((const char*)(gbase) + (voff)[_i]), (PG8_LAS unsigned*)(lds + (bufoff) + ldsw + _i * 8192), 16, 0, 0); } while (0)
#define PG8_LDA(dst, b, h) do { _Pragma("unroll") for (int m = 0; m < 4; ++m) _Pragma("unroll") for (int k = 0; k < 2; ++k) dst[m][k] = *(const PG8_LAS bf16x8*)(lds + PG8_SA(b, h) + aoff + m * 2048 + k * 1024); } while (0)
#define PG8_LDB(dst, b, h) do { _Pragma("unroll") for (int n = 0; n < 2; ++n) _Pragma("unroll") for (int k = 0; k < 2; ++k) dst[n][k] = *(const PG8_LAS bf16x8*)(lds + PG8_SB(b, h) + boff + n * 2048 + k * 1024); } while (0)
#define PG8_MMA(ai, bj, At, Bt) do { __builtin_amdgcn_s_setprio(1); _Pragma("unroll") for (int m = 0; m < 4; ++m) _Pragma("unroll") for (int n = 0; n < 2; ++n) _Pragma("unroll") for (int k = 0; k < 2; ++k) \
        acc[ai][bj][m][n] = __builtin_amdgcn_mfma_f32_16x16x32_bf16(Bt[n][k], At[m][k], acc[ai][bj][m][n], 0, 0, 0); __builtin_amdgcn_s_setprio(0); } while (0)
#define PG8_WAIT_V(n) asm volatile("s_waitcnt vmcnt(" #n ")" ::: "memory")
#define PG8_WAIT_L(n) asm volatile("s_waitcnt lgkmcnt(" #n ")" ::: "memory")
#define PG8_BAR __builtin_amdgcn_s_barrier()
#define PG8_SCHED __builtin_amdgcn_sched_barrier(0)
    Unit cur, nxt; int ui = 0;
    if (!S.next(0, cur)) return;
    f32x4 acc[2][2][4][2];
#pragma unroll
    for (int a = 0; a < 2; ++a)
#pragma unroll
        for (int b = 0; b < 2; ++b)
#pragma unroll
            for (int m = 0; m < 4; ++m)
#pragma unroll
                for (int n = 0; n < 2; ++n) acc[a][b][m][n] = (f32x4){0.f, 0.f, 0.f, 0.f};
    bf16x8 At[4][2], B0[2][2], B1[2][2];
    const char* cA = (const char*)g.A + (size_t)cur.pm * tstep; const char* cB = (const char*)g.Bt + (size_t)cur.pn * tstep;
    S.a_ready(cur);
    if constexpr (SP2) {
        PG8_STAGE(PG8_SB(0, 0), cB, voffB); PG8_STAGE(PG8_SB(0, 1), cB + hstep, voffB); PG8_STAGE(PG8_SA(0, 0), cA, voffA); PG8_STAGE(PG8_SA(0, 1), cA + hstep, voffA);
        if (wr == 1) PG8_BAR;
        PG8_WAIT_V(2); PG8_BAR;
        PG8_STAGE(PG8_SB(1, 0), cB + kstep, voffB); PG8_STAGE(PG8_SA(1, 0), cA + kstep, voffA); PG8_STAGE(PG8_SB(1, 1), cB + hstep + kstep, voffB);
        PG8_WAIT_V(6); PG8_BAR;
    } else {
        PG8_STAGE(PG8_SB(0, 0), cB, voffB); PG8_STAGE(PG8_SA(0, 0), cA, voffA); PG8_STAGE(PG8_SB(0, 1), cB + hstep, voffB); PG8_STAGE(PG8_SA(0, 1), cA + hstep, voffA);
        if (wr == 1) PG8_BAR;
        PG8_WAIT_V(4); PG8_BAR;
        PG8_STAGE(PG8_SB(1, 0), cB + kstep, voffB); PG8_STAGE(PG8_SA(1, 0), cA + kstep, voffA); PG8_STAGE(PG8_SB(1, 1), cB + hstep + kstep, voffB);
        PG8_WAIT_V(6); PG8_BAR;
    }
    for (;;) {
        const bool has_next = S.next(ui + 1, nxt);
        const char* nA = has_next ? (const char*)g.A + (size_t)nxt.pm * tstep : cA; const char* nB = has_next ? (const char*)g.Bt + (size_t)nxt.pn * tstep : cB;
        for (int t = 0; t < nt; t += 2) {
            const bool last = (t == nt - 2);
            const char* a1 = cA + (size_t)(t + 1) * kstep;
            const char* a2 = last ? nA : cA + (size_t)(t + 2) * kstep; const char* b2 = last ? nB : cB + (size_t)(t + 2) * kstep;
            const char* a3 = a2 + kstep; const char* b3 = b2 + kstep;
            if (last && has_next) S.a_ready(nxt);
            if constexpr (SP2) {
            PG8_LDB(B0, 0, 0); PG8_LDB(B1, 0, 1); PG8_SCHED; PG8_LDA(At, 0, 0); PG8_STAGE(PG8_SA(1, 1), a1 + hstep, voffA);
            PG8_WAIT_V(8); PG8_WAIT_L(0); PG8_BAR; PG8_MMA(0, 0, At, B0); PG8_MMA(0, 1, At, B1); PG8_BAR; PG8_SCHED;
            PG8_LDA(At, 0, 1); PG8_STAGE(PG8_SB(0, 0), b2, voffB); PG8_STAGE(PG8_SB(0, 1), b2 + hstep, voffB); PG8_STAGE(PG8_SA(0, 0), a2, voffA);
            PG8_WAIT_V(8); PG8_WAIT_L(0); PG8_BAR; PG8_MMA(1, 0, At, B0); PG8_MMA(1, 1, At, B1); PG8_BAR; PG8_SCHED;
            PG8_LDB(B0, 1, 0); PG8_LDB(B1, 1, 1); PG8_SCHED; PG8_LDA(At, 1, 0); PG8_STAGE(PG8_SA(0, 1), a2 + hstep, voffA);
            PG8_WAIT_V(8); PG8_WAIT_L(0); PG8_BAR; PG8_MMA(0, 0, At, B0); PG8_MMA(0, 1, At, B1); PG8_BAR; PG8_SCHED;
            PG8_LDA(At, 1, 1); PG8_STAGE(PG8_SB(1, 0), b3, voffB); PG8_STAGE(PG8_SB(1, 1), b3 + hstep, voffB); PG8_STAGE(PG8_SA(1, 0), a3, voffA);
            PG8_WAIT_V(8); PG8_WAIT_L(0); PG8_BAR; PG8_MMA(1, 0, At, B0); PG8_MMA(1, 1, At, B1); PG8_BAR; PG8_SCHED;
            } else {
            PG8_LDB(B0, 0, 0); PG8_SCHED; PG8_LDA(At, 0, 0); PG8_STAGE(PG8_SA(1, 1), a1 + hstep, voffA);
            PG8_WAIT_L(8); PG8_BAR; PG8_WAIT_L(0); PG8_MMA(0, 0, At, B0); PG8_BAR; PG8_SCHED;
            PG8_LDB(B1, 0, 1); PG8_STAGE(PG8_SB(0, 0), b2, voffB);
            PG8_BAR; PG8_WAIT_L(0); PG8_MMA(0, 1, At, B1); PG8_BAR;
            PG8_LDA(At, 0, 1); PG8_STAGE(PG8_SA(0, 0), a2, voffA);
            PG8_BAR; PG8_WAIT_L(0); PG8_MMA(1, 0, At, B0); PG8_BAR; PG8_SCHED;
            PG8_STAGE(PG8_SB(0, 1), b2 + hstep, voffB);
            PG8_WAIT_V(6); PG8_BAR; PG8_MMA(1, 1, At, B1); PG8_BAR;
            PG8_LDB(B0, 1, 0); PG8_SCHED; PG8_LDA(At, 1, 0); PG8_STAGE(PG8_SA(0, 1), a2 + hstep, voffA);
            PG8_WAIT_L(8); PG8_BAR; PG8_WAIT_L(0); PG8_MMA(0, 0, At, B0); PG8_BAR; PG8_SCHED;
            PG8_LDB(B1, 1, 1); PG8_STAGE(PG8_SB(1, 0), b3, voffB);
            PG8_BAR; PG8_WAIT_L(0); PG8_MMA(0, 1, At, B1); PG8_BAR;
            PG8_LDA(At, 1, 1); PG8_STAGE(PG8_SA(1, 0), a3, voffA);
            PG8_BAR; PG8_WAIT_L(0); PG8_MMA(1, 0, At, B0); PG8_BAR; PG8_SCHED;
            PG8_STAGE(PG8_SB(1, 1), b3 + hstep, voffB);
            PG8_WAIT_V(6); PG8_BAR; PG8_MMA(1, 1, At, B1); PG8_BAR;
            }
        }
        if constexpr (ALIGN_EPI) { if (wr == 0) PG8_BAR; }
        if constexpr (!Epi::AFTER_DRAIN) { E(acc, cur, wr, wc, fr, fq); S.done(cur); }
        if (!has_next) break;
#pragma unroll
        for (int a = 0; a < 2; ++a)
#pragma unroll
            for (int b = 0; b < 2; ++b)
#pragma unroll
                for (int m = 0; m < 4; ++m)
#pragma unroll
                    for (int n = 0; n < 2; ++n) acc[a][b][m][n] = (f32x4){0.f, 0.f, 0.f, 0.f};
        cur = nxt; cA = nA; cB = nB; ++ui;
        if constexpr (ALIGN_EPI) { if (wr == 1) PG8_BAR; }
    }
    PG8_WAIT_V(0);
    if constexpr (!ALIGN_EPI) { if (wr == 0) PG8_BAR; }
    PG8_BAR;
    if constexpr (Epi::AFTER_DRAIN) { E.fused(acc, cur, wr, wc, fr, fq, lds, wid, lane); S.done(cur); }
#undef PG8_SA
#undef PG8_SB
#undef PG8_STAGE
#undef PG8_LDA
#undef PG8_LDB
#undef PG8_MMA
#undef PG8_WAIT_V
#undef PG8_WAIT_L
#undef PG8_BAR
#undef PG8_SCHED
}
}
#define LAS __attribute__((address_space(3)))
typedef unsigned short bf16;
typedef unsigned v4u __attribute__((ext_vector_type(4)));
typedef unsigned v2u __attribute__((ext_vector_type(2)));
typedef float f32x4 __attribute__((ext_vector_type(4)));
typedef float f32x2 __attribute__((ext_vector_type(2)));
typedef float f32x16 __attribute__((ext_vector_type(16)));
typedef short bf16x8 __attribute__((ext_vector_type(8)));

constexpr int NWAVES = 8;
constexpr int DM = 2048, MROWS = 6144;
constexpr int NPROJ = 12416, NPROJ_PAD = 12544;
constexpr int LDS_BYTES = 147456;
constexpr size_t MiB = 1u << 20;
constexpr size_t WS_CTL = 0, WS_MOD = 1 * MiB, WS_AB = 2 * MiB, WS_STATS = 6 * MiB, WS_VEC = 10 * MiB;
constexpr size_t WS_WIN = 16 * MiB, WS_WOUT = 65 * MiB, WS_WCMIN = 81 * MiB, WS_WCMOUT = 113 * MiB, WS_WFF1 = 129 * MiB, WS_WFF2 = 193 * MiB, WS_WSB = 257 * MiB;
constexpr size_t WS_X = 258 * MiB, WS_XN = 306 * MiB, WS_QKV = 330 * MiB  , WS_Z = 426 * MiB  ;
constexpr size_t WS_KA = 474 * MiB  , WS_QA = 498 * MiB, WS_KT = 522 * MiB, WS_VT = 546 * MiB, WS_TB = 594 * MiB, WS_IN = 642 * MiB, WS_END = 690 * MiB;
constexpr size_t OUT_SF = (size_t)MROWS * DM, OUT_SB = OUT_SF + (size_t)16 * 32 * 128 * 128;

struct Params { const float* in[26]; float* out; unsigned char* ws; int ph_lo, ph_hi, flags, pad; };

__device__ __forceinline__ unsigned f2bf(float f) { unsigned u = __builtin_bit_cast(unsigned, f); return (u + 0x7fffu + ((u >> 16) & 1u)) >> 16; }
__device__ __forceinline__ unsigned pk2(float lo, float hi) { return pg8::cvt_pk_bf16(lo, hi); }
__device__ __forceinline__ float bflo(unsigned u) { return __builtin_bit_cast(float, u << 16); }
__device__ __forceinline__ float bfhi(unsigned u) { return __builtin_bit_cast(float, u & 0xffff0000u); }
__device__ __forceinline__ float bf2f(bf16 b) { return __builtin_bit_cast(float, (unsigned)b << 16); }
__device__ __forceinline__ float wave_sum(float v) {
#pragma unroll
    for (int o = 1; o < 64; o <<= 1) v += __shfl_xor(v, o);
    return v;
}
__device__ __forceinline__ float silu_f(float x) { return x * __builtin_amdgcn_rcpf(1.0f + __expf(-x)); }
#define LDS_WAIT() asm volatile("s_waitcnt lgkmcnt(0)" ::: "memory")
#define LDS_BAR() asm volatile("s_waitcnt lgkmcnt(0)\n\ts_barrier" ::: "memory")

__device__ __forceinline__ void transpose_item(const float* W, int K, int N, bf16* WT, LAS float* scr, int item, int lane) {
    const int nblk = N >> 6, kb = item / nblk, nb = item - kb * nblk, k0 = kb * 64, n0 = nb * 64;
    const float* src = W + (size_t)k0 * N + n0 + lane;
#pragma unroll 16
    for (int i = 0; i < 64; ++i) scr[i * 65 + lane] = src[(size_t)i * N];
    LDS_WAIT();
    const int c = lane & 7;
#pragma unroll
    for (int j = 0; j < 8; ++j) { const int n = (lane >> 3) + 8 * j; const LAS float* s = scr + (8 * c) * 65 + n;
        v4u o; o.x = pk2(s[0 * 65], s[1 * 65]); o.y = pk2(s[2 * 65], s[3 * 65]); o.z = pk2(s[4 * 65], s[5 * 65]); o.w = pk2(s[6 * 65], s[7 * 65]);
        *(v4u*)(WT + (size_t)(n0 + n) * K + k0 + 8 * c) = o; }
    LDS_WAIT();
}
__device__ __forceinline__ void phase_prologue(const Params& p, LAS unsigned char* lds, int tid, int lane, int wave, int vcu, int G) {
    unsigned char* ws = p.ws;
    {
        LAS float* sc = (LAS float*)lds; LAS float* red = sc + 3 * 2048;
        for (int i = tid; i < 3 * 2048; i += 512) { const int cnd = i >> 11, k = i & 2047; const float x = cnd == 0 ? p.in[5][k] : p.in[4][(cnd - 1) * 2048 + k]; sc[i] = silu_f(x); }
        __syncthreads();
        float* MOD = (float*)(ws + WS_MOD);
        for (int strip = vcu; strip < 256; strip += G) {
            const int l = strip >> 7, n0 = (strip & 127) * 96;
            if (tid < 504) {
                const int cl = tid % 24, g = tid / 24;
                const float* W = p.in[8] + (size_t)l * 2048 * 12288 + n0 + 4 * cl;
                f32x4 a0 = {0.f, 0.f, 0.f, 0.f}, a1 = a0, a2 = a0;
#pragma unroll 7
                for (int k = g; k < 2048; k += 21) { const f32x4 w = *(const f32x4*)(W + (size_t)k * 12288); a0 += w * sc[k]; a1 += w * sc[2048 + k]; a2 += w * sc[4096 + k]; }
                LAS float* r = red + g * 288 + 4 * cl;
                *(LAS f32x4*)(r) = a0; *(LAS f32x4*)(r + 96) = a1; *(LAS f32x4*)(r + 192) = a2;
            }
            __syncthreads();
            if (tid < 288) { float s = 0.f;
#pragma unroll
                for (int g = 0; g < 21; ++g) s += red[g * 288 + tid];
                const int cnd = tid / 96, c = tid % 96; MOD[(l * 3 + cnd) * 12288 + n0 + c] = s + p.in[9][l * 12288 + n0 + c]; }
            __syncthreads();
        }
    }
    {
        LAS float* scr = (LAS float*)(lds + wave * 16640);
        const int gw = vcu * NWAVES + wave, NGW = G * NWAVES;
        constexpr int I0 = 32 * 194, I1 = 64 * 32, I2 = 32 * 128, I3 = 64 * 32, I4 = 32 * 128, I6 = 128 * 32;
        constexpr int NITEMS = I0 + I1 + I2 + I3 + 2 * I4 + 2 * I6;
        for (int it = gw; it < NITEMS; it += NGW) {
            int r = it;
            if (r < I0) { transpose_item(p.in[10], 2048, NPROJ, (bf16*)(ws + WS_WIN), scr, r, lane); continue; } r -= I0;
            if (r < I1) { transpose_item(p.in[15], 4096, 2048, (bf16*)(ws + WS_WOUT), scr, r, lane); continue; } r -= I1;
            if (r < I2) { transpose_item(p.in[16], 2048, 8192, (bf16*)(ws + WS_WCMIN), scr, r, lane); continue; } r -= I2;
            if (r < I3) { transpose_item(p.in[22], 4096, 2048, (bf16*)(ws + WS_WCMOUT), scr, r, lane); continue; } r -= I3;
            if (r < 2 * I4) { const int l = r / I4; transpose_item(p.in[23] + (size_t)l * 2048 * 8192, 2048, 8192, (bf16*)(ws + WS_WFF1) + (size_t)l * 2048 * 8192, scr, r - l * I4, lane); continue; } r -= 2 * I4;
            { const int l = r / I6; transpose_item(p.in[24] + (size_t)l * 2048 * 8192, 8192, 2048, (bf16*)(ws + WS_WFF2) + (size_t)l * 2048 * 8192, scr, r - l * I6, lane); }
        }
    }
    {
        const int gt = vcu * 512 + tid, NT = G * 512;
        const float* wsf = p.in[20]; v4u* dst = (v4u*)(ws + WS_WSB);
        for (int i = gt; i < 32768; i += NT) { const f32x4 a = *(const f32x4*)(wsf + 8 * i), b = *(const f32x4*)(wsf + 8 * i + 4); v4u o; o.x = pk2(a[0], a[1]); o.y = pk2(a[2], a[3]); o.z = pk2(b[0], b[1]); o.w = pk2(b[2], b[3]); dst[i] = o; }
        v4u* pad = (v4u*)((bf16*)(ws + WS_WIN) + (size_t)NPROJ * 2048);
        for (int i = gt; i < 32768; i += NT) pad[i] = (v4u){0u, 0u, 0u, 0u};
    }
}

template <int MODE>
__device__ __forceinline__ void phase_norm(const Params& p, int layer, int which, int lane, int wave, int vcu, int G) {
    unsigned char* ws = p.ws; float* X = (float*)(ws + WS_X); bf16* XN = (bf16*)(ws + WS_XN); const float* MOD = (const float*)(ws + WS_MOD);
    const int gw = vcu * NWAVES + wave, NGW = G * NWAVES;
    for (int row = gw; row < MROWS; row += NGW) {
        f32x4 v[8];
        const float* src = MODE == 0 ? (row < 4096 ? p.in[0] + (size_t)row * DM : p.in[1] + (size_t)(row - 4096) * DM) : X + (size_t)row * DM;
#pragma unroll
        for (int j = 0; j < 8; ++j) v[j] = *(const f32x4*)(src + 4 * (lane + 64 * j));
        if (MODE == 0) {
            if (row >= 4096) {
                const int pos = (row - 4096) & 1023; const float gr = (float)(pos >> 6), gc = (float)(pos & 63);
#pragma unroll
                for (int j = 0; j < 8; ++j) { const float base = (j >> 1) < 2 ? gr : gc;
#pragma unroll
                    for (int e = 0; e < 4; ++e) { const int i = (4 * (lane + 64 * j) + e) & 511; const float fr = expf(-(float)i * (9.210340371976184f / 512.0f)); const float ang = base * fr;
                        v[j][e] += ((j >> 1) & 1) ? cosf(ang) : sinf(ang); } }
            }
#pragma unroll
            for (int j = 0; j < 8; ++j) *(f32x4*)(X + (size_t)row * DM + 4 * (lane + 64 * j)) = v[j];
        }
        float ss = 0.f;
#pragma unroll
        for (int j = 0; j < 8; ++j) ss += (v[j][0] * v[j][0] + v[j][1] * v[j][1]) + (v[j][2] * v[j][2] + v[j][3] * v[j][3]);
        ss = wave_sum(ss);
        const float r = 1.0f / sqrtf(ss * (1.0f / DM) + 1e-6f);
        if (MODE == 2) {
#pragma unroll
            for (int j = 0; j < 8; ++j) { const f32x4 w = *(const f32x4*)(p.in[25] + 4 * (lane + 64 * j)); f32x4 y = v[j] * r * w;
#ifdef PROBE_A_LO
                { const unsigned long long* TS = (const unsigned long long*)(ws + WS_CTL + 1024);
                  const float ta = (float)(long long)(__hip_atomic_load(TS + PROBE_A_HI, __ATOMIC_RELAXED, __HIP_MEMORY_SCOPE_AGENT) - __hip_atomic_load(TS + PROBE_A_LO, __ATOMIC_RELAXED, __HIP_MEMORY_SCOPE_AGENT)) * 0.01f;
                  const float tb = (float)(long long)(__hip_atomic_load(TS + PROBE_B_HI, __ATOMIC_RELAXED, __HIP_MEMORY_SCOPE_AGENT) - __hip_atomic_load(TS + PROBE_B_LO, __ATOMIC_RELAXED, __HIP_MEMORY_SCOPE_AGENT)) * 0.01f;
                  if (row < 4096) y = y * (1.0f + ta * 1e-4f);
                  if (row == 4096 && j == 0 && lane == 0) y[0] += tb * 0.01f; }
#endif
                *(f32x4*)(p.out + (size_t)row * DM + 4 * (lane + 64 * j)) = y; }
        } else {
            const int cond = row < 4096 ? 0 : (row < 5120 ? 1 : 2);
            const float* nw = p.in[which ? 7 : 6] + layer * DM; const float* mb = MOD + (size_t)(layer * 3 + cond) * 12288 + (which ? 6144 : 0);
#pragma unroll
            for (int j = 0; j < 8; ++j) { const int c = 4 * (lane + 64 * j); const f32x4 w = *(const f32x4*)(nw + c), sh = *(const f32x4*)(mb + c), sc = *(const f32x4*)(mb + 2048 + c);
                const f32x4 y = v[j] * r * w * (sc + 1.0f) + sh; v2u o; o.x = pk2(y[0], y[1]); o.y = pk2(y[2], y[3]); *(v2u*)(XN + (size_t)row * DM + c) = o; }
        }
    }
}

__device__ __forceinline__ bf16x8 as_frag(const v4u v) { return __builtin_bit_cast(bf16x8, v); }
__device__ __forceinline__ v4u pack8f(const f32x4 a, const f32x4 b) { v4u o; o.x = pk2(a[0], a[1]); o.y = pk2(a[2], a[3]); o.z = pk2(b[0], b[1]); o.w = pk2(b[2], b[3]); return o; }
#define MFMA16(a, b, c) __builtin_amdgcn_mfma_f32_16x16x32_bf16((a), (b), (c), 0, 0, 0)

#define INV_LD(i, j) (*(const LAS f32x4*)(As + (i) * 68 + 4 * (j)))
#define INV_SB() __builtin_amdgcn_sched_barrier(0)
__device__ __forceinline__ void tri_inverse_64(LAS float* As, const int lane) {
    f32x4 pa0, pa1, pa2, pa3, pa4, pa5, pa6, pa7, pb0, pb1, pb2, pb3, pb4, pb5, pb6, pb7, l0, l1, l2, l3, l4, l5, l6, l7;
    float x0, x1, x2, x3, x4, x5, x6, x7, x8, x9, x10, x11, x12, x13, x14, x15, x16, x17, x18, x19, x20, x21, x22, x23, x24, x25, x26, x27, x28, x29, x30, x31, x32, x33, x34, x35, x36, x37, x38, x39, x40, x41, x42, x43, x44, x45, x46, x47, x48, x49, x50, x51, x52, x53, x54, x55, x56, x57, x58, x59, x60, x61, x62, x63;
    { int li = lane; asm volatile("" : "+v"(li)); x0 = (li == 0) ? 1.f : 0.f; }
    pb0 = INV_LD(1, 0);
    pa0 = INV_LD(2, 0); INV_SB();
    { int li = lane; asm volatile("" : "+v"(li)); float a0 = (li == 1) ? 1.f : 0.f, a1 = 0.f, a2 = 0.f, a3 = 0.f; a0 -= pb0[0] * x0; x1 = (a0 + a1) + (a2 + a3); } INV_SB();
    pb0 = INV_LD(3, 0); INV_SB();
    { int li = lane; asm volatile("" : "+v"(li)); float a0 = (li == 2) ? 1.f : 0.f, a1 = 0.f, a2 = 0.f, a3 = 0.f; a0 -= pa0[0] * x0; a1 -= pa0[1] * x1; x2 = (a0 + a1) + (a2 + a3); } INV_SB();
    pa0 = INV_LD(4, 0); INV_SB();
    { int li = lane; asm volatile("" : "+v"(li)); float a0 = (li == 3) ? 1.f : 0.f, a1 = 0.f, a2 = 0.f, a3 = 0.f; a0 -= pb0[0] * x0; a1 -= pb0[1] * x1; a2 -= pb0[2] * x2; x3 = (a0 + a1) + (a2 + a3); } INV_SB();
    pb0 = INV_LD(5, 0); pb1 = INV_LD(5, 1); INV_SB();
    { int li = lane; asm volatile("" : "+v"(li)); float a0 = (li == 4) ? 1.f : 0.f, a1 = 0.f, a2 = 0.f, a3 = 0.f; a0 -= pa0[0] * x0; a1 -= pa0[1] * x1; a2 -= pa0[2] * x2; a3 -= pa0[3] * x3; x4 = (a0 + a1) + (a2 + a3); } INV_SB();
    pa0 = INV_LD(6, 0); pa1 = INV_LD(6, 1); INV_SB();
    { int li = lane; asm volatile("" : "+v"(li)); float a0 = (li == 5) ? 1.f : 0.f, a1 = 0.f, a2 = 0.f, a3 = 0.f; a0 -= pb0[0] * x0; a1 -= pb0[1] * x1; a2 -= pb0[2] * x2; a3 -= pb0[3] * x3; a0 -= pb1[0] * x4; x5 = (a0 + a1) + (a2 + a3); } INV_SB();
    pb0 = INV_LD(7, 0); pb1 = INV_LD(7, 1); INV_SB();
    { int li = lane; asm volatile("" : "+v"(li)); float a0 = (li == 6) ? 1.f : 0.f, a1 = 0.f, a2 = 0.f, a3 = 0.f; a0 -= pa0[0] * x0; a1 -= pa0[1] * x1; a2 -= pa0[2] * x2; a3 -= pa0[3] * x3; a0 -= pa1[0] * x4; a1 -= pa1[1] * x5; x6 = (a0 + a1) + (a2 + a3); } INV_SB();
    pa0 = INV_LD(8, 0); pa1 = INV_LD(8, 1); INV_SB();
    { int li = lane; asm volatile("" : "+v"(li)); float a0 = (li == 7) ? 1.f : 0.f, a1 = 0.f, a2 = 0.f, a3 = 0.f; a0 -= pb0[0] * x0; a1 -= pb0[1] * x1; a2 -= pb0[2] * x2; a3 -= pb0[3] * x3; a0 -= pb1[0] * x4; a1 -= pb1[1] * x5; a2 -= pb1[2] * x6; x7 = (a0 + a1) + (a2 + a3); } INV_SB();
    pb0 = INV_LD(9, 0); pb1 = INV_LD(9, 1); pb2 = INV_LD(9, 2); INV_SB();
    { int li = lane; asm volatile("" : "+v"(li)); float a0 = (li == 8) ? 1.f : 0.f, a1 = 0.f, a2 = 0.f, a3 = 0.f; a0 -= pa0[0] * x0; a1 -= pa0[1] * x1; a2 -= pa0[2] * x2; a3 -= pa0[3] * x3; a0 -= pa1[0] * x4; a1 -= pa1[1] * x5; a2 -= pa1[2] * x6; a3 -= pa1[3] * x7; x8 = (a0 + a1) + (a2 + a3); } INV_SB();
    pa0 = INV_LD(10, 0); pa1 = INV_LD(10, 1); pa2 = INV_LD(10, 2); INV_SB();
    { int li = lane; asm volatile("" : "+v"(li)); float a0 = (li == 9) ? 1.f : 0.f, a1 = 0.f, a2 = 0.f, a3 = 0.f; a0 -= pb0[0] * x0; a1 -= pb0[1] * x1; a2 -= pb0[2] * x2; a3 -= pb0[3] * x3; a0 -= pb1[0] * x4; a1 -= pb1[1] * x5; a2 -= pb1[2] * x6; a3 -= pb1[3] * x7; a0 -= pb2[0] * x8; x9 = (a0 + a1) + (a2 + a3); } INV_SB();
    pb0 = INV_LD(11, 0); pb1 = INV_LD(11, 1); pb2 = INV_LD(11, 2); INV_SB();
    { int li = lane; asm volatile("" : "+v"(li)); float a0 = (li == 10) ? 1.f : 0.f, a1 = 0.f, a2 = 0.f, a3 = 0.f; a0 -= pa0[0] * x0; a1 -= pa0[1] * x1; a2 -= pa0[2] * x2; a3 -= pa0[3] * x3; a0 -= pa1[0] * x4; a1 -= pa1[1] * x5; a2 -= pa1[2] * x6; a3 -= pa1[3] * x7; a0 -= pa2[0] * x8; a1 -= pa2[1] * x9; x10 = (a0 + a1) + (a2 + a3); } INV_SB();
    pa0 = INV_LD(12, 0); pa1 = INV_LD(12, 1); pa2 = INV_LD(12, 2); INV_SB();
    { int li = lane; asm volatile("" : "+v"(li)); float a0 = (li == 11) ? 1.f : 0.f, a1 = 0.f, a2 = 0.f, a3 = 0.f; a0 -= pb0[0] * x0; a1 -= pb0[1] * x1; a2 -= pb0[2] * x2; a3 -= pb0[3] * x3; a0 -= pb1[0] * x4; a1 -= pb1[1] * x5; a2 -= pb1[2] * x6; a3 -= pb1[3] * x7; a0 -= pb2[0] * x8; a1 -= pb2[1] * x9; a2 -= pb2[2] * x10; x11 = (a0 + a1) + (a2 + a3); } INV_SB();
    pb0 = INV_LD(13, 0); pb1 = INV_LD(13, 1); pb2 = INV_LD(13, 2); pb3 = INV_LD(13, 3); INV_SB();
    { int li = lane; asm volatile("" : "+v"(li)); float a0 = (li == 12) ? 1.f : 0.f, a1 = 0.f, a2 = 0.f, a3 = 0.f; a0 -= pa0[0] * x0; a1 -= pa0[1] * x1; a2 -= pa0[2] * x2; a3 -= pa0[3] * x3; a0 -= pa1[0] * x4; a1 -= pa1[1] * x5; a2 -= pa1[2] * x6; a3 -= pa1[3] * x7; a0 -= pa2[0] * x8; a1 -= pa2[1] * x9; a2 -= pa2[2] * x10; a3 -= pa2[3] * x11; x12 = (a0 + a1) + (a2 + a3); } INV_SB();
    pa0 = INV_LD(14, 0); pa1 = INV_LD(14, 1); pa2 = INV_LD(14, 2); pa3 = INV_LD(14, 3); INV_SB();
    { int li = lane; asm volatile("" : "+v"(li)); float a0 = (li == 13) ? 1.f : 0.f, a1 = 0.f, a2 = 0.f, a3 = 0.f; a0 -= pb0[0] * x0; a1 -= pb0[1] * x1; a2 -= pb0[2] * x2; a3 -= pb0[3] * x3; a0 -= pb1[0] * x4; a1 -= pb1[1] * x5; a2 -= pb1[2] * x6; a3 -= pb1[3] * x7; a0 -= pb2[0] * x8; a1 -= pb2[1] * x9; a2 -= pb2[2] * x10; a3 -= pb2[3] * x11; a0 -= pb3[0] * x12; x13 = (a0 + a1) + (a2 + a3); } INV_SB();
    pb0 = INV_LD(15, 0); pb1 = INV_LD(15, 1); pb2 = INV_LD(15, 2); pb3 = INV_LD(15, 3); INV_SB();
    { int li = lane; asm volatile("" : "+v"(li)); float a0 = (li == 14) ? 1.f : 0.f, a1 = 0.f, a2 = 0.f, a3 = 0.f; a0 -= pa0[0] * x0; a1 -= pa0[1] * x1; a2 -= pa0[2] * x2; a3 -= pa0[3] * x3; a0 -= pa1[0] * x4; a1 -= pa1[1] * x5; a2 -= pa1[2] * x6; a3 -= pa1[3] * x7; a0 -= pa2[0] * x8; a1 -= pa2[1] * x9; a2 -= pa2[2] * x10; a3 -= pa2[3] * x11; a0 -= pa3[0] * x12; a1 -= pa3[1] * x13; x14 = (a0 + a1) + (a2 + a3); } INV_SB();
    pa0 = INV_LD(16, 0); pa1 = INV_LD(16, 1); pa2 = INV_LD(16, 2); pa3 = INV_LD(16, 3); INV_SB();
    { int li = lane; asm volatile("" : "+v"(li)); float a0 = (li == 15) ? 1.f : 0.f, a1 = 0.f, a2 = 0.f, a3 = 0.f; a0 -= pb0[0] * x0; a1 -= pb0[1] * x1; a2 -= pb0[2] * x2; a3 -= pb0[3] * x3; a0 -= pb1[0] * x4; a1 -= pb1[1] * x5; a2 -= pb1[2] * x6; a3 -= pb1[3] * x7; a0 -= pb2[0] * x8; a1 -= pb2[1] * x9; a2 -= pb2[2] * x10; a3 -= pb2[3] * x11; a0 -= pb3[0] * x12; a1 -= pb3[1] * x13; a2 -= pb3[2] * x14; x15 = (a0 + a1) + (a2 + a3); } INV_SB();
    pb0 = INV_LD(17, 0); pb1 = INV_LD(17, 1); pb2 = INV_LD(17, 2); pb3 = INV_LD(17, 3); pb4 = INV_LD(17, 4); INV_SB();
    { int li = lane; asm volatile("" : "+v"(li)); float a0 = (li == 16) ? 1.f : 0.f, a1 = 0.f, a2 = 0.f, a3 = 0.f; a0 -= pa0[0] * x0; a1 -= pa0[1] * x1; a2 -= pa0[2] * x2; a3 -= pa0[3] * x3; a0 -= pa1[0] * x4; a1 -= pa1[1] * x5; a2 -= pa1[2] * x6; a3 -= pa1[3] * x7; a0 -= pa2[0] * x8; a1 -= pa2[1] * x9; a2 -= pa2[2] * x10; a3 -= pa2[3] * x11; a0 -= pa3[0] * x12; a1 -= pa3[1] * x13; a2 -= pa3[2] * x14; a3 -= pa3[3] * x15; x16 = (a0 + a1) + (a2 + a3); } INV_SB();
    pa0 = INV_LD(18, 0); pa1 = INV_LD(18, 1); pa2 = INV_LD(18, 2); pa3 = INV_LD(18, 3); pa4 = INV_LD(18, 4); INV_SB();
    { int li = lane; asm volatile("" : "+v"(li)); float a0 = (li == 17) ? 1.f : 0.f, a1 = 0.f, a2 = 0.f, a3 = 0.f; a0 -= pb0[0] * x0; a1 -= pb0[1] * x1; a2 -= pb0[2] * x2; a3 -= pb0[3] * x3; a0 -= pb1[0] * x4; a1 -= pb1[1] * x5; a2 -= pb1[2] * x6; a3 -= pb1[3] * x7; a0 -= pb2[0] * x8; a1 -= pb2[1] * x9; a2 -= pb2[2] * x10; a3 -= pb2[3] * x11; a0 -= pb3[0] * x12; a1 -= pb3[1] * x13; a2 -= pb3[2] * x14; a3 -= pb3[3] * x15; a0 -= pb4[0] * x16; x17 = (a0 + a1) + (a2 + a3); } INV_SB();
    pb0 = INV_LD(19, 0); pb1 = INV_LD(19, 1); pb2 = INV_LD(19, 2); pb3 = INV_LD(19, 3); pb4 = INV_LD(19, 4); INV_SB();
    { int li = lane; asm volatile("" : "+v"(li)); float a0 = (li == 18) ? 1.f : 0.f, a1 = 0.f, a2 = 0.f, a3 = 0.f; a0 -= pa0[0] * x0; a1 -= pa0[1] * x1; a2 -= pa0[2] * x2; a3 -= pa0[3] * x3; a0 -= pa1[0] * x4; a1 -= pa1[1] * x5; a2 -= pa1[2] * x6; a3 -= pa1[3] * x7; a0 -= pa2[0] * x8; a1 -= pa2[1] * x9; a2 -= pa2[2] * x10; a3 -= pa2[3] * x11; a0 -= pa3[0] * x12; a1 -= pa3[1] * x13; a2 -= pa3[2] * x14; a3 -= pa3[3] * x15; a0 -= pa4[0] * x16; a1 -= pa4[1] * x17; x18 = (a0 + a1) + (a2 + a3); } INV_SB();
    pa0 = INV_LD(20, 0); pa1 = INV_LD(20, 1); pa2 = INV_LD(20, 2); pa3 = INV_LD(20, 3); pa4 = INV_LD(20, 4); INV_SB();
    { int li = lane; asm volatile("" : "+v"(li)); float a0 = (li == 19) ? 1.f : 0.f, a1 = 0.f, a2 = 0.f, a3 = 0.f; a0 -= pb0[0] * x0; a1 -= pb0[1] * x1; a2 -= pb0[2] * x2; a3 -= pb0[3] * x3; a0 -= pb1[0] * x4; a1 -= pb1[1] * x5; a2 -= pb1[2] * x6; a3 -= pb1[3] * x7; a0 -= pb2[0] * x8; a1 -= pb2[1] * x9; a2 -= pb2[2] * x10; a3 -= pb2[3] * x11; a0 -= pb3[0] * x12; a1 -= pb3[1] * x13; a2 -= pb3[2] * x14; a3 -= pb3[3] * x15; a0 -= pb4[0] * x16; a1 -= pb4[1] * x17; a2 -= pb4[2] * x18; x19 = (a0 + a1) + (a2 + a3); } INV_SB();
    pb0 = INV_LD(21, 0); pb1 = INV_LD(21, 1); pb2 = INV_LD(21, 2); pb3 = INV_LD(21, 3); pb4 = INV_LD(21, 4); pb5 = INV_LD(21, 5); INV_SB();
    { int li = lane; asm volatile("" : "+v"(li)); float a0 = (li == 20) ? 1.f : 0.f, a1 = 0.f, a2 = 0.f, a3 = 0.f; a0 -= pa0[0] * x0; a1 -= pa0[1] * x1; a2 -= pa0[2] * x2; a3 -= pa0[3] * x3; a0 -= pa1[0] * x4; a1 -= pa1[1] * x5; a2 -= pa1[2] * x6; a3 -= pa1[3] * x7; a0 -= pa2[0] * x8; a1 -= pa2[1] * x9; a2 -= pa2[2] * x10; a3 -= pa2[3] * x11; a0 -= pa3[0] * x12; a1 -= pa3[1] * x13; a2 -= pa3[2] * x14; a3 -= pa3[3] * x15; a0 -= pa4[0] * x16; a1 -= pa4[1] * x17; a2 -= pa4[2] * x18; a3 -= pa4[3] * x19; x20 = (a0 + a1) + (a2 + a3); } INV_SB();
    pa0 = INV_LD(22, 0); pa1 = INV_LD(22, 1); pa2 = INV_LD(22, 2); pa3 = INV_LD(22, 3); pa4 = INV_LD(22, 4); pa5 = INV_LD(22, 5); INV_SB();
    { int li = lane; asm volatile("" : "+v"(li)); float a0 = (li == 21) ? 1.f : 0.f, a1 = 0.f, a2 = 0.f, a3 = 0.f; a0 -= pb0[0] * x0; a1 -= pb0[1] * x1; a2 -= pb0[2] * x2; a3 -= pb0[3] * x3; a0 -= pb1[0] * x4; a1 -= pb1[1] * x5; a2 -= pb1[2] * x6; a3 -= pb1[3] * x7; a0 -= pb2[0] * x8; a1 -= pb2[1] * x9; a2 -= pb2[2] * x10; a3 -= pb2[3] * x11; a0 -= pb3[0] * x12; a1 -= pb3[1] * x13; a2 -= pb3[2] * x14; a3 -= pb3[3] * x15; a0 -= pb4[0] * x16; a1 -= pb4[1] * x17; a2 -= pb4[2] * x18; a3 -= pb4[3] * x19; a0 -= pb5[0] * x20; x21 = (a0 + a1) + (a2 + a3); } INV_SB();
    pb0 = INV_LD(23, 0); pb1 = INV_LD(23, 1); pb2 = INV_LD(23, 2); pb3 = INV_LD(23, 3); pb4 = INV_LD(23, 4); pb5 = INV_LD(23, 5); INV_SB();
    { int li = lane; asm volatile("" : "+v"(li)); float a0 = (li == 22) ? 1.f : 0.f, a1 = 0.f, a2 = 0.f, a3 = 0.f; a0 -= pa0[0] * x0; a1 -= pa0[1] * x1; a2 -= pa0[2] * x2; a3 -= pa0[3] * x3; a0 -= pa1[0] * x4; a1 -= pa1[1] * x5; a2 -= pa1[2] * x6; a3 -= pa1[3] * x7; a0 -= pa2[0] * x8; a1 -= pa2[1] * x9; a2 -= pa2[2] * x10; a3 -= pa2[3] * x11; a0 -= pa3[0] * x12; a1 -= pa3[1] * x13; a2 -= pa3[2] * x14; a3 -= pa3[3] * x15; a0 -= pa4[0] * x16; a1 -= pa4[1] * x17; a2 -= pa4[2] * x18; a3 -= pa4[3] * x19; a0 -= pa5[0] * x20; a1 -= pa5[1] * x21; x22 = (a0 + a1) + (a2 + a3); } INV_SB();
    pa0 = INV_LD(24, 0); pa1 = INV_LD(24, 1); pa2 = INV_LD(24, 2); pa3 = INV_LD(24, 3); pa4 = INV_LD(24, 4); pa5 = INV_LD(24, 5); INV_SB();
    { int li = lane; asm volatile("" : "+v"(li)); float a0 = (li == 23) ? 1.f : 0.f, a1 = 0.f, a2 = 0.f, a3 = 0.f; a0 -= pb0[0] * x0; a1 -= pb0[1] * x1; a2 -= pb0[2] * x2; a3 -= pb0[3] * x3; a0 -= pb1[0] * x4; a1 -= pb1[1] * x5; a2 -= pb1[2] * x6; a3 -= pb1[3] * x7; a0 -= pb2[0] * x8; a1 -= pb2[1] * x9; a2 -= pb2[2] * x10; a3 -= pb2[3] * x11; a0 -= pb3[0] * x12; a1 -= pb3[1] * x13; a2 -= pb3[2] * x14; a3 -= pb3[3] * x15; a0 -= pb4[0] * x16; a1 -= pb4[1] * x17; a2 -= pb4[2] * x18; a3 -= pb4[3] * x19; a0 -= pb5[0] * x20; a1 -= pb5[1] * x21; a2 -= pb5[2] * x22; x23 = (a0 + a1) + (a2 + a3); } INV_SB();
    pb0 = INV_LD(25, 0); pb1 = INV_LD(25, 1); pb2 = INV_LD(25, 2); pb3 = INV_LD(25, 3); pb4 = INV_LD(25, 4); pb5 = INV_LD(25, 5); pb6 = INV_LD(25, 6); INV_SB();
    { int li = lane; asm volatile("" : "+v"(li)); float a0 = (li == 24) ? 1.f : 0.f, a1 = 0.f, a2 = 0.f, a3 = 0.f; a0 -= pa0[0] * x0; a1 -= pa0[1] * x1; a2 -= pa0[2] * x2; a3 -= pa0[3] * x3; a0 -= pa1[0] * x4; a1 -= pa1[1] * x5; a2 -= pa1[2] * x6; a3 -= pa1[3] * x7; a0 -= pa2[0] * x8; a1 -= pa2[1] * x9; a2 -= pa2[2] * x10; a3 -= pa2[3] * x11; a0 -= pa3[0] * x12; a1 -= pa3[1] * x13; a2 -= pa3[2] * x14; a3 -= pa3[3] * x15; a0 -= pa4[0] * x16; a1 -= pa4[1] * x17; a2 -= pa4[2] * x18; a3 -= pa4[3] * x19; a0 -= pa5[0] * x20; a1 -= pa5[1] * x21; a2 -= pa5[2] * x22; a3 -= pa5[3] * x23; x24 = (a0 + a1) + (a2 + a3); } INV_SB();
    pa0 = INV_LD(26, 0); pa1 = INV_LD(26, 1); pa2 = INV_LD(26, 2); pa3 = INV_LD(26, 3); pa4 = INV_LD(26, 4); pa5 = INV_LD(26, 5); pa6 = INV_LD(26, 6); INV_SB();
    { int li = lane; asm volatile("" : "+v"(li)); float a0 = (li == 25) ? 1.f : 0.f, a1 = 0.f, a2 = 0.f, a3 = 0.f; a0 -= pb0[0] * x0; a1 -= pb0[1] * x1; a2 -= pb0[2] * x2; a3 -= pb0[3] * x3; a0 -= pb1[0] * x4; a1 -= pb1[1] * x5; a2 -= pb1[2] * x6; a3 -= pb1[3] * x7; a0 -= pb2[0] * x8; a1 -= pb2[1] * x9; a2 -= pb2[2] * x10; a3 -= pb2[3] * x11; a0 -= pb3[0] * x12; a1 -= pb3[1] * x13; a2 -= pb3[2] * x14; a3 -= pb3[3] * x15; a0 -= pb4[0] * x16; a1 -= pb4[1] * x17; a2 -= pb4[2] * x18; a3 -= pb4[3] * x19; a0 -= pb5[0] * x20; a1 -= pb5[1] * x21; a2 -= pb5[2] * x22; a3 -= pb5[3] * x23; a0 -= pb6[0] * x24; x25 = (a0 + a1) + (a2 + a3); } INV_SB();
    pb0 = INV_LD(27, 0); pb1 = INV_LD(27, 1); pb2 = INV_LD(27, 2); pb3 = INV_LD(27, 3); pb4 = INV_LD(27, 4); pb5 = INV_LD(27, 5); pb6 = INV_LD(27, 6); INV_SB();
    { int li = lane; asm volatile("" : "+v"(li)); float a0 = (li == 26) ? 1.f : 0.f, a1 = 0.f, a2 = 0.f, a3 = 0.f; a0 -= pa0[0] * x0; a1 -= pa0[1] * x1; a2 -= pa0[2] * x2; a3 -= pa0[3] * x3; a0 -= pa1[0] * x4; a1 -= pa1[1] * x5; a2 -= pa1[2] * x6; a3 -= pa1[3] * x7; a0 -= pa2[0] * x8; a1 -= pa2[1] * x9; a2 -= pa2[2] * x10; a3 -= pa2[3] * x11; a0 -= pa3[0] * x12; a1 -= pa3[1] * x13; a2 -= pa3[2] * x14; a3 -= pa3[3] * x15; a0 -= pa4[0] * x16; a1 -= pa4[1] * x17; a2 -= pa4[2] * x18; a3 -= pa4[3] * x19; a0 -= pa5[0] * x20; a1 -= pa5[1] * x21; a2 -= pa5[2] * x22; a3 -= pa5[3] * x23; a0 -= pa6[0] * x24; a1 -= pa6[1] * x25; x26 = (a0 + a1) + (a2 + a3); } INV_SB();
    pa0 = INV_LD(28, 0); pa1 = INV_LD(28, 1); pa2 = INV_LD(28, 2); pa3 = INV_LD(28, 3); pa4 = INV_LD(28, 4); pa5 = INV_LD(28, 5); pa6 = INV_LD(28, 6); INV_SB();
    { int li = lane; asm volatile("" : "+v"(li)); float a0 = (li == 27) ? 1.f : 0.f, a1 = 0.f, a2 = 0.f, a3 = 0.f; a0 -= pb0[0] * x0; a1 -= pb0[1] * x1; a2 -= pb0[2] * x2; a3 -= pb0[3] * x3; a0 -= pb1[0] * x4; a1 -= pb1[1] * x5; a2 -= pb1[2] * x6; a3 -= pb1[3] * x7; a0 -= pb2[0] * x8; a1 -= pb2[1] * x9; a2 -= pb2[2] * x10; a3 -= pb2[3] * x11; a0 -= pb3[0] * x12; a1 -= pb3[1] * x13; a2 -= pb3[2] * x14; a3 -= pb3[3] * x15; a0 -= pb4[0] * x16; a1 -= pb4[1] * x17; a2 -= pb4[2] * x18; a3 -= pb4[3] * x19; a0 -= pb5[0] * x20; a1 -= pb5[1] * x21; a2 -= pb5[2] * x22; a3 -= pb5[3] * x23; a0 -= pb6[0] * x24; a1 -= pb6[1] * x25; a2 -= pb6[2] * x26; x27 = (a0 + a1) + (a2 + a3); } INV_SB();
    pb0 = INV_LD(29, 0); pb1 = INV_LD(29, 1); pb2 = INV_LD(29, 2); pb3 = INV_LD(29, 3); pb4 = INV_LD(29, 4); pb5 = INV_LD(29, 5); pb6 = INV_LD(29, 6); pb7 = INV_LD(29, 7); INV_SB();
    { int li = lane; asm volatile("" : "+v"(li)); float a0 = (li == 28) ? 1.f : 0.f, a1 = 0.f, a2 = 0.f, a3 = 0.f; a0 -= pa0[0] * x0; a1 -= pa0[1] * x1; a2 -= pa0[2] * x2; a3 -= pa0[3] * x3; a0 -= pa1[0] * x4; a1 -= pa1[1] * x5; a2 -= pa1[2] * x6; a3 -= pa1[3] * x7; a0 -= pa2[0] * x8; a1 -= pa2[1] * x9; a2 -= pa2[2] * x10; a3 -= pa2[3] * x11; a0 -= pa3[0] * x12; a1 -= pa3[1] * x13; a2 -= pa3[2] * x14; a3 -= pa3[3] * x15; a0 -= pa4[0] * x16; a1 -= pa4[1] * x17; a2 -= pa4[2] * x18; a3 -= pa4[3] * x19; a0 -= pa5[0] * x20; a1 -= pa5[1] * x21; a2 -= pa5[2] * x22; a3 -= pa5[3] * x23; a0 -= pa6[0] * x24; a1 -= pa6[1] * x25; a2 -= pa6[2] * x26; a3 -= pa6[3] * x27; x28 = (a0 + a1) + (a2 + a3); } INV_SB();
    pa0 = INV_LD(30, 0); pa1 = INV_LD(30, 1); pa2 = INV_LD(30, 2); pa3 = INV_LD(30, 3); pa4 = INV_LD(30, 4); pa5 = INV_LD(30, 5); pa6 = INV_LD(30, 6); pa7 = INV_LD(30, 7); INV_SB();
    { int li = lane; asm volatile("" : "+v"(li)); float a0 = (li == 29) ? 1.f : 0.f, a1 = 0.f, a2 = 0.f, a3 = 0.f; a0 -= pb0[0] * x0; a1 -= pb0[1] * x1; a2 -= pb0[2] * x2; a3 -= pb0[3] * x3; a0 -= pb1[0] * x4; a1 -= pb1[1] * x5; a2 -= pb1[2] * x6; a3 -= pb1[3] * x7; a0 -= pb2[0] * x8; a1 -= pb2[1] * x9; a2 -= pb2[2] * x10; a3 -= pb2[3] * x11; a0 -= pb3[0] * x12; a1 -= pb3[1] * x13; a2 -= pb3[2] * x14; a3 -= pb3[3] * x15; a0 -= pb4[0] * x16; a1 -= pb4[1] * x17; a2 -= pb4[2] * x18; a3 -= pb4[3] * x19; a0 -= pb5[0] * x20; a1 -= pb5[1] * x21; a2 -= pb5[2] * x22; a3 -= pb5[3] * x23; a0 -= pb6[0] * x24; a1 -= pb6[1] * x25; a2 -= pb6[2] * x26; a3 -= pb6[3] * x27; a0 -= pb7[0] * x28; x29 = (a0 + a1) + (a2 + a3); } INV_SB();
    pb0 = INV_LD(31, 0); pb1 = INV_LD(31, 1); pb2 = INV_LD(31, 2); pb3 = INV_LD(31, 3); pb4 = INV_LD(31, 4); pb5 = INV_LD(31, 5); pb6 = INV_LD(31, 6); pb7 = INV_LD(31, 7); INV_SB();
    { int li = lane; asm volatile("" : "+v"(li)); float a0 = (li == 30) ? 1.f : 0.f, a1 = 0.f, a2 = 0.f, a3 = 0.f; a0 -= pa0[0] * x0; a1 -= pa0[1] * x1; a2 -= pa0[2] * x2; a3 -= pa0[3] * x3; a0 -= pa1[0] * x4; a1 -= pa1[1] * x5; a2 -= pa1[2] * x6; a3 -= pa1[3] * x7; a0 -= pa2[0] * x8; a1 -= pa2[1] * x9; a2 -= pa2[2] * x10; a3 -= pa2[3] * x11; a0 -= pa3[0] * x12; a1 -= pa3[1] * x13; a2 -= pa3[2] * x14; a3 -= pa3[3] * x15; a0 -= pa4[0] * x16; a1 -= pa4[1] * x17; a2 -= pa4[2] * x18; a3 -= pa4[3] * x19; a0 -= pa5[0] * x20; a1 -= pa5[1] * x21; a2 -= pa5[2] * x22; a3 -= pa5[3] * x23; a0 -= pa6[0] * x24; a1 -= pa6[1] * x25; a2 -= pa6[2] * x26; a3 -= pa6[3] * x27; a0 -= pa7[0] * x28; a1 -= pa7[1] * x29; x30 = (a0 + a1) + (a2 + a3); } INV_SB();
    pa0 = INV_LD(32, 0); pa1 = INV_LD(32, 1); pa2 = INV_LD(32, 2); pa3 = INV_LD(32, 3); pa4 = INV_LD(32, 4); pa5 = INV_LD(32, 5); pa6 = INV_LD(32, 6); pa7 = INV_LD(32, 7); INV_SB();
    { int li = lane; asm volatile("" : "+v"(li)); float a0 = (li == 31) ? 1.f : 0.f, a1 = 0.f, a2 = 0.f, a3 = 0.f; a0 -= pb0[0] * x0; a1 -= pb0[1] * x1; a2 -= pb0[2] * x2; a3 -= pb0[3] * x3; a0 -= pb1[0] * x4; a1 -= pb1[1] * x5; a2 -= pb1[2] * x6; a3 -= pb1[3] * x7; a0 -= pb2[0] * x8; a1 -= pb2[1] * x9; a2 -= pb2[2] * x10; a3 -= pb2[3] * x11; a0 -= pb3[0] * x12; a1 -= pb3[1] * x13; a2 -= pb3[2] * x14; a3 -= pb3[3] * x15; a0 -= pb4[0] * x16; a1 -= pb4[1] * x17; a2 -= pb4[2] * x18; a3 -= pb4[3] * x19; a0 -= pb5[0] * x20; a1 -= pb5[1] * x21; a2 -= pb5[2] * x22; a3 -= pb5[3] * x23; a0 -= pb6[0] * x24; a1 -= pb6[1] * x25; a2 -= pb6[2] * x26; a3 -= pb6[3] * x27; a0 -= pb7[0] * x28; a1 -= pb7[1] * x29; a2 -= pb7[2] * x30; x31 = (a0 + a1) + (a2 + a3); } INV_SB();
    pb0 = INV_LD(33, 0); pb1 = INV_LD(33, 1); pb2 = INV_LD(33, 2); pb3 = INV_LD(33, 3); pb4 = INV_LD(33, 4); pb5 = INV_LD(33, 5); pb6 = INV_LD(33, 6); pb7 = INV_LD(33, 7); INV_SB();
    { int li = lane; asm volatile("" : "+v"(li)); float a0 = (li == 32) ? 1.f : 0.f, a1 = 0.f, a2 = 0.f, a3 = 0.f; a0 -= pa0[0] * x0; a1 -= pa0[1] * x1; a2 -= pa0[2] * x2; a3 -= pa0[3] * x3; a0 -= pa1[0] * x4; a1 -= pa1[1] * x5; a2 -= pa1[2] * x6; a3 -= pa1[3] * x7; a0 -= pa2[0] * x8; a1 -= pa2[1] * x9; a2 -= pa2[2] * x10; a3 -= pa2[3] * x11; a0 -= pa3[0] * x12; a1 -= pa3[1] * x13; a2 -= pa3[2] * x14; a3 -= pa3[3] * x15; a0 -= pa4[0] * x16; a1 -= pa4[1] * x17; a2 -= pa4[2] * x18; a3 -= pa4[3] * x19; a0 -= pa5[0] * x20; a1 -= pa5[1] * x21; a2 -= pa5[2] * x22; a3 -= pa5[3] * x23; a0 -= pa6[0] * x24; a1 -= pa6[1] * x25; a2 -= pa6[2] * x26; a3 -= pa6[3] * x27; a0 -= pa7[0] * x28; a1 -= pa7[1] * x29; a2 -= pa7[2] * x30; a3 -= pa7[3] * x31; x32 = (a0 + a1) + (a2 + a3); } INV_SB();
    l0 = INV_LD(33, 8); pa0 = INV_LD(34, 0); pa1 = INV_LD(34, 1); pa2 = INV_LD(34, 2); pa3 = INV_LD(34, 3); pa4 = INV_LD(34, 4); pa5 = INV_LD(34, 5); pa6 = INV_LD(34, 6); pa7 = INV_LD(34, 7); INV_SB();
    { int li = lane; asm volatile("" : "+v"(li)); float a0 = (li == 33) ? 1.f : 0.f, a1 = 0.f, a2 = 0.f, a3 = 0.f; a0 -= pb0[0] * x0; a1 -= pb0[1] * x1; a2 -= pb0[2] * x2; a3 -= pb0[3] * x3; a0 -= pb1[0] * x4; a1 -= pb1[1] * x5; a2 -= pb1[2] * x6; a3 -= pb1[3] * x7; a0 -= pb2[0] * x8; a1 -= pb2[1] * x9; a2 -= pb2[2] * x10; a3 -= pb2[3] * x11; a0 -= pb3[0] * x12; a1 -= pb3[1] * x13; a2 -= pb3[2] * x14; a3 -= pb3[3] * x15; a0 -= pb4[0] * x16; a1 -= pb4[1] * x17; a2 -= pb4[2] * x18; a3 -= pb4[3] * x19; a0 -= pb5[0] * x20; a1 -= pb5[1] * x21; a2 -= pb5[2] * x22; a3 -= pb5[3] * x23; a0 -= pb6[0] * x24; a1 -= pb6[1] * x25; a2 -= pb6[2] * x26; a3 -= pb6[3] * x27; a0 -= pb7[0] * x28; a1 -= pb7[1] * x29; a2 -= pb7[2] * x30; a3 -= pb7[3] * x31; a0 -= l0[0] * x32; x33 = (a0 + a1) + (a2 + a3); } INV_SB();
    l0 = INV_LD(34, 8); pb0 = INV_LD(35, 0); pb1 = INV_LD(35, 1); pb2 = INV_LD(35, 2); pb3 = INV_LD(35, 3); pb4 = INV_LD(35, 4); pb5 = INV_LD(35, 5); pb6 = INV_LD(35, 6); pb7 = INV_LD(35, 7); INV_SB();
    { int li = lane; asm volatile("" : "+v"(li)); float a0 = (li == 34) ? 1.f : 0.f, a1 = 0.f, a2 = 0.f, a3 = 0.f; a0 -= pa0[0] * x0; a1 -= pa0[1] * x1; a2 -= pa0[2] * x2; a3 -= pa0[3] * x3; a0 -= pa1[0] * x4; a1 -= pa1[1] * x5; a2 -= pa1[2] * x6; a3 -= pa1[3] * x7; a0 -= pa2[0] * x8; a1 -= pa2[1] * x9; a2 -= pa2[2] * x10; a3 -= pa2[3] * x11; a0 -= pa3[0] * x12; a1 -= pa3[1] * x13; a2 -= pa3[2] * x14; a3 -= pa3[3] * x15; a0 -= pa4[0] * x16; a1 -= pa4[1] * x17; a2 -= pa4[2] * x18; a3 -= pa4[3] * x19; a0 -= pa5[0] * x20; a1 -= pa5[1] * x21; a2 -= pa5[2] * x22; a3 -= pa5[3] * x23; a0 -= pa6[0] * x24; a1 -= pa6[1] * x25; a2 -= pa6[2] * x26; a3 -= pa6[3] * x27; a0 -= pa7[0] * x28; a1 -= pa7[1] * x29; a2 -= pa7[2] * x30; a3 -= pa7[3] * x31; a0 -= l0[0] * x32; a1 -= l0[1] * x33; x34 = (a0 + a1) + (a2 + a3); } INV_SB();
    l0 = INV_LD(35, 8); pa0 = INV_LD(36, 0); pa1 = INV_LD(36, 1); pa2 = INV_LD(36, 2); pa3 = INV_LD(36, 3); pa4 = INV_LD(36, 4); pa5 = INV_LD(36, 5); pa6 = INV_LD(36, 6); pa7 = INV_LD(36, 7); INV_SB();
    { int li = lane; asm volatile("" : "+v"(li)); float a0 = (li == 35) ? 1.f : 0.f, a1 = 0.f, a2 = 0.f, a3 = 0.f; a0 -= pb0[0] * x0; a1 -= pb0[1] * x1; a2 -= pb0[2] * x2; a3 -= pb0[3] * x3; a0 -= pb1[0] * x4; a1 -= pb1[1] * x5; a2 -= pb1[2] * x6; a3 -= pb1[3] * x7; a0 -= pb2[0] * x8; a1 -= pb2[1] * x9; a2 -= pb2[2] * x10; a3 -= pb2[3] * x11; a0 -= pb3[0] * x12; a1 -= pb3[1] * x13; a2 -= pb3[2] * x14; a3 -= pb3[3] * x15; a0 -= pb4[0] * x16; a1 -= pb4[1] * x17; a2 -= pb4[2] * x18; a3 -= pb4[3] * x19; a0 -= pb5[0] * x20; a1 -= pb5[1] * x21; a2 -= pb5[2] * x22; a3 -= pb5[3] * x23; a0 -= pb6[0] * x24; a1 -= pb6[1] * x25; a2 -= pb6[2] * x26; a3 -= pb6[3] * x27; a0 -= pb7[0] * x28; a1 -= pb7[1] * x29; a2 -= pb7[2] * x30; a3 -= pb7[3] * x31; a0 -= l0[0] * x32; a1 -= l0[1] * x33; a2 -= l0[2] * x34; x35 = (a0 + a1) + (a2 + a3); } INV_SB();
    l0 = INV_LD(36, 8); pb0 = INV_LD(37, 0); pb1 = INV_LD(37, 1); pb2 = INV_LD(37, 2); pb3 = INV_LD(37, 3); pb4 = INV_LD(37, 4); pb5 = INV_LD(37, 5); pb6 = INV_LD(37, 6); pb7 = INV_LD(37, 7); INV_SB();
    { int li = lane; asm volatile("" : "+v"(li)); float a0 = (li == 36) ? 1.f : 0.f, a1 = 0.f, a2 = 0.f, a3 = 0.f; a0 -= pa0[0] * x0; a1 -= pa0[1] * x1; a2 -= pa0[2] * x2; a3 -= pa0[3] * x3; a0 -= pa1[0] * x4; a1 -= pa1[1] * x5; a2 -= pa1[2] * x6; a3 -= pa1[3] * x7; a0 -= pa2[0] * x8; a1 -= pa2[1] * x9; a2 -= pa2[2] * x10; a3 -= pa2[3] * x11; a0 -= pa3[0] * x12; a1 -= pa3[1] * x13; a2 -= pa3[2] * x14; a3 -= pa3[3] * x15; a0 -= pa4[0] * x16; a1 -= pa4[1] * x17; a2 -= pa4[2] * x18; a3 -= pa4[3] * x19; a0 -= pa5[0] * x20; a1 -= pa5[1] * x21; a2 -= pa5[2] * x22; a3 -= pa5[3] * x23; a0 -= pa6[0] * x24; a1 -= pa6[1] * x25; a2 -= pa6[2] * x26; a3 -= pa6[3] * x27; a0 -= pa7[0] * x28; a1 -= pa7[1] * x29; a2 -= pa7[2] * x30; a3 -= pa7[3] * x31; a0 -= l0[0] * x32; a1 -= l0[1] * x33; a2 -= l0[2] * x34; a3 -= l0[3] * x35; x36 = (a0 + a1) + (a2 + a3); } INV_SB();
    l0 = INV_LD(37, 8); l1 = INV_LD(37, 9); pa0 = INV_LD(38, 0); pa1 = INV_LD(38, 1); pa2 = INV_LD(38, 2); pa3 = INV_LD(38, 3); pa4 = INV_LD(38, 4); pa5 = INV_LD(38, 5); pa6 = INV_LD(38, 6); pa7 = INV_LD(38, 7); INV_SB();
    { int li = lane; asm volatile("" : "+v"(li)); float a0 = (li == 37) ? 1.f : 0.f, a1 = 0.f, a2 = 0.f, a3 = 0.f; a0 -= pb0[0] * x0; a1 -= pb0[1] * x1; a2 -= pb0[2] * x2; a3 -= pb0[3] * x3; a0 -= pb1[0] * x4; a1 -= pb1[1] * x5; a2 -= pb1[2] * x6; a3 -= pb1[3] * x7; a0 -= pb2[0] * x8; a1 -= pb2[1] * x9; a2 -= pb2[2] * x10; a3 -= pb2[3] * x11; a0 -= pb3[0] * x12; a1 -= pb3[1] * x13; a2 -= pb3[2] * x14; a3 -= pb3[3] * x15; a0 -= pb4[0] * x16; a1 -= pb4[1] * x17; a2 -= pb4[2] * x18; a3 -= pb4[3] * x19; a0 -= pb5[0] * x20; a1 -= pb5[1] * x21; a2 -= pb5[2] * x22; a3 -= pb5[3] * x23; a0 -= pb6[0] * x24; a1 -= pb6[1] * x25; a2 -= pb6[2] * x26; a3 -= pb6[3] * x27; a0 -= pb7[0] * x28; a1 -= pb7[1] * x29; a2 -= pb7[2] * x30; a3 -= pb7[3] * x31; a0 -= l0[0] * x32; a1 -= l0[1] * x33; a2 -= l0[2] * x34; a3 -= l0[3] * x35; a0 -= l1[0] * x36; x37 = (a0 + a1) + (a2 + a3); } INV_SB();
    l0 = INV_LD(38, 8); l1 = INV_LD(38, 9); pb0 = INV_LD(39, 0); pb1 = INV_LD(39, 1); pb2 = INV_LD(39, 2); pb3 = INV_LD(39, 3); pb4 = INV_LD(39, 4); pb5 = INV_LD(39, 5); pb6 = INV_LD(39, 6); pb7 = INV_LD(39, 7); INV_SB();
    { int li = lane; asm volatile("" : "+v"(li)); float a0 = (li == 38) ? 1.f : 0.f, a1 = 0.f, a2 = 0.f, a3 = 0.f; a0 -= pa0[0] * x0; a1 -= pa0[1] * x1; a2 -= pa0[2] * x2; a3 -= pa0[3] * x3; a0 -= pa1[0] * x4; a1 -= pa1[1] * x5; a2 -= pa1[2] * x6; a3 -= pa1[3] * x7; a0 -= pa2[0] * x8; a1 -= pa2[1] * x9; a2 -= pa2[2] * x10; a3 -= pa2[3] * x11; a0 -= pa3[0] * x12; a1 -= pa3[1] * x13; a2 -= pa3[2] * x14; a3 -= pa3[3] * x15; a0 -= pa4[0] * x16; a1 -= pa4[1] * x17; a2 -= pa4[2] * x18; a3 -= pa4[3] * x19; a0 -= pa5[0] * x20; a1 -= pa5[1] * x21; a2 -= pa5[2] * x22; a3 -= pa5[3] * x23; a0 -= pa6[0] * x24; a1 -= pa6[1] * x25; a2 -= pa6[2] * x26; a3 -= pa6[3] * x27; a0 -= pa7[0] * x28; a1 -= pa7[1] * x29; a2 -= pa7[2] * x30; a3 -= pa7[3] * x31; a0 -= l0[0] * x32; a1 -= l0[1] * x33; a2 -= l0[2] * x34; a3 -= l0[3] * x35; a0 -= l1[0] * x36; a1 -= l1[1] * x37; x38 = (a0 + a1) + (a2 + a3); } INV_SB();
    l0 = INV_LD(39, 8); l1 = INV_LD(39, 9); pa0 = INV_LD(40, 0); pa1 = INV_LD(40, 1); pa2 = INV_LD(40, 2); pa3 = INV_LD(40, 3); pa4 = INV_LD(40, 4); pa5 = INV_LD(40, 5); pa6 = INV_LD(40, 6); pa7 = INV_LD(40, 7); INV_SB();
    { int li = lane; asm volatile("" : "+v"(li)); float a0 = (li == 39) ? 1.f : 0.f, a1 = 0.f, a2 = 0.f, a3 = 0.f; a0 -= pb0[0] * x0; a1 -= pb0[1] * x1; a2 -= pb0[2] * x2; a3 -= pb0[3] * x3; a0 -= pb1[0] * x4; a1 -= pb1[1] * x5; a2 -= pb1[2] * x6; a3 -= pb1[3] * x7; a0 -= pb2[0] * x8; a1 -= pb2[1] * x9; a2 -= pb2[2] * x10; a3 -= pb2[3] * x11; a0 -= pb3[0] * x12; a1 -= pb3[1] * x13; a2 -= pb3[2] * x14; a3 -= pb3[3] * x15; a0 -= pb4[0] * x16; a1 -= pb4[1] * x17; a2 -= pb4[2] * x18; a3 -= pb4[3] * x19; a0 -= pb5[0] * x20; a1 -= pb5[1] * x21; a2 -= pb5[2] * x22; a3 -= pb5[3] * x23; a0 -= pb6[0] * x24; a1 -= pb6[1] * x25; a2 -= pb6[2] * x26; a3 -= pb6[3] * x27; a0 -= pb7[0] * x28; a1 -= pb7[1] * x29; a2 -= pb7[2] * x30; a3 -= pb7[3] * x31; a0 -= l0[0] * x32; a1 -= l0[1] * x33; a2 -= l0[2] * x34; a3 -= l0[3] * x35; a0 -= l1[0] * x36; a1 -= l1[1] * x37; a2 -= l1[2] * x38; x39 = (a0 + a1) + (a2 + a3); } INV_SB();
    l0 = INV_LD(40, 8); l1 = INV_LD(40, 9); pb0 = INV_LD(41, 0); pb1 = INV_LD(41, 1); pb2 = INV_LD(41, 2); pb3 = INV_LD(41, 3); pb4 = INV_LD(41, 4); pb5 = INV_LD(41, 5); pb6 = INV_LD(41, 6); pb7 = INV_LD(41, 7); INV_SB();
    { int li = lane; asm volatile("" : "+v"(li)); float a0 = (li == 40) ? 1.f : 0.f, a1 = 0.f, a2 = 0.f, a3 = 0.f; a0 -= pa0[0] * x0; a1 -= pa0[1] * x1; a2 -= pa0[2] * x2; a3 -= pa0[3] * x3; a0 -= pa1[0] * x4; a1 -= pa1[1] * x5; a2 -= pa1[2] * x6; a3 -= pa1[3] * x7; a0 -= pa2[0] * x8; a1 -= pa2[1] * x9; a2 -= pa2[2] * x10; a3 -= pa2[3] * x11; a0 -= pa3[0] * x12; a1 -= pa3[1] * x13; a2 -= pa3[2] * x14; a3 -= pa3[3] * x15; a0 -= pa4[0] * x16; a1 -= pa4[1] * x17; a2 -= pa4[2] * x18; a3 -= pa4[3] * x19; a0 -= pa5[0] * x20; a1 -= pa5[1] * x21; a2 -= pa5[2] * x22; a3 -= pa5[3] * x23; a0 -= pa6[0] * x24; a1 -= pa6[1] * x25; a2 -= pa6[2] * x26; a3 -= pa6[3] * x27; a0 -= pa7[0] * x28; a1 -= pa7[1] * x29; a2 -= pa7[2] * x30; a3 -= pa7[3] * x31; a0 -= l0[0] * x32; a1 -= l0[1] * x33; a2 -= l0[2] * x34; a3 -= l0[3] * x35; a0 -= l1[0] * x36; a1 -= l1[1] * x37; a2 -= l1[2] * x38; a3 -= l1[3] * x39; x40 = (a0 + a1) + (a2 + a3); } INV_SB();
    l0 = INV_LD(41, 8); l1 = INV_LD(41, 9); l2 = INV_LD(41, 10); pa0 = INV_LD(42, 0); pa1 = INV_LD(42, 1); pa2 = INV_LD(42, 2); pa3 = INV_LD(42, 3); pa4 = INV_LD(42, 4); pa5 = INV_LD(42, 5); pa6 = INV_LD(42, 6); pa7 = INV_LD(42, 7); INV_SB();
    { int li = lane; asm volatile("" : "+v"(li)); float a0 = (li == 41) ? 1.f : 0.f, a1 = 0.f, a2 = 0.f, a3 = 0.f; a0 -= pb0[0] * x0; a1 -= pb0[1] * x1; a2 -= pb0[2] * x2; a3 -= pb0[3] * x3; a0 -= pb1[0] * x4; a1 -= pb1[1] * x5; a2 -= pb1[2] * x6; a3 -= pb1[3] * x7; a0 -= pb2[0] * x8; a1 -= pb2[1] * x9; a2 -= pb2[2] * x10; a3 -= pb2[3] * x11; a0 -= pb3[0] * x12; a1 -= pb3[1] * x13; a2 -= pb3[2] * x14; a3 -= pb3[3] * x15; a0 -= pb4[0] * x16; a1 -= pb4[1] * x17; a2 -= pb4[2] * x18; a3 -= pb4[3] * x19; a0 -= pb5[0] * x20; a1 -= pb5[1] * x21; a2 -= pb5[2] * x22; a3 -= pb5[3] * x23; a0 -= pb6[0] * x24; a1 -= pb6[1] * x25; a2 -= pb6[2] * x26; a3 -= pb6[3] * x27; a0 -= pb7[0] * x28; a1 -= pb7[1] * x29; a2 -= pb7[2] * x30; a3 -= pb7[3] * x31; a0 -= l0[0] * x32; a1 -= l0[1] * x33; a2 -= l0[2] * x34; a3 -= l0[3] * x35; a0 -= l1[0] * x36; a1 -= l1[1] * x37; a2 -= l1[2] * x38; a3 -= l1[3] * x39; a0 -= l2[0] * x40; x41 = (a0 + a1) + (a2 + a3); } INV_SB();
    l0 = INV_LD(42, 8); l1 = INV_LD(42, 9); l2 = INV_LD(42, 10); pb0 = INV_LD(43, 0); pb1 = INV_LD(43, 1); pb2 = INV_LD(43, 2); pb3 = INV_LD(43, 3); pb4 = INV_LD(43, 4); pb5 = INV_LD(43, 5); pb6 = INV_LD(43, 6); pb7 = INV_LD(43, 7); INV_SB();
    { int li = lane; asm volatile("" : "+v"(li)); float a0 = (li == 42) ? 1.f : 0.f, a1 = 0.f, a2 = 0.f, a3 = 0.f; a0 -= pa0[0] * x0; a1 -= pa0[1] * x1; a2 -= pa0[2] * x2; a3 -= pa0[3] * x3; a0 -= pa1[0] * x4; a1 -= pa1[1] * x5; a2 -= pa1[2] * x6; a3 -= pa1[3] * x7; a0 -= pa2[0] * x8; a1 -= pa2[1] * x9; a2 -= pa2[2] * x10; a3 -= pa2[3] * x11; a0 -= pa3[0] * x12; a1 -= pa3[1] * x13; a2 -= pa3[2] * x14; a3 -= pa3[3] * x15; a0 -= pa4[0] * x16; a1 -= pa4[1] * x17; a2 -= pa4[2] * x18; a3 -= pa4[3] * x19; a0 -= pa5[0] * x20; a1 -= pa5[1] * x21; a2 -= pa5[2] * x22; a3 -= pa5[3] * x23; a0 -= pa6[0] * x24; a1 -= pa6[1] * x25; a2 -= pa6[2] * x26; a3 -= pa6[3] * x27; a0 -= pa7[0] * x28; a1 -= pa7[1] * x29; a2 -= pa7[2] * x30; a3 -= pa7[3] * x31; a0 -= l0[0] * x32; a1 -= l0[1] * x33; a2 -= l0[2] * x34; a3 -= l0[3] * x35; a0 -= l1[0] * x36; a1 -= l1[1] * x37; a2 -= l1[2] * x38; a3 -= l1[3] * x39; a0 -= l2[0] * x40; a1 -= l2[1] * x41; x42 = (a0 + a1) + (a2 + a3); } INV_SB();
    l0 = INV_LD(43, 8); l1 = INV_LD(43, 9); l2 = INV_LD(43, 10); pa0 = INV_LD(44, 0); pa1 = INV_LD(44, 1); pa2 = INV_LD(44, 2); pa3 = INV_LD(44, 3); pa4 = INV_LD(44, 4); pa5 = INV_LD(44, 5); pa6 = INV_LD(44, 6); pa7 = INV_LD(44, 7); INV_SB();
    { int li = lane; asm volatile("" : "+v"(li)); float a0 = (li == 43) ? 1.f : 0.f, a1 = 0.f, a2 = 0.f, a3 = 0.f; a0 -= pb0[0] * x0; a1 -= pb0[1] * x1; a2 -= pb0[2] * x2; a3 -= pb0[3] * x3; a0 -= pb1[0] * x4; a1 -= pb1[1] * x5; a2 -= pb1[2] * x6; a3 -= pb1[3] * x7; a0 -= pb2[0] * x8; a1 -= pb2[1] * x9; a2 -= pb2[2] * x10; a3 -= pb2[3] * x11; a0 -= pb3[0] * x12; a1 -= pb3[1] * x13; a2 -= pb3[2] * x14; a3 -= pb3[3] * x15; a0 -= pb4[0] * x16; a1 -= pb4[1] * x17; a2 -= pb4[2] * x18; a3 -= pb4[3] * x19; a0 -= pb5[0] * x20; a1 -= pb5[1] * x21; a2 -= pb5[2] * x22; a3 -= pb5[3] * x23; a0 -= pb6[0] * x24; a1 -= pb6[1] * x25; a2 -= pb6[2] * x26; a3 -= pb6[3] * x27; a0 -= pb7[0] * x28; a1 -= pb7[1] * x29; a2 -= pb7[2] * x30; a3 -= pb7[3] * x31; a0 -= l0[0] * x32; a1 -= l0[1] * x33; a2 -= l0[2] * x34; a3 -= l0[3] * x35; a0 -= l1[0] * x36; a1 -= l1[1] * x37; a2 -= l1[2] * x38; a3 -= l1[3] * x39; a0 -= l2[0] * x40; a1 -= l2[1] * x41; a2 -= l2[2] * x42; x43 = (a0 + a1) + (a2 + a3); } INV_SB();
    l0 = INV_LD(44, 8); l1 = INV_LD(44, 9); l2 = INV_LD(44, 10); pb0 = INV_LD(45, 0); pb1 = INV_LD(45, 1); pb2 = INV_LD(45, 2); pb3 = INV_LD(45, 3); pb4 = INV_LD(45, 4); pb5 = INV_LD(45, 5); pb6 = INV_LD(45, 6); pb7 = INV_LD(45, 7); INV_SB();
    { int li = lane; asm volatile("" : "+v"(li)); float a0 = (li == 44) ? 1.f : 0.f, a1 = 0.f, a2 = 0.f, a3 = 0.f; a0 -= pa0[0] * x0; a1 -= pa0[1] * x1; a2 -= pa0[2] * x2; a3 -= pa0[3] * x3; a0 -= pa1[0] * x4; a1 -= pa1[1] * x5; a2 -= pa1[2] * x6; a3 -= pa1[3] * x7; a0 -= pa2[0] * x8; a1 -= pa2[1] * x9; a2 -= pa2[2] * x10; a3 -= pa2[3] * x11; a0 -= pa3[0] * x12; a1 -= pa3[1] * x13; a2 -= pa3[2] * x14; a3 -= pa3[3] * x15; a0 -= pa4[0] * x16; a1 -= pa4[1] * x17; a2 -= pa4[2] * x18; a3 -= pa4[3] * x19; a0 -= pa5[0] * x20; a1 -= pa5[1] * x21; a2 -= pa5[2] * x22; a3 -= pa5[3] * x23; a0 -= pa6[0] * x24; a1 -= pa6[1] * x25; a2 -= pa6[2] * x26; a3 -= pa6[3] * x27; a0 -= pa7[0] * x28; a1 -= pa7[1] * x29; a2 -= pa7[2] * x30; a3 -= pa7[3] * x31; a0 -= l0[0] * x32; a1 -= l0[1] * x33; a2 -= l0[2] * x34; a3 -= l0[3] * x35; a0 -= l1[0] * x36; a1 -= l1[1] * x37; a2 -= l1[2] * x38; a3 -= l1[3] * x39; a0 -= l2[0] * x40; a1 -= l2[1] * x41; a2 -= l2[2] * x42; a3 -= l2[3] * x43; x44 = (a0 + a1) + (a2 + a3); } INV_SB();
    l0 = INV_LD(45, 8); l1 = INV_LD(45, 9); l2 = INV_LD(45, 10); l3 = INV_LD(45, 11); pa0 = INV_LD(46, 0); pa1 = INV_LD(46, 1); pa2 = INV_LD(46, 2); pa3 = INV_LD(46, 3); pa4 = INV_LD(46, 4); pa5 = INV_LD(46, 5); pa6 = INV_LD(46, 6); pa7 = INV_LD(46, 7); INV_SB();
    { int li = lane; asm volatile("" : "+v"(li)); float a0 = (li == 45) ? 1.f : 0.f, a1 = 0.f, a2 = 0.f, a3 = 0.f; a0 -= pb0[0] * x0; a1 -= pb0[1] * x1; a2 -= pb0[2] * x2; a3 -= pb0[3] * x3; a0 -= pb1[0] * x4; a1 -= pb1[1] * x5; a2 -= pb1[2] * x6; a3 -= pb1[3] * x7; a0 -= pb2[0] * x8; a1 -= pb2[1] * x9; a2 -= pb2[2] * x10; a3 -= pb2[3] * x11; a0 -= pb3[0] * x12; a1 -= pb3[1] * x13; a2 -= pb3[2] * x14; a3 -= pb3[3] * x15; a0 -= pb4[0] * x16; a1 -= pb4[1] * x17; a2 -= pb4[2] * x18; a3 -= pb4[3] * x19; a0 -= pb5[0] * x20; a1 -= pb5[1] * x21; a2 -= pb5[2] * x22; a3 -= pb5[3] * x23; a0 -= pb6[0] * x24; a1 -= pb6[1] * x25; a2 -= pb6[2] * x26; a3 -= pb6[3] * x27; a0 -= pb7[0] * x28; a1 -= pb7[1] * x29; a2 -= pb7[2] * x30; a3 -= pb7[3] * x31; a0 -= l0[0] * x32; a1 -= l0[1] * x33; a2 -= l0[2] * x34; a3 -= l0[3] * x35; a0 -= l1[0] * x36; a1 -= l1[1] * x37; a2 -= l1[2] * x38; a3 -= l1[3] * x39; a0 -= l2[0] * x40; a1 -= l2[1] * x41; a2 -= l2[2] * x42; a3 -= l2[3] * x43; a0 -= l3[0] * x44; x45 = (a0 + a1) + (a2 + a3); } INV_SB();
    l0 = INV_LD(46, 8); l1 = INV_LD(46, 9); l2 = INV_LD(46, 10); l3 = INV_LD(46, 11); pb0 = INV_LD(47, 0); pb1 = INV_LD(47, 1); pb2 = INV_LD(47, 2); pb3 = INV_LD(47, 3); pb4 = INV_LD(47, 4); pb5 = INV_LD(47, 5); pb6 = INV_LD(47, 6); pb7 = INV_LD(47, 7); INV_SB();
    { int li = lane; asm volatile("" : "+v"(li)); float a0 = (li == 46) ? 1.f : 0.f, a1 = 0.f, a2 = 0.f, a3 = 0.f; a0 -= pa0[0] * x0; a1 -= pa0[1] * x1; a2 -= pa0[2] * x2; a3 -= pa0[3] * x3; a0 -= pa1[0] * x4; a1 -= pa1[1] * x5; a2 -= pa1[2] * x6; a3 -= pa1[3] * x7; a0 -= pa2[0] * x8; a1 -= pa2[1] * x9; a2 -= pa2[2] * x10; a3 -= pa2[3] * x11; a0 -= pa3[0] * x12; a1 -= pa3[1] * x13; a2 -= pa3[2] * x14; a3 -= pa3[3] * x15; a0 -= pa4[0] * x16; a1 -= pa4[1] * x17; a2 -= pa4[2] * x18; a3 -= pa4[3] * x19; a0 -= pa5[0] * x20; a1 -= pa5[1] * x21; a2 -= pa5[2] * x22; a3 -= pa5[3] * x23; a0 -= pa6[0] * x24; a1 -= pa6[1] * x25; a2 -= pa6[2] * x26; a3 -= pa6[3] * x27; a0 -= pa7[0] * x28; a1 -= pa7[1] * x29; a2 -= pa7[2] * x30; a3 -= pa7[3] * x31; a0 -= l0[0] * x32; a1 -= l0[1] * x33; a2 -= l0[2] * x34; a3 -= l0[3] * x35; a0 -= l1[0] * x36; a1 -= l1[1] * x37; a2 -= l1[2] * x38; a3 -= l1[3] * x39; a0 -= l2[0] * x40; a1 -= l2[1] * x41; a2 -= l2[2] * x42; a3 -= l2[3] * x43; a0 -= l3[0] * x44; a1 -= l3[1] * x45; x46 = (a0 + a1) + (a2 + a3); } INV_SB();
    l0 = INV_LD(47, 8); l1 = INV_LD(47, 9); l2 = INV_LD(47, 10); l3 = INV_LD(47, 11); pa0 = INV_LD(48, 0); pa1 = INV_LD(48, 1); pa2 = INV_LD(48, 2); pa3 = INV_LD(48, 3); pa4 = INV_LD(48, 4); pa5 = INV_LD(48, 5); pa6 = INV_LD(48, 6); pa7 = INV_LD(48, 7); INV_SB();
    { int li = lane; asm volatile("" : "+v"(li)); float a0 = (li == 47) ? 1.f : 0.f, a1 = 0.f, a2 = 0.f, a3 = 0.f; a0 -= pb0[0] * x0; a1 -= pb0[1] * x1; a2 -= pb0[2] * x2; a3 -= pb0[3] * x3; a0 -= pb1[0] * x4; a1 -= pb1[1] * x5; a2 -= pb1[2] * x6; a3 -= pb1[3] * x7; a0 -= pb2[0] * x8; a1 -= pb2[1] * x9; a2 -= pb2[2] * x10; a3 -= pb2[3] * x11; a0 -= pb3[0] * x12; a1 -= pb3[1] * x13; a2 -= pb3[2] * x14; a3 -= pb3[3] * x15; a0 -= pb4[0] * x16; a1 -= pb4[1] * x17; a2 -= pb4[2] * x18; a3 -= pb4[3] * x19; a0 -= pb5[0] * x20; a1 -= pb5[1] * x21; a2 -= pb5[2] * x22; a3 -= pb5[3] * x23; a0 -= pb6[0] * x24; a1 -= pb6[1] * x25; a2 -= pb6[2] * x26; a3 -= pb6[3] * x27; a0 -= pb7[0] * x28; a1 -= pb7[1] * x29; a2 -= pb7[2] * x30; a3 -= pb7[3] * x31; a0 -= l0[0] * x32; a1 -= l0[1] * x33; a2 -= l0[2] * x34; a3 -= l0[3] * x35; a0 -= l1[0] * x36; a1 -= l1[1] * x37; a2 -= l1[2] * x38; a3 -= l1[3] * x39; a0 -= l2[0] * x40; a1 -= l2[1] * x41; a2 -= l2[2] * x42; a3 -= l2[3] * x43; a0 -= l3[0] * x44; a1 -= l3[1] * x45; a2 -= l3[2] * x46; x47 = (a0 + a1) + (a2 + a3); } INV_SB();
    l0 = INV_LD(48, 8); l1 = INV_LD(48, 9); l2 = INV_LD(48, 10); l3 = INV_LD(48, 11); pb0 = INV_LD(49, 0); pb1 = INV_LD(49, 1); pb2 = INV_LD(49, 2); pb3 = INV_LD(49, 3); pb4 = INV_LD(49, 4); pb5 = INV_LD(49, 5); pb6 = INV_LD(49, 6); pb7 = INV_LD(49, 7); INV_SB();
    { int li = lane; asm volatile("" : "+v"(li)); float a0 = (li == 48) ? 1.f : 0.f, a1 = 0.f, a2 = 0.f, a3 = 0.f; a0 -= pa0[0] * x0; a1 -= pa0[1] * x1; a2 -= pa0[2] * x2; a3 -= pa0[3] * x3; a0 -= pa1[0] * x4; a1 -= pa1[1] * x5; a2 -= pa1[2] * x6; a3 -= pa1[3] * x7; a0 -= pa2[0] * x8; a1 -= pa2[1] * x9; a2 -= pa2[2] * x10; a3 -= pa2[3] * x11; a0 -= pa3[0] * x12; a1 -= pa3[1] * x13; a2 -= pa3[2] * x14; a3 -= pa3[3] * x15; a0 -= pa4[0] * x16; a1 -= pa4[1] * x17; a2 -= pa4[2] * x18; a3 -= pa4[3] * x19; a0 -= pa5[0] * x20; a1 -= pa5[1] * x21; a2 -= pa5[2] * x22; a3 -= pa5[3] * x23; a0 -= pa6[0] * x24; a1 -= pa6[1] * x25; a2 -= pa6[2] * x26; a3 -= pa6[3] * x27; a0 -= pa7[0] * x28; a1 -= pa7[1] * x29; a2 -= pa7[2] * x30; a3 -= pa7[3] * x31; a0 -= l0[0] * x32; a1 -= l0[1] * x33; a2 -= l0[2] * x34; a3 -= l0[3] * x35; a0 -= l1[0] * x36; a1 -= l1[1] * x37; a2 -= l1[2] * x38; a3 -= l1[3] * x39; a0 -= l2[0] * x40; a1 -= l2[1] * x41; a2 -= l2[2] * x42; a3 -= l2[3] * x43; a0 -= l3[0] * x44; a1 -= l3[1] * x45; a2 -= l3[2] * x46; a3 -= l3[3] * x47; x48 = (a0 + a1) + (a2 + a3); } INV_SB();
    l0 = INV_LD(49, 8); l1 = INV_LD(49, 9); l2 = INV_LD(49, 10); l3 = INV_LD(49, 11); l4 = INV_LD(49, 12); pa0 = INV_LD(50, 0); pa1 = INV_LD(50, 1); pa2 = INV_LD(50, 2); pa3 = INV_LD(50, 3); pa4 = INV_LD(50, 4); pa5 = INV_LD(50, 5); pa6 = INV_LD(50, 6); pa7 = INV_LD(50, 7); INV_SB();
    { int li = lane; asm volatile("" : "+v"(li)); float a0 = (li == 49) ? 1.f : 0.f, a1 = 0.f, a2 = 0.f, a3 = 0.f; a0 -= pb0[0] * x0; a1 -= pb0[1] * x1; a2 -= pb0[2] * x2; a3 -= pb0[3] * x3; a0 -= pb1[0] * x4; a1 -= pb1[1] * x5; a2 -= pb1[2] * x6; a3 -= pb1[3] * x7; a0 -= pb2[0] * x8; a1 -= pb2[1] * x9; a2 -= pb2[2] * x10; a3 -= pb2[3] * x11; a0 -= pb3[0] * x12; a1 -= pb3[1] * x13; a2 -= pb3[2] * x14; a3 -= pb3[3] * x15; a0 -= pb4[0] * x16; a1 -= pb4[1] * x17; a2 -= pb4[2] * x18; a3 -= pb4[3] * x19; a0 -= pb5[0] * x20; a1 -= pb5[1] * x21; a2 -= pb5[2] * x22; a3 -= pb5[3] * x23; a0 -= pb6[0] * x24; a1 -= pb6[1] * x25; a2 -= pb6[2] * x26; a3 -= pb6[3] * x27; a0 -= pb7[0] * x28; a1 -= pb7[1] * x29; a2 -= pb7[2] * x30; a3 -= pb7[3] * x31; a0 -= l0[0] * x32; a1 -= l0[1] * x33; a2 -= l0[2] * x34; a3 -= l0[3] * x35; a0 -= l1[0] * x36; a1 -= l1[1] * x37; a2 -= l1[2] * x38; a3 -= l1[3] * x39; a0 -= l2[0] * x40; a1 -= l2[1] * x41; a2 -= l2[2] * x42; a3 -= l2[3] * x43; a0 -= l3[0] * x44; a1 -= l3[1] * x45; a2 -= l3[2] * x46; a3 -= l3[3] * x47; a0 -= l4[0] * x48; x49 = (a0 + a1) + (a2 + a3); } INV_SB();
    l0 = INV_LD(50, 8); l1 = INV_LD(50, 9); l2 = INV_LD(50, 10); l3 = INV_LD(50, 11); l4 = INV_LD(50, 12); pb0 = INV_LD(51, 0); pb1 = INV_LD(51, 1); pb2 = INV_LD(51, 2); pb3 = INV_LD(51, 3); pb4 = INV_LD(51, 4); pb5 = INV_LD(51, 5); pb6 = INV_LD(51, 6); pb7 = INV_LD(51, 7); INV_SB();
    { int li = lane; asm volatile("" : "+v"(li)); float a0 = (li == 50) ? 1.f : 0.f, a1 = 0.f, a2 = 0.f, a3 = 0.f; a0 -= pa0[0] * x0; a1 -= pa0[1] * x1; a2 -= pa0[2] * x2; a3 -= pa0[3] * x3; a0 -= pa1[0] * x4; a1 -= pa1[1] * x5; a2 -= pa1[2] * x6; a3 -= pa1[3] * x7; a0 -= pa2[0] * x8; a1 -= pa2[1] * x9; a2 -= pa2[2] * x10; a3 -= pa2[3] * x11; a0 -= pa3[0] * x12; a1 -= pa3[1] * x13; a2 -= pa3[2] * x14; a3 -= pa3[3] * x15; a0 -= pa4[0] * x16; a1 -= pa4[1] * x17; a2 -= pa4[2] * x18; a3 -= pa4[3] * x19; a0 -= pa5[0] * x20; a1 -= pa5[1] * x21; a2 -= pa5[2] * x22; a3 -= pa5[3] * x23; a0 -= pa6[0] * x24; a1 -= pa6[1] * x25; a2 -= pa6[2] * x26; a3 -= pa6[3] * x27; a0 -= pa7[0] * x28; a1 -= pa7[1] * x29; a2 -= pa7[2] * x30; a3 -= pa7[3] * x31; a0 -= l0[0] * x32; a1 -= l0[1] * x33; a2 -= l0[2] * x34; a3 -= l0[3] * x35; a0 -= l1[0] * x36; a1 -= l1[1] * x37; a2 -= l1[2] * x38; a3 -= l1[3] * x39; a0 -= l2[0] * x40; a1 -= l2[1] * x41; a2 -= l2[2] * x42; a3 -= l2[3] * x43; a0 -= l3[0] * x44; a1 -= l3[1] * x45; a2 -= l3[2] * x46; a3 -= l3[3] * x47; a0 -= l4[0] * x48; a1 -= l4[1] * x49; x50 = (a0 + a1) + (a2 + a3); } INV_SB();
    l0 = INV_LD(51, 8); l1 = INV_LD(51, 9); l2 = INV_LD(51, 10); l3 = INV_LD(51, 11); l4 = INV_LD(51, 12); pa0 = INV_LD(52, 0); pa1 = INV_LD(52, 1); pa2 = INV_LD(52, 2); pa3 = INV_LD(52, 3); pa4 = INV_LD(52, 4); pa5 = INV_LD(52, 5); pa6 = INV_LD(52, 6); pa7 = INV_LD(52, 7); INV_SB();
    { int li = lane; asm volatile("" : "+v"(li)); float a0 = (li == 51) ? 1.f : 0.f, a1 = 0.f, a2 = 0.f, a3 = 0.f; a0 -= pb0[0] * x0; a1 -= pb0[1] * x1; a2 -= pb0[2] * x2; a3 -= pb0[3] * x3; a0 -= pb1[0] * x4; a1 -= pb1[1] * x5; a2 -= pb1[2] * x6; a3 -= pb1[3] * x7; a0 -= pb2[0] * x8; a1 -= pb2[1] * x9; a2 -= pb2[2] * x10; a3 -= pb2[3] * x11; a0 -= pb3[0] * x12; a1 -= pb3[1] * x13; a2 -= pb3[2] * x14; a3 -= pb3[3] * x15; a0 -= pb4[0] * x16; a1 -= pb4[1] * x17; a2 -= pb4[2] * x18; a3 -= pb4[3] * x19; a0 -= pb5[0] * x20; a1 -= pb5[1] * x21; a2 -= pb5[2] * x22; a3 -= pb5[3] * x23; a0 -= pb6[0] * x24; a1 -= pb6[1] * x25; a2 -= pb6[2] * x26; a3 -= pb6[3] * x27; a0 -= pb7[0] * x28; a1 -= pb7[1] * x29; a2 -= pb7[2] * x30; a3 -= pb7[3] * x31; a0 -= l0[0] * x32; a1 -= l0[1] * x33; a2 -= l0[2] * x34; a3 -= l0[3] * x35; a0 -= l1[0] * x36; a1 -= l1[1] * x37; a2 -= l1[2] * x38; a3 -= l1[3] * x39; a0 -= l2[0] * x40; a1 -= l2[1] * x41; a2 -= l2[2] * x42; a3 -= l2[3] * x43; a0 -= l3[0] * x44; a1 -= l3[1] * x45; a2 -= l3[2] * x46; a3 -= l3[3] * x47; a0 -= l4[0] * x48; a1 -= l4[1] * x49; a2 -= l4[2] * x50; x51 = (a0 + a1) + (a2 + a3); } INV_SB();
    l0 = INV_LD(52, 8); l1 = INV_LD(52, 9); l2 = INV_LD(52, 10); l3 = INV_LD(52, 11); l4 = INV_LD(52, 12); pb0 = INV_LD(53, 0); pb1 = INV_LD(53, 1); pb2 = INV_LD(53, 2); pb3 = INV_LD(53, 3); pb4 = INV_LD(53, 4); pb5 = INV_LD(53, 5); pb6 = INV_LD(53, 6); pb7 = INV_LD(53, 7); INV_SB();
    { int li = lane; asm volatile("" : "+v"(li)); float a0 = (li == 52) ? 1.f : 0.f, a1 = 0.f, a2 = 0.f, a3 = 0.f; a0 -= pa0[0] * x0; a1 -= pa0[1] * x1; a2 -= pa0[2] * x2; a3 -= pa0[3] * x3; a0 -= pa1[0] * x4; a1 -= pa1[1] * x5; a2 -= pa1[2] * x6; a3 -= pa1[3] * x7; a0 -= pa2[0] * x8; a1 -= pa2[1] * x9; a2 -= pa2[2] * x10; a3 -= pa2[3] * x11; a0 -= pa3[0] * x12; a1 -= pa3[1] * x13; a2 -= pa3[2] * x14; a3 -= pa3[3] * x15; a0 -= pa4[0] * x16; a1 -= pa4[1] * x17; a2 -= pa4[2] * x18; a3 -= pa4[3] * x19; a0 -= pa5[0] * x20; a1 -= pa5[1] * x21; a2 -= pa5[2] * x22; a3 -= pa5[3] * x23; a0 -= pa6[0] * x24; a1 -= pa6[1] * x25; a2 -= pa6[2] * x26; a3 -= pa6[3] * x27; a0 -= pa7[0] * x28; a1 -= pa7[1] * x29; a2 -= pa7[2] * x30; a3 -= pa7[3] * x31; a0 -= l0[0] * x32; a1 -= l0[1] * x33; a2 -= l0[2] * x34; a3 -= l0[3] * x35; a0 -= l1[0] * x36; a1 -= l1[1] * x37; a2 -= l1[2] * x38; a3 -= l1[3] * x39; a0 -= l2[0] * x40; a1 -= l2[1] * x41; a2 -= l2[2] * x42; a3 -= l2[3] * x43; a0 -= l3[0] * x44; a1 -= l3[1] * x45; a2 -= l3[2] * x46; a3 -= l3[3] * x47; a0 -= l4[0] * x48; a1 -= l4[1] * x49; a2 -= l4[2] * x50; a3 -= l4[3] * x51; x52 = (a0 + a1) + (a2 + a3); } INV_SB();
    l0 = INV_LD(53, 8); l1 = INV_LD(53, 9); l2 = INV_LD(53, 10); l3 = INV_LD(53, 11); l4 = INV_LD(53, 12); l5 = INV_LD(53, 13); pa0 = INV_LD(54, 0); pa1 = INV_LD(54, 1); pa2 = INV_LD(54, 2); pa3 = INV_LD(54, 3); pa4 = INV_LD(54, 4); pa5 = INV_LD(54, 5); pa6 = INV_LD(54, 6); pa7 = INV_LD(54, 7); INV_SB();
    { int li = lane; asm volatile("" : "+v"(li)); float a0 = (li == 53) ? 1.f : 0.f, a1 = 0.f, a2 = 0.f, a3 = 0.f; a0 -= pb0[0] * x0; a1 -= pb0[1] * x1; a2 -= pb0[2] * x2; a3 -= pb0[3] * x3; a0 -= pb1[0] * x4; a1 -= pb1[1] * x5; a2 -= pb1[2] * x6; a3 -= pb1[3] * x7; a0 -= pb2[0] * x8; a1 -= pb2[1] * x9; a2 -= pb2[2] * x10; a3 -= pb2[3] * x11; a0 -= pb3[0] * x12; a1 -= pb3[1] * x13; a2 -= pb3[2] * x14; a3 -= pb3[3] * x15; a0 -= pb4[0] * x16; a1 -= pb4[1] * x17; a2 -= pb4[2] * x18; a3 -= pb4[3] * x19; a0 -= pb5[0] * x20; a1 -= pb5[1] * x21; a2 -= pb5[2] * x22; a3 -= pb5[3] * x23; a0 -= pb6[0] * x24; a1 -= pb6[1] * x25; a2 -= pb6[2] * x26; a3 -= pb6[3] * x27; a0 -= pb7[0] * x28; a1 -= pb7[1] * x29; a2 -= pb7[2] * x30; a3 -= pb7[3] * x31; a0 -= l0[0] * x32; a1 -= l0[1] * x33; a2 -= l0[2] * x34; a3 -= l0[3] * x35; a0 -= l1[0] * x36; a1 -= l1[1] * x37; a2 -= l1[2] * x38; a3 -= l1[3] * x39; a0 -= l2[0] * x40; a1 -= l2[1] * x41; a2 -= l2[2] * x42; a3 -= l2[3] * x43; a0 -= l3[0] * x44; a1 -= l3[1] * x45; a2 -= l3[2] * x46; a3 -= l3[3] * x47; a0 -= l4[0] * x48; a1 -= l4[1] * x49; a2 -= l4[2] * x50; a3 -= l4[3] * x51; a0 -= l5[0] * x52; x53 = (a0 + a1) + (a2 + a3); } INV_SB();
    l0 = INV_LD(54, 8); l1 = INV_LD(54, 9); l2 = INV_LD(54, 10); l3 = INV_LD(54, 11); l4 = INV_LD(54, 12); l5 = INV_LD(54, 13); pb0 = INV_LD(55, 0); pb1 = INV_LD(55, 1); pb2 = INV_LD(55, 2); pb3 = INV_LD(55, 3); pb4 = INV_LD(55, 4); pb5 = INV_LD(55, 5); pb6 = INV_LD(55, 6); pb7 = INV_LD(55, 7); INV_SB();
    { int li = lane; asm volatile("" : "+v"(li)); float a0 = (li == 54) ? 1.f : 0.f, a1 = 0.f, a2 = 0.f, a3 = 0.f; a0 -= pa0[0] * x0; a1 -= pa0[1] * x1; a2 -= pa0[2] * x2; a3 -= pa0[3] * x3; a0 -= pa1[0] * x4; a1 -= pa1[1] * x5; a2 -= pa1[2] * x6; a3 -= pa1[3] * x7; a0 -= pa2[0] * x8; a1 -= pa2[1] * x9; a2 -= pa2[2] * x10; a3 -= pa2[3] * x11; a0 -= pa3[0] * x12; a1 -= pa3[1] * x13; a2 -= pa3[2] * x14; a3 -= pa3[3] * x15; a0 -= pa4[0] * x16; a1 -= pa4[1] * x17; a2 -= pa4[2] * x18; a3 -= pa4[3] * x19; a0 -= pa5[0] * x20; a1 -= pa5[1] * x21; a2 -= pa5[2] * x22; a3 -= pa5[3] * x23; a0 -= pa6[0] * x24; a1 -= pa6[1] * x25; a2 -= pa6[2] * x26; a3 -= pa6[3] * x27; a0 -= pa7[0] * x28; a1 -= pa7[1] * x29; a2 -= pa7[2] * x30; a3 -= pa7[3] * x31; a0 -= l0[0] * x32; a1 -= l0[1] * x33; a2 -= l0[2] * x34; a3 -= l0[3] * x35; a0 -= l1[0] * x36; a1 -= l1[1] * x37; a2 -= l1[2] * x38; a3 -= l1[3] * x39; a0 -= l2[0] * x40; a1 -= l2[1] * x41; a2 -= l2[2] * x42; a3 -= l2[3] * x43; a0 -= l3[0] * x44; a1 -= l3[1] * x45; a2 -= l3[2] * x46; a3 -= l3[3] * x47; a0 -= l4[0] * x48; a1 -= l4[1] * x49; a2 -= l4[2] * x50; a3 -= l4[3] * x51; a0 -= l5[0] * x52; a1 -= l5[1] * x53; x54 = (a0 + a1) + (a2 + a3); } INV_SB();
    l0 = INV_LD(55, 8); l1 = INV_LD(55, 9); l2 = INV_LD(55, 10); l3 = INV_LD(55, 11); l4 = INV_LD(55, 12); l5 = INV_LD(55, 13); pa0 = INV_LD(56, 0); pa1 = INV_LD(56, 1); pa2 = INV_LD(56, 2); pa3 = INV_LD(56, 3); pa4 = INV_LD(56, 4); pa5 = INV_LD(56, 5); pa6 = INV_LD(56, 6); pa7 = INV_LD(56, 7); INV_SB();
    { int li = lane; asm volatile("" : "+v"(li)); float a0 = (li == 55) ? 1.f : 0.f, a1 = 0.f, a2 = 0.f, a3 = 0.f; a0 -= pb0[0] * x0; a1 -= pb0[1] * x1; a2 -= pb0[2] * x2; a3 -= pb0[3] * x3; a0 -= pb1[0] * x4; a1 -= pb1[1] * x5; a2 -= pb1[2] * x6; a3 -= pb1[3] * x7; a0 -= pb2[0] * x8; a1 -= pb2[1] * x9; a2 -= pb2[2] * x10; a3 -= pb2[3] * x11; a0 -= pb3[0] * x12; a1 -= pb3[1] * x13; a2 -= pb3[2] * x14; a3 -= pb3[3] * x15; a0 -= pb4[0] * x16; a1 -= pb4[1] * x17; a2 -= pb4[2] * x18; a3 -= pb4[3] * x19; a0 -= pb5[0] * x20; a1 -= pb5[1] * x21; a2 -= pb5[2] * x22; a3 -= pb5[3] * x23; a0 -= pb6[0] * x24; a1 -= pb6[1] * x25; a2 -= pb6[2] * x26; a3 -= pb6[3] * x27; a0 -= pb7[0] * x28; a1 -= pb7[1] * x29; a2 -= pb7[2] * x30; a3 -= pb7[3] * x31; a0 -= l0[0] * x32; a1 -= l0[1] * x33; a2 -= l0[2] * x34; a3 -= l0[3] * x35; a0 -= l1[0] * x36; a1 -= l1[1] * x37; a2 -= l1[2] * x38; a3 -= l1[3] * x39; a0 -= l2[0] * x40; a1 -= l2[1] * x41; a2 -= l2[2] * x42; a3 -= l2[3] * x43; a0 -= l3[0] * x44; a1 -= l3[1] * x45; a2 -= l3[2] * x46; a3 -= l3[3] * x47; a0 -= l4[0] * x48; a1 -= l4[1] * x49; a2 -= l4[2] * x50; a3 -= l4[3] * x51; a0 -= l5[0] * x52; a1 -= l5[1] * x53; a2 -= l5[2] * x54; x55 = (a0 + a1) + (a2 + a3); } INV_SB();
    l0 = INV_LD(56, 8); l1 = INV_LD(56, 9); l2 = INV_LD(56, 10); l3 = INV_LD(56, 11); l4 = INV_LD(56, 12); l5 = INV_LD(56, 13); pb0 = INV_LD(57, 0); pb1 = INV_LD(57, 1); pb2 = INV_LD(57, 2); pb3 = INV_LD(57, 3); pb4 = INV_LD(57, 4); pb5 = INV_LD(57, 5); pb6 = INV_LD(57, 6); pb7 = INV_LD(57, 7); INV_SB();
    { int li = lane; asm volatile("" : "+v"(li)); float a0 = (li == 56) ? 1.f : 0.f, a1 = 0.f, a2 = 0.f, a3 = 0.f; a0 -= pa0[0] * x0; a1 -= pa0[1] * x1; a2 -= pa0[2] * x2; a3 -= pa0[3] * x3; a0 -= pa1[0] * x4; a1 -= pa1[1] * x5; a2 -= pa1[2] * x6; a3 -= pa1[3] * x7; a0 -= pa2[0] * x8; a1 -= pa2[1] * x9; a2 -= pa2[2] * x10; a3 -= pa2[3] * x11; a0 -= pa3[0] * x12; a1 -= pa3[1] * x13; a2 -= pa3[2] * x14; a3 -= pa3[3] * x15; a0 -= pa4[0] * x16; a1 -= pa4[1] * x17; a2 -= pa4[2] * x18; a3 -= pa4[3] * x19; a0 -= pa5[0] * x20; a1 -= pa5[1] * x21; a2 -= pa5[2] * x22; a3 -= pa5[3] * x23; a0 -= pa6[0] * x24; a1 -= pa6[1] * x25; a2 -= pa6[2] * x26; a3 -= pa6[3] * x27; a0 -= pa7[0] * x28; a1 -= pa7[1] * x29; a2 -= pa7[2] * x30; a3 -= pa7[3] * x31; a0 -= l0[0] * x32; a1 -= l0[1] * x33; a2 -= l0[2] * x34; a3 -= l0[3] * x35; a0 -= l1[0] * x36; a1 -= l1[1] * x37; a2 -= l1[2] * x38; a3 -= l1[3] * x39; a0 -= l2[0] * x40; a1 -= l2[1] * x41; a2 -= l2[2] * x42; a3 -= l2[3] * x43; a0 -= l3[0] * x44; a1 -= l3[1] * x45; a2 -= l3[2] * x46; a3 -= l3[3] * x47; a0 -= l4[0] * x48; a1 -= l4[1] * x49; a2 -= l4[2] * x50; a3 -= l4[3] * x51; a0 -= l5[0] * x52; a1 -= l5[1] * x53; a2 -= l5[2] * x54; a3 -= l5[3] * x55; x56 = (a0 + a1) + (a2 + a3); } INV_SB();
    l0 = INV_LD(57, 8); l1 = INV_LD(57, 9); l2 = INV_LD(57, 10); l3 = INV_LD(57, 11); l4 = INV_LD(57, 12); l5 = INV_LD(57, 13); l6 = INV_LD(57, 14); pa0 = INV_LD(58, 0); pa1 = INV_LD(58, 1); pa2 = INV_LD(58, 2); pa3 = INV_LD(58, 3); pa4 = INV_LD(58, 4); pa5 = INV_LD(58, 5); pa6 = INV_LD(58, 6); pa7 = INV_LD(58, 7); INV_SB();
    { int li = lane; asm volatile("" : "+v"(li)); float a0 = (li == 57) ? 1.f : 0.f, a1 = 0.f, a2 = 0.f, a3 = 0.f; a0 -= pb0[0] * x0; a1 -= pb0[1] * x1; a2 -= pb0[2] * x2; a3 -= pb0[3] * x3; a0 -= pb1[0] * x4; a1 -= pb1[1] * x5; a2 -= pb1[2] * x6; a3 -= pb1[3] * x7; a0 -= pb2[0] * x8; a1 -= pb2[1] * x9; a2 -= pb2[2] * x10; a3 -= pb2[3] * x11; a0 -= pb3[0] * x12; a1 -= pb3[1] * x13; a2 -= pb3[2] * x14; a3 -= pb3[3] * x15; a0 -= pb4[0] * x16; a1 -= pb4[1] * x17; a2 -= pb4[2] * x18; a3 -= pb4[3] * x19; a0 -= pb5[0] * x20; a1 -= pb5[1] * x21; a2 -= pb5[2] * x22; a3 -= pb5[3] * x23; a0 -= pb6[0] * x24; a1 -= pb6[1] * x25; a2 -= pb6[2] * x26; a3 -= pb6[3] * x27; a0 -= pb7[0] * x28; a1 -= pb7[1] * x29; a2 -= pb7[2] * x30; a3 -= pb7[3] * x31; a0 -= l0[0] * x32; a1 -= l0[1] * x33; a2 -= l0[2] * x34; a3 -= l0[3] * x35; a0 -= l1[0] * x36; a1 -= l1[1] * x37; a2 -= l1[2] * x38; a3 -= l1[3] * x39; a0 -= l2[0] * x40; a1 -= l2[1] * x41; a2 -= l2[2] * x42; a3 -= l2[3] * x43; a0 -= l3[0] * x44; a1 -= l3[1] * x45; a2 -= l3[2] * x46; a3 -= l3[3] * x47; a0 -= l4[0] * x48; a1 -= l4[1] * x49; a2 -= l4[2] * x50; a3 -= l4[3] * x51; a0 -= l5[0] * x52; a1 -= l5[1] * x53; a2 -= l5[2] * x54; a3 -= l5[3] * x55; a0 -= l6[0] * x56; x57 = (a0 + a1) + (a2 + a3); } INV_SB();
    l0 = INV_LD(58, 8); l1 = INV_LD(58, 9); l2 = INV_LD(58, 10); l3 = INV_LD(58, 11); l4 = INV_LD(58, 12); l5 = INV_LD(58, 13); l6 = INV_LD(58, 14); pb0 = INV_LD(59, 0); pb1 = INV_LD(59, 1); pb2 = INV_LD(59, 2); pb3 = INV_LD(59, 3); pb4 = INV_LD(59, 4); pb5 = INV_LD(59, 5); pb6 = INV_LD(59, 6); pb7 = INV_LD(59, 7); INV_SB();
    { int li = lane; asm volatile("" : "+v"(li)); float a0 = (li == 58) ? 1.f : 0.f, a1 = 0.f, a2 = 0.f, a3 = 0.f; a0 -= pa0[0] * x0; a1 -= pa0[1] * x1; a2 -= pa0[2] * x2; a3 -= pa0[3] * x3; a0 -= pa1[0] * x4; a1 -= pa1[1] * x5; a2 -= pa1[2] * x6; a3 -= pa1[3] * x7; a0 -= pa2[0] * x8; a1 -= pa2[1] * x9; a2 -= pa2[2] * x10; a3 -= pa2[3] * x11; a0 -= pa3[0] * x12; a1 -= pa3[1] * x13; a2 -= pa3[2] * x14; a3 -= pa3[3] * x15; a0 -= pa4[0] * x16; a1 -= pa4[1] * x17; a2 -= pa4[2] * x18; a3 -= pa4[3] * x19; a0 -= pa5[0] * x20; a1 -= pa5[1] * x21; a2 -= pa5[2] * x22; a3 -= pa5[3] * x23; a0 -= pa6[0] * x24; a1 -= pa6[1] * x25; a2 -= pa6[2] * x26; a3 -= pa6[3] * x27; a0 -= pa7[0] * x28; a1 -= pa7[1] * x29; a2 -= pa7[2] * x30; a3 -= pa7[3] * x31; a0 -= l0[0] * x32; a1 -= l0[1] * x33; a2 -= l0[2] * x34; a3 -= l0[3] * x35; a0 -= l1[0] * x36; a1 -= l1[1] * x37; a2 -= l1[2] * x38; a3 -= l1[3] * x39; a0 -= l2[0] * x40; a1 -= l2[1] * x41; a2 -= l2[2] * x42; a3 -= l2[3] * x43; a0 -= l3[0] * x44; a1 -= l3[1] * x45; a2 -= l3[2] * x46; a3 -= l3[3] * x47; a0 -= l4[0] * x48; a1 -= l4[1] * x49; a2 -= l4[2] * x50; a3 -= l4[3] * x51; a0 -= l5[0] * x52; a1 -= l5[1] * x53; a2 -= l5[2] * x54; a3 -= l5[3] * x55; a0 -= l6[0] * x56; a1 -= l6[1] * x57; x58 = (a0 + a1) + (a2 + a3); } INV_SB();
    l0 = INV_LD(59, 8); l1 = INV_LD(59, 9); l2 = INV_LD(59, 10); l3 = INV_LD(59, 11); l4 = INV_LD(59, 12); l5 = INV_LD(59, 13); l6 = INV_LD(59, 14); pa0 = INV_LD(60, 0); pa1 = INV_LD(60, 1); pa2 = INV_LD(60, 2); pa3 = INV_LD(60, 3); pa4 = INV_LD(60, 4); pa5 = INV_LD(60, 5); pa6 = INV_LD(60, 6); pa7 = INV_LD(60, 7); INV_SB();
    { int li = lane; asm volatile("" : "+v"(li)); float a0 = (li == 59) ? 1.f : 0.f, a1 = 0.f, a2 = 0.f, a3 = 0.f; a0 -= pb0[0] * x0; a1 -= pb0[1] * x1; a2 -= pb0[2] * x2; a3 -= pb0[3] * x3; a0 -= pb1[0] * x4; a1 -= pb1[1] * x5; a2 -= pb1[2] * x6; a3 -= pb1[3] * x7; a0 -= pb2[0] * x8; a1 -= pb2[1] * x9; a2 -= pb2[2] * x10; a3 -= pb2[3] * x11; a0 -= pb3[0] * x12; a1 -= pb3[1] * x13; a2 -= pb3[2] * x14; a3 -= pb3[3] * x15; a0 -= pb4[0] * x16; a1 -= pb4[1] * x17; a2 -= pb4[2] * x18; a3 -= pb4[3] * x19; a0 -= pb5[0] * x20; a1 -= pb5[1] * x21; a2 -= pb5[2] * x22; a3 -= pb5[3] * x23; a0 -= pb6[0] * x24; a1 -= pb6[1] * x25; a2 -= pb6[2] * x26; a3 -= pb6[3] * x27; a0 -= pb7[0] * x28; a1 -= pb7[1] * x29; a2 -= pb7[2] * x30; a3 -= pb7[3] * x31; a0 -= l0[0] * x32; a1 -= l0[1] * x33; a2 -= l0[2] * x34; a3 -= l0[3] * x35; a0 -= l1[0] * x36; a1 -= l1[1] * x37; a2 -= l1[2] * x38; a3 -= l1[3] * x39; a0 -= l2[0] * x40; a1 -= l2[1] * x41; a2 -= l2[2] * x42; a3 -= l2[3] * x43; a0 -= l3[0] * x44; a1 -= l3[1] * x45; a2 -= l3[2] * x46; a3 -= l3[3] * x47; a0 -= l4[0] * x48; a1 -= l4[1] * x49; a2 -= l4[2] * x50; a3 -= l4[3] * x51; a0 -= l5[0] * x52; a1 -= l5[1] * x53; a2 -= l5[2] * x54; a3 -= l5[3] * x55; a0 -= l6[0] * x56; a1 -= l6[1] * x57; a2 -= l6[2] * x58; x59 = (a0 + a1) + (a2 + a3); } INV_SB();
    l0 = INV_LD(60, 8); l1 = INV_LD(60, 9); l2 = INV_LD(60, 10); l3 = INV_LD(60, 11); l4 = INV_LD(60, 12); l5 = INV_LD(60, 13); l6 = INV_LD(60, 14); pb0 = INV_LD(61, 0); pb1 = INV_LD(61, 1); pb2 = INV_LD(61, 2); pb3 = INV_LD(61, 3); pb4 = INV_LD(61, 4); pb5 = INV_LD(61, 5); pb6 = INV_LD(61, 6); pb7 = INV_LD(61, 7); INV_SB();
    { int li = lane; asm volatile("" : "+v"(li)); float a0 = (li == 60) ? 1.f : 0.f, a1 = 0.f, a2 = 0.f, a3 = 0.f; a0 -= pa0[0] * x0; a1 -= pa0[1] * x1; a2 -= pa0[2] * x2; a3 -= pa0[3] * x3; a0 -= pa1[0] * x4; a1 -= pa1[1] * x5; a2 -= pa1[2] * x6; a3 -= pa1[3] * x7; a0 -= pa2[0] * x8; a1 -= pa2[1] * x9; a2 -= pa2[2] * x10; a3 -= pa2[3] * x11; a0 -= pa3[0] * x12; a1 -= pa3[1] * x13; a2 -= pa3[2] * x14; a3 -= pa3[3] * x15; a0 -= pa4[0] * x16; a1 -= pa4[1] * x17; a2 -= pa4[2] * x18; a3 -= pa4[3] * x19; a0 -= pa5[0] * x20; a1 -= pa5[1] * x21; a2 -= pa5[2] * x22; a3 -= pa5[3] * x23; a0 -= pa6[0] * x24; a1 -= pa6[1] * x25; a2 -= pa6[2] * x26; a3 -= pa6[3] * x27; a0 -= pa7[0] * x28; a1 -= pa7[1] * x29; a2 -= pa7[2] * x30; a3 -= pa7[3] * x31; a0 -= l0[0] * x32; a1 -= l0[1] * x33; a2 -= l0[2] * x34; a3 -= l0[3] * x35; a0 -= l1[0] * x36; a1 -= l1[1] * x37; a2 -= l1[2] * x38; a3 -= l1[3] * x39; a0 -= l2[0] * x40; a1 -= l2[1] * x41; a2 -= l2[2] * x42; a3 -= l2[3] * x43; a0 -= l3[0] * x44; a1 -= l3[1] * x45; a2 -= l3[2] * x46; a3 -= l3[3] * x47; a0 -= l4[0] * x48; a1 -= l4[1] * x49; a2 -= l4[2] * x50; a3 -= l4[3] * x51; a0 -= l5[0] * x52; a1 -= l5[1] * x53; a2 -= l5[2] * x54; a3 -= l5[3] * x55; a0 -= l6[0] * x56; a1 -= l6[1] * x57; a2 -= l6[2] * x58; a3 -= l6[3] * x59; x60 = (a0 + a1) + (a2 + a3); } INV_SB();
    l0 = INV_LD(61, 8); l1 = INV_LD(61, 9); l2 = INV_LD(61, 10); l3 = INV_LD(61, 11); l4 = INV_LD(61, 12); l5 = INV_LD(61, 13); l6 = INV_LD(61, 14); l7 = INV_LD(61, 15); pa0 = INV_LD(62, 0); pa1 = INV_LD(62, 1); pa2 = INV_LD(62, 2); pa3 = INV_LD(62, 3); pa4 = INV_LD(62, 4); pa5 = INV_LD(62, 5); pa6 = INV_LD(62, 6); pa7 = INV_LD(62, 7); INV_SB();
    { int li = lane; asm volatile("" : "+v"(li)); float a0 = (li == 61) ? 1.f : 0.f, a1 = 0.f, a2 = 0.f, a3 = 0.f; a0 -= pb0[0] * x0; a1 -= pb0[1] * x1; a2 -= pb0[2] * x2; a3 -= pb0[3] * x3; a0 -= pb1[0] * x4; a1 -= pb1[1] * x5; a2 -= pb1[2] * x6; a3 -= pb1[3] * x7; a0 -= pb2[0] * x8; a1 -= pb2[1] * x9; a2 -= pb2[2] * x10; a3 -= pb2[3] * x11; a0 -= pb3[0] * x12; a1 -= pb3[1] * x13; a2 -= pb3[2] * x14; a3 -= pb3[3] * x15; a0 -= pb4[0] * x16; a1 -= pb4[1] * x17; a2 -= pb4[2] * x18; a3 -= pb4[3] * x19; a0 -= pb5[0] * x20; a1 -= pb5[1] * x21; a2 -= pb5[2] * x22; a3 -= pb5[3] * x23; a0 -= pb6[0] * x24; a1 -= pb6[1] * x25; a2 -= pb6[2] * x26; a3 -= pb6[3] * x27; a0 -= pb7[0] * x28; a1 -= pb7[1] * x29; a2 -= pb7[2] * x30; a3 -= pb7[3] * x31; a0 -= l0[0] * x32; a1 -= l0[1] * x33; a2 -= l0[2] * x34; a3 -= l0[3] * x35; a0 -= l1[0] * x36; a1 -= l1[1] * x37; a2 -= l1[2] * x38; a3 -= l1[3] * x39; a0 -= l2[0] * x40; a1 -= l2[1] * x41; a2 -= l2[2] * x42; a3 -= l2[3] * x43; a0 -= l3[0] * x44; a1 -= l3[1] * x45; a2 -= l3[2] * x46; a3 -= l3[3] * x47; a0 -= l4[0] * x48; a1 -= l4[1] * x49; a2 -= l4[2] * x50; a3 -= l4[3] * x51; a0 -= l5[0] * x52; a1 -= l5[1] * x53; a2 -= l5[2] * x54; a3 -= l5[3] * x55; a0 -= l6[0] * x56; a1 -= l6[1] * x57; a2 -= l6[2] * x58; a3 -= l6[3] * x59; a0 -= l7[0] * x60; x61 = (a0 + a1) + (a2 + a3); } INV_SB();
    l0 = INV_LD(62, 8); l1 = INV_LD(62, 9); l2 = INV_LD(62, 10); l3 = INV_LD(62, 11); l4 = INV_LD(62, 12); l5 = INV_LD(62, 13); l6 = INV_LD(62, 14); l7 = INV_LD(62, 15); pb0 = INV_LD(63, 0); pb1 = INV_LD(63, 1); pb2 = INV_LD(63, 2); pb3 = INV_LD(63, 3); pb4 = INV_LD(63, 4); pb5 = INV_LD(63, 5); pb6 = INV_LD(63, 6); pb7 = INV_LD(63, 7); INV_SB();
    { int li = lane; asm volatile("" : "+v"(li)); float a0 = (li == 62) ? 1.f : 0.f, a1 = 0.f, a2 = 0.f, a3 = 0.f; a0 -= pa0[0] * x0; a1 -= pa0[1] * x1; a2 -= pa0[2] * x2; a3 -= pa0[3] * x3; a0 -= pa1[0] * x4; a1 -= pa1[1] * x5; a2 -= pa1[2] * x6; a3 -= pa1[3] * x7; a0 -= pa2[0] * x8; a1 -= pa2[1] * x9; a2 -= pa2[2] * x10; a3 -= pa2[3] * x11; a0 -= pa3[0] * x12; a1 -= pa3[1] * x13; a2 -= pa3[2] * x14; a3 -= pa3[3] * x15; a0 -= pa4[0] * x16; a1 -= pa4[1] * x17; a2 -= pa4[2] * x18; a3 -= pa4[3] * x19; a0 -= pa5[0] * x20; a1 -= pa5[1] * x21; a2 -= pa5[2] * x22; a3 -= pa5[3] * x23; a0 -= pa6[0] * x24; a1 -= pa6[1] * x25; a2 -= pa6[2] * x26; a3 -= pa6[3] * x27; a0 -= pa7[0] * x28; a1 -= pa7[1] * x29; a2 -= pa7[2] * x30; a3 -= pa7[3] * x31; a0 -= l0[0] * x32; a1 -= l0[1] * x33; a2 -= l0[2] * x34; a3 -= l0[3] * x35; a0 -= l1[0] * x36; a1 -= l1[1] * x37; a2 -= l1[2] * x38; a3 -= l1[3] * x39; a0 -= l2[0] * x40; a1 -= l2[1] * x41; a2 -= l2[2] * x42; a3 -= l2[3] * x43; a0 -= l3[0] * x44; a1 -= l3[1] * x45; a2 -= l3[2] * x46; a3 -= l3[3] * x47; a0 -= l4[0] * x48; a1 -= l4[1] * x49; a2 -= l4[2] * x50; a3 -= l4[3] * x51; a0 -= l5[0] * x52; a1 -= l5[1] * x53; a2 -= l5[2] * x54; a3 -= l5[3] * x55; a0 -= l6[0] * x56; a1 -= l6[1] * x57; a2 -= l6[2] * x58; a3 -= l6[3] * x59; a0 -= l7[0] * x60; a1 -= l7[1] * x61; x62 = (a0 + a1) + (a2 + a3); } INV_SB();
    l0 = INV_LD(63, 8); l1 = INV_LD(63, 9); l2 = INV_LD(63, 10); l3 = INV_LD(63, 11); l4 = INV_LD(63, 12); l5 = INV_LD(63, 13); l6 = INV_LD(63, 14); l7 = INV_LD(63, 15); INV_SB();
    { int li = lane; asm volatile("" : "+v"(li)); float a0 = (li == 63) ? 1.f : 0.f, a1 = 0.f, a2 = 0.f, a3 = 0.f; a0 -= pb0[0] * x0; a1 -= pb0[1] * x1; a2 -= pb0[2] * x2; a3 -= pb0[3] * x3; a0 -= pb1[0] * x4; a1 -= pb1[1] * x5; a2 -= pb1[2] * x6; a3 -= pb1[3] * x7; a0 -= pb2[0] * x8; a1 -= pb2[1] * x9; a2 -= pb2[2] * x10; a3 -= pb2[3] * x11; a0 -= pb3[0] * x12; a1 -= pb3[1] * x13; a2 -= pb3[2] * x14; a3 -= pb3[3] * x15; a0 -= pb4[0] * x16; a1 -= pb4[1] * x17; a2 -= pb4[2] * x18; a3 -= pb4[3] * x19; a0 -= pb5[0] * x20; a1 -= pb5[1] * x21; a2 -= pb5[2] * x22; a3 -= pb5[3] * x23; a0 -= pb6[0] * x24; a1 -= pb6[1] * x25; a2 -= pb6[2] * x26; a3 -= pb6[3] * x27; a0 -= pb7[0] * x28; a1 -= pb7[1] * x29; a2 -= pb7[2] * x30; a3 -= pb7[3] * x31; a0 -= l0[0] * x32; a1 -= l0[1] * x33; a2 -= l0[2] * x34; a3 -= l0[3] * x35; a0 -= l1[0] * x36; a1 -= l1[1] * x37; a2 -= l1[2] * x38; a3 -= l1[3] * x39; a0 -= l2[0] * x40; a1 -= l2[1] * x41; a2 -= l2[2] * x42; a3 -= l2[3] * x43; a0 -= l3[0] * x44; a1 -= l3[1] * x45; a2 -= l3[2] * x46; a3 -= l3[3] * x47; a0 -= l4[0] * x48; a1 -= l4[1] * x49; a2 -= l4[2] * x50; a3 -= l4[3] * x51; a0 -= l5[0] * x52; a1 -= l5[1] * x53; a2 -= l5[2] * x54; a3 -= l5[3] * x55; a0 -= l6[0] * x56; a1 -= l6[1] * x57; a2 -= l6[2] * x58; a3 -= l6[3] * x59; a0 -= l7[0] * x60; a1 -= l7[1] * x61; a2 -= l7[2] * x62; x63 = (a0 + a1) + (a2 + a3); } INV_SB();
    asm volatile("s_waitcnt lgkmcnt(0)" ::: "memory");
    As[0 * 65 + lane] = x0; As[1 * 65 + lane] = x1; As[2 * 65 + lane] = x2; As[3 * 65 + lane] = x3; As[4 * 65 + lane] = x4; As[5 * 65 + lane] = x5; As[6 * 65 + lane] = x6; As[7 * 65 + lane] = x7;
    As[8 * 65 + lane] = x8; As[9 * 65 + lane] = x9; As[10 * 65 + lane] = x10; As[11 * 65 + lane] = x11; As[12 * 65 + lane] = x12; As[13 * 65 + lane] = x13; As[14 * 65 + lane] = x14; As[15 * 65 + lane] = x15;
    As[16 * 65 + lane] = x16; As[17 * 65 + lane] = x17; As[18 * 65 + lane] = x18; As[19 * 65 + lane] = x19; As[20 * 65 + lane] = x20; As[21 * 65 + lane] = x21; As[22 * 65 + lane] = x22; As[23 * 65 + lane] = x23;
    As[24 * 65 + lane] = x24; As[25 * 65 + lane] = x25; As[26 * 65 + lane] = x26; As[27 * 65 + lane] = x27; As[28 * 65 + lane] = x28; As[29 * 65 + lane] = x29; As[30 * 65 + lane] = x30; As[31 * 65 + lane] = x31;
    As[32 * 65 + lane] = x32; As[33 * 65 + lane] = x33; As[34 * 65 + lane] = x34; As[35 * 65 + lane] = x35; As[36 * 65 + lane] = x36; As[37 * 65 + lane] = x37; As[38 * 65 + lane] = x38; As[39 * 65 + lane] = x39;
    As[40 * 65 + lane] = x40; As[41 * 65 + lane] = x41; As[42 * 65 + lane] = x42; As[43 * 65 + lane] = x43; As[44 * 65 + lane] = x44; As[45 * 65 + lane] = x45; As[46 * 65 + lane] = x46; As[47 * 65 + lane] = x47;
    As[48 * 65 + lane] = x48; As[49 * 65 + lane] = x49; As[50 * 65 + lane] = x50; As[51 * 65 + lane] = x51; As[52 * 65 + lane] = x52; As[53 * 65 + lane] = x53; As[54 * 65 + lane] = x54; As[55 * 65 + lane] = x55;
    As[56 * 65 + lane] = x56; As[57 * 65 + lane] = x57; As[58 * 65 + lane] = x58; As[59 * 65 + lane] = x59; As[60 * 65 + lane] = x60; As[61 * 65 + lane] = x61; As[62 * 65 + lane] = x62; As[63 * 65 + lane] = x63;
    asm volatile("s_waitcnt lgkmcnt(0)" ::: "memory");
}
__device__ __forceinline__ void dnf_load_x(const bf16* QKV, int u, int tid, unsigned (&xr)[36]) {
    const int c = u >> 4, kh = u & 15;
    int s0, s1; if (c < 64) { s0 = (c >> 2) * 256; s1 = s0 + 256; } else { s0 = 4096 + ((c - 64) >> 4) * 1024; s1 = s0 + 1024; }
    const int cp = tid & 255, th = tid >> 8;
    const int r0 = c * 64 + th * 32 - 2;
    const bf16* base = QKV + (size_t)kh * 6144 * 512 + 2 * cp;
#pragma unroll
    for (int i = 0; i < 36; ++i) { const int rr = r0 + i; const bool ok = rr >= s0 && rr < s1; const unsigned v = *(const unsigned*)(base + (size_t)(ok ? rr : s0) * 512); xr[i] = ok ? v : 0u; }
}
__device__ __forceinline__ void phase_dn_front(const Params& p, LAS unsigned char* lds, int tid0, int lane0, int wave, int vcu, int G) {
    unsigned char* ws = p.ws; const int fl = p.flags;
    LAS float* XQK = (LAS float*)lds;
    LAS bf16* XV = (LAS bf16*)(lds + 66560);
    LAS float* Gm = (LAS float*)lds; LAS float* Pm = Gm + 64 * 65;
    LAS float* As = (LAS float*)(lds + 33280) + (wave & 3) * (64 * 68);
    LAS v4u* FB = (LAS v4u*)(lds + 105472);
    LAS float* RN = (LAS float*)(lds + 138240);
    LAS float* gcs = (LAS float*)(lds + 138752); LAS float* bes = gcs + 256;
    const bf16* QKV = (const bf16*)(ws + WS_QKV); const float* cw = p.in[11];
    const float* AB = (const float*)(ws + WS_AB); float* VEC = (float*)(ws + WS_VEC);
    unsigned xr[36]; float w0[5], w1[5];
    if (vcu < 1536) dnf_load_x(QKV, vcu, tid0, xr);
    for (int u = vcu; u < 1536; u += G) {
        const int c = u >> 4, kh = u & 15;
        int tid_o = tid0; asm volatile("" : "+v"(tid_o));
        const int tid = tid_o, lane = tid & 63, c16 = lane & 15, q4 = lane >> 4;
        if (!(fl & 4)) {
            const int cp = tid & 255, th = tid >> 8;
            int gcol, lcol; if (cp < 64) { gcol = kh * 128 + 2 * cp; lcol = 2 * cp; } else if (cp < 128) { gcol = 2048 + kh * 128 + 2 * (cp - 64); lcol = 128 + 2 * (cp - 64); } else { gcol = 4096 + kh * 256 + 2 * (cp - 128); lcol = 2 * (cp - 128); }
            if ((G & 15) != 0 || u == vcu) {
#pragma unroll
                for (int j = 0; j < 5; ++j) { w0[j] = cw[j * 8192 + gcol]; w1[j] = cw[j * 8192 + gcol + 1]; } }
#pragma unroll
            for (int i = 0; i < 32; ++i) {
                float a0 = 0.f, a1 = 0.f;
#pragma unroll
                for (int j = 0; j < 5; ++j) { a0 += w0[j] * bflo(xr[i + j]); a1 += w1[j] * bfhi(xr[i + j]); }
                a0 = silu_f(a0); a1 = silu_f(a1);
                const int t = th * 32 + i;
                if (cp < 128) *(LAS f32x2*)(XQK + t * 260 + lcol) = (f32x2){a0, a1}; else *(LAS unsigned*)(XV + t * 264 + lcol) = pk2(a0, a1);
            }
        }
        LDS_BAR();
        if (!(fl & 4))
        { float ra[8][4];
#pragma unroll
          for (int tt = 0; tt < 8; ++tt) { const LAS float* r = XQK + (wave * 8 + tt) * 260; ra[tt][0] = r[lane]; ra[tt][1] = r[64 + lane]; ra[tt][2] = r[128 + lane]; ra[tt][3] = r[192 + lane]; }
          __builtin_amdgcn_sched_barrier(0);
          float sq[8], sk[8];
#pragma unroll
          for (int tt = 0; tt < 8; ++tt) { sq[tt] = ra[tt][0] * ra[tt][0] + ra[tt][1] * ra[tt][1]; sk[tt] = ra[tt][2] * ra[tt][2] + ra[tt][3] * ra[tt][3]; }
#pragma unroll
          for (int o = 1; o < 64; o <<= 1) {
#pragma unroll
              for (int tt = 0; tt < 8; ++tt) { sq[tt] += __shfl_xor(sq[tt], o); sk[tt] += __shfl_xor(sk[tt], o); } }
#pragma unroll
          for (int tt = 0; tt < 8; ++tt) if (lane == tt) { const int t = wave * 8 + tt; RN[t] = (1.0f / sqrtf(sq[tt] + 1e-6f)) * 0.08838834764831845f; RN[64 + t] = 1.0f / sqrtf(sk[tt] + 1e-6f); } }
        LDS_BAR();
        if (!(fl & 2)) {
            v4u* KAo = (v4u*)(ws + WS_KA) + (size_t)u * 1024; v4u* QAo = (v4u*)(ws + WS_QA) + (size_t)u * 1024; v4u* KTo = (v4u*)(ws + WS_KT) + (size_t)u * 1024;
            v4u* VTo = (v4u*)(ws + WS_VT) + (size_t)(c * 32 + 2 * kh) * 1024;
            for (int pi = tid; pi < 1024; pi += 512) {
                const int mt = pi >> 8, ks = (pi >> 6) & 3, ln = pi & 63, t = 16 * mt + (ln & 15), kq = ln >> 4;
                const LAS float* rq = XQK + t * 260 + 32 * ks + 4 * kq;
                const v4u oq = pack8f(*(const LAS f32x4*)rq * RN[t], *(const LAS f32x4*)(rq + 16) * RN[t]);
                const v4u ok = pack8f(*(const LAS f32x4*)(rq + 128) * RN[64 + t], *(const LAS f32x4*)(rq + 144) * RN[64 + t]);
                QAo[pi] = oq; KAo[pi] = ok; FB[pi] = ok; FB[1024 + pi] = oq;
            }
            for (int pi = tid; pi < 1024; pi += 512) {
                const int mt = pi >> 7, ks = (pi >> 6) & 1, ln = pi & 63, dk = 16 * mt + (ln & 15), kq = ln >> 4, tb = 32 * ks + 4 * kq;
                float e[8], rn[8];
#pragma unroll
                for (int j = 0; j < 8; ++j) { const int t = tb + 16 * (j >> 2) + (j & 3); e[j] = XQK[t * 260 + 128 + dk]; rn[j] = RN[64 + t]; }
                __builtin_amdgcn_sched_barrier(0);
#pragma unroll
                for (int j = 0; j < 8; ++j) e[j] *= rn[j];
                v4u o; o.x = pk2(e[0], e[1]); o.y = pk2(e[2], e[3]); o.z = pk2(e[4], e[5]); o.w = pk2(e[6], e[7]); KTo[pi] = o;
            }
            for (int pi = tid; pi < 2048; pi += 512) {
                const int e2 = pi >> 10, q = pi & 1023, sl = q >> 7, hf = (q >> 6) & 1, ln = q & 63, dv = 16 * sl + (ln & 15), qq = ln >> 4;
                unsigned e[8];
#pragma unroll
                for (int j = 0; j < 8; ++j) { const int t = 16 * (2 * hf + (j >> 2)) + 4 * qq + (j & 3); e[j] = XV[t * 264 + e2 * 128 + dv]; }
                __builtin_amdgcn_sched_barrier(0);
                v4u o; o.x = e[0] | (e[1] << 16); o.y = e[2] | (e[3] << 16); o.z = e[4] | (e[5] << 16); o.w = e[6] | (e[7] << 16); VTo[pi] = o;
            }
            if (wave < 4) {
                const int su = wave, d = su & 1, h = 2 * kh + (su >> 1); const size_t row = (size_t)64 * c + lane;
                const float a = AB[row * 128 + d * 64 + h], b = AB[row * 128 + d * 64 + 32 + h];
                const float x = a + p.in[13][d * 32 + h], sp = x > 20.f ? x : log1pf(expf(x));
                const float lg = -expf(p.in[12][d * 32 + h]) * sp, beta = 1.0f / (1.0f + expf(-b));
                float pre = lg;
#pragma unroll
                for (int o = 1; o < 64; o <<= 1) { const float v = __shfl_up(pre, o); if (lane >= o) pre += v; }
                const float total = __shfl(pre, 63);
                const float gc = d ? (total - pre + lg) : pre;
                gcs[su * 64 + lane] = gc; bes[su * 64 + lane] = beta;
                float* V = VEC + (size_t)((c * 32 + h) * 2 + d) * 192; V[lane] = expf(gc); V[64 + lane] = expf(total - gc); if (lane == 0) V[128] = expf(total);
            }
        }
        LDS_BAR();
        if (!(fl & 8)) {
            const int mat = wave >> 2, mt = wave & 3;
            bf16x8 af[4];
#pragma unroll
            for (int ks = 0; ks < 4; ++ks) af[ks] = as_frag(FB[(mat ? 1024 : 0) + (mt * 4 + ks) * 64 + lane]);
            LAS float* M = mat ? Pm : Gm;
#pragma unroll
            for (int nt = 0; nt < 4; ++nt) { f32x4 acc = {0.f, 0.f, 0.f, 0.f};
#pragma unroll
                for (int ks = 0; ks < 4; ++ks) acc = MFMA16(af[ks], as_frag(FB[(nt * 4 + ks) * 64 + lane]), acc);
#pragma unroll
                for (int r = 0; r < 4; ++r) M[(16 * mt + 4 * q4 + r) * 65 + 16 * nt + c16] = acc[r]; }
        }
        LDS_BAR();
        if (fl & 1) { } else if (wave < 4) {
            const int su = wave, d = su & 1, h = 2 * kh + (su >> 1);
            const LAS float* gc_ = gcs + su * 64; const LAS float* be_ = bes + su * 64;
            if (!(fl & 32)) { const int j = d ? 63 - lane : lane; const float gcj = gc_[j];
#pragma unroll
              for (int b0 = 0; b0 < 64; b0 += 16) { float gi[16], bi[16], gm[16];
#pragma unroll
                  for (int k = 0; k < 16; ++k) { const int ip = b0 + k, i = d ? 63 - ip : ip; gi[k] = gc_[i]; bi[k] = be_[i]; gm[k] = Gm[i * 65 + j]; }
                  __builtin_amdgcn_sched_barrier(0);
#pragma unroll
                  for (int k = 0; k < 16; ++k) { const int ip = b0 + k; As[ip * 68 + lane] = (lane < ip) ? bi[k] * gm[k] * __expf(fminf(gi[k] - gcj, 0.f)) : 0.f; }
                  __builtin_amdgcn_sched_barrier(0); } }
            LDS_WAIT();
            if (!(fl & 16)) tri_inverse_64(As, lane);
            if (u + G < 1536) dnf_load_x(QKV, u + G, tid, xr);
            int c16b = c16, q4b = q4; asm volatile("" : "+v"(c16b), "+v"(q4b));
            v4u* TBo = (v4u*)(ws + WS_TB) + (size_t)((c * 32 + h) * 2 + d) * 512 + 16 * q4b + c16b;
            if (!(fl & 64))
#pragma unroll
            for (int ps = 0; ps < 8; ++ps) { const int mt = ps >> 1, ks = ps & 1, i = 16 * mt + c16b, ip = d ? 63 - i : i; float e[8];
                float bb[8];
#pragma unroll
                for (int k = 0; k < 8; ++k) { const int cc = 32 * ks + 16 * (k >> 2) + 4 * q4b + (k & 3), cp = d ? 63 - cc : cc; e[k] = As[ip * 65 + cp]; bb[k] = be_[cc]; }
                __builtin_amdgcn_sched_barrier(0);
#pragma unroll
                for (int k = 0; k < 8; ++k) e[k] *= bb[k];
                v4u o; o.x = pk2(e[0], e[1]); o.y = pk2(e[2], e[3]); o.z = pk2(e[4], e[5]); o.w = pk2(e[6], e[7]); TBo[ps * 64] = o; asm volatile("" ::: "memory"); }
        } else {
            const int su = wave - 4, d = su & 1, h = 2 * kh + (su >> 1);
            if (u + G < 1536) dnf_load_x(QKV, u + G, tid, xr);
            const LAS float* gc_ = gcs + su * 64;
            v4u* INo = (v4u*)(ws + WS_IN) + (size_t)((c * 32 + h) * 2 + d) * 512 + lane;
            if (!(fl & 128))
#pragma unroll
            for (int ps = 0; ps < 8; ++ps) { const int mt = ps >> 1, ks = ps & 1, i = 16 * mt + c16; const float gci = gc_[i]; float e[8];
                float gj[8];
#pragma unroll
                for (int k = 0; k < 8; ++k) { const int jn = 32 * ks + 16 * (k >> 2) + 4 * q4 + (k & 3); e[k] = Pm[i * 65 + jn]; gj[k] = gc_[jn]; }
                __builtin_amdgcn_sched_barrier(0);
#pragma unroll
                for (int k = 0; k < 8; ++k) { const int jn = 32 * ks + 16 * (k >> 2) + 4 * q4 + (k & 3); const bool ok = d ? (jn >= i) : (jn <= i);
                    e[k] = ok ? e[k] * __expf(fminf(gci - gj[k], 0.f)) : 0.f; }
                v4u o; o.x = pk2(e[0], e[1]); o.y = pk2(e[2], e[3]); o.z = pk2(e[4], e[5]); o.w = pk2(e[6], e[7]); INo[ps * 64] = o; asm volatile("" ::: "memory"); }
        }
        LDS_BAR();
    }
}

#ifndef DQ_SYNC
#define DQ_SYNC 0
#endif
constexpr int DQ_BUF = 50176, DQ_QA = 0, DQ_KT = 16384, DQ_TB = 32768, DQ_IN = 40960, DQ_VEC = 49152, DQ_KA = 2 * DQ_BUF, DQ_V = DQ_KA + 16384;
struct DnStep { int c, h, d; };
__device__ __forceinline__ void dq_group(int gi, int& lat, int& seq, int& h, int& d) { lat = gi < 128; const int gj = lat ? gi : gi - 128; seq = lat ? 16 + (gj >> 6) : (gj >> 6); h = (gj >> 1) & 31; d = gj & 1; }
__device__ __forceinline__ int dq_chunk(int lat, int seq, int d, int n) { const int nch = lat ? 16 : 4, cbase = lat ? 64 + 16 * (seq - 16) : 4 * seq; return cbase + (d ? nch - 1 - n : n); }
#define DMA16(gsrc, ldst) __builtin_amdgcn_global_load_lds((const unsigned*)(gsrc), (LAS unsigned*)(ldst), 16, 0, 0)
__device__ __forceinline__ void dq_issue_db(unsigned char* ws, LAS unsigned char* buf, const DnStep st, int wave, int lane) {
    const int kh = st.h >> 1; const size_t ck = (size_t)(st.c * 16 + kh) * 16384, chd = (size_t)((st.c * 32 + st.h) * 2 + st.d);
    const unsigned char* qa = ws + WS_QA + ck + lane * 16; const unsigned char* kt = ws + WS_KT + ck + lane * 16;
    const unsigned char* tb = ws + WS_TB + chd * 8192 + lane * 16; const unsigned char* in = ws + WS_IN + chd * 8192 + lane * 16;
#pragma unroll
    for (int i = 0; i < 2; ++i) { const int pc = wave + 8 * i; DMA16(qa + pc * 1024, buf + DQ_QA + pc * 1024); DMA16(kt + pc * 1024, buf + DQ_KT + pc * 1024); }
    DMA16(tb + wave * 1024, buf + DQ_TB + wave * 1024); DMA16(in + wave * 1024, buf + DQ_IN + wave * 1024);
    if (wave == 0) DMA16(ws + WS_VEC + chd * 768 + lane * 16, buf + DQ_VEC);
}
__device__ __forceinline__ void dq_issue_sb(unsigned char* ws, LAS unsigned char* lds, const DnStep st, int wave, int lane) {
    const int kh = st.h >> 1; const unsigned char* ka = ws + WS_KA + (size_t)(st.c * 16 + kh) * 16384 + lane * 16;
    const unsigned char* vt = ws + WS_VT + (size_t)(st.c * 32 + st.h) * 16384 + wave * 2048 + lane * 16;
#pragma unroll
    for (int i = 0; i < 2; ++i) { const int pc = wave + 8 * i; DMA16(ka + pc * 1024, lds + DQ_KA + pc * 1024); DMA16(vt + i * 1024, lds + DQ_V + wave * 2048 + i * 1024); }
}
__device__ __forceinline__ bf16x8 pack2(const f32x4 a, const f32x4 b) { return __builtin_bit_cast(bf16x8, pack8f(a, b)); }
__device__ __forceinline__ void phase_dn_seq(const Params& p, LAS unsigned char* lds, int lane, int wave, int vcu, int G) {
    unsigned char* ws = p.ws;
    const int c16 = lane & 15, q4 = lane >> 4;
    const int total_groups = (G == 256) ? (vcu < 128 ? 3 : 6) : ((1152 - vcu + G - 1) / G);
#define DQ_GROUP_AT(gp) ((G == 256) ? (vcu < 128 ? ((gp) == 0 ? vcu : 128 + 2 * vcu + (gp) - 1) : 384 + 6 * (vcu - 128) + (gp)) : vcu + (gp) * G)
    int gpos = 0, gi = DQ_GROUP_AT(0), n = 0, lat = 0, seq = 0, h = 0, d = 0, nch = 0;
    if (total_groups <= 0 || gi >= 1152) return;
    dq_group(gi, lat, seq, h, d); nch = lat ? 16 : 4;
    DnStep cur{dq_chunk(lat, seq, d, 0), h, d};
    dq_issue_db(ws, lds, cur, wave, lane); dq_issue_sb(ws, lds, cur, wave, lane);
    asm volatile("s_waitcnt vmcnt(0)\n\ts_barrier" ::: "memory");
    f32x4 S[8];
    int par = 0;
    for (;;) {
        if (n == 0) {
            if (lat) { const float* stp = p.in[d ? 3 : 2] + (size_t)((seq - 16) * 32 + h) * 16384 + 16 * wave + c16;
#pragma unroll
                for (int dt = 0; dt < 8; ++dt)
#pragma unroll
                    for (int r = 0; r < 4; ++r) S[dt][r] = stp[(16 * dt + 4 * q4 + r) * 128];
            } else {
#pragma unroll
                for (int dt = 0; dt < 8; ++dt) S[dt] = (f32x4){0.f, 0.f, 0.f, 0.f}; }
        }
        int n_gpos = gpos, n_gi = gi, n_n = n + 1, n_lat = lat, n_seq = seq, n_h = h, n_d = d; bool has_next = true;
        if (n_n == nch) { n_n = 0; n_gpos = gpos + 1; if (n_gpos >= total_groups) has_next = false; else { n_gi = DQ_GROUP_AT(n_gpos); dq_group(n_gi, n_lat, n_seq, n_h, n_d); } }
        const DnStep nxt{has_next ? dq_chunk(n_lat, n_seq, n_d, n_n) : cur.c, n_h, n_d};
        LAS unsigned char* buf = lds + par * DQ_BUF;
#if DQ_SYNC
        if (n != 0 || gpos != 0) { dq_issue_db(ws, buf, cur, wave, lane); dq_issue_sb(ws, lds, cur, wave, lane); asm volatile("s_waitcnt vmcnt(0)\n\ts_barrier" ::: "memory"); }
#endif
        bf16x8 Sb[4];
#pragma unroll
        for (int ks = 0; ks < 4; ++ks) Sb[ks] = pack2(S[2 * ks], S[2 * ks + 1]);
        if (has_next && !DQ_SYNC) dq_issue_db(ws, lds + (par ^ 1) * DQ_BUF, nxt, wave, lane);
        const LAS float* vec = (const LAS float*)(buf + DQ_VEC);
        f32x4 R[4];
        { const v4u v0 = *(const LAS v4u*)(lds + DQ_V + wave * 2048 + lane * 16), v1 = *(const LAS v4u*)(lds + DQ_V + wave * 2048 + 1024 + lane * 16);
          const f32x4 V[4] = {{bflo(v0.x), bfhi(v0.x), bflo(v0.y), bfhi(v0.y)}, {bflo(v0.z), bfhi(v0.z), bflo(v0.w), bfhi(v0.w)}, {bflo(v1.x), bfhi(v1.x), bflo(v1.y), bfhi(v1.y)}, {bflo(v1.z), bfhi(v1.z), bflo(v1.w), bfhi(v1.w)}};
#pragma unroll
          for (int mt = 0; mt < 4; ++mt) { f32x4 acc = {0.f, 0.f, 0.f, 0.f};
#pragma unroll
              for (int ks = 0; ks < 4; ++ks) acc = MFMA16(as_frag(*(const LAS v4u*)(lds + DQ_KA + ((mt * 4 + ks) * 64 + lane) * 16)), Sb[ks], acc);
              const f32x4 eg = *(const LAS f32x4*)(vec + 16 * mt + 4 * q4);
              R[mt] = V[mt] - eg * acc; } }
        const bf16x8 Rb[2] = {pack2(R[0], R[1]), pack2(R[2], R[3])};
        asm volatile("s_waitcnt lgkmcnt(0)\n\ts_barrier" ::: "memory");
        if (has_next && !DQ_SYNC) dq_issue_sb(ws, lds, nxt, wave, lane);
        f32x4 vn[4];
#pragma unroll
        for (int mt = 0; mt < 4; ++mt) { f32x4 acc = {0.f, 0.f, 0.f, 0.f};
#pragma unroll
            for (int ks = 0; ks < 2; ++ks) acc = MFMA16(as_frag(*(const LAS v4u*)(buf + DQ_TB + ((mt * 2 + ks) * 64 + lane) * 16)), Rb[ks], acc);
            vn[mt] = acc; }
        const bf16x8 vb[2] = {pack2(vn[0], vn[1]), pack2(vn[2], vn[3])};
#pragma unroll
        for (int mt = 0; mt < 4; ++mt) vn[mt] = vn[mt] * *(const LAS f32x4*)(vec + 64 + 16 * mt + 4 * q4);
        const bf16x8 vd[2] = {pack2(vn[0], vn[1]), pack2(vn[2], vn[3])};
        { bf16* op = (bf16*)(ws + WS_QKV) + (size_t)cur.d * MROWS * 4096 + (size_t)(64 * cur.c + 4 * q4) * 4096 + cur.h * 128 + 16 * wave + c16;
#pragma unroll
          for (int mt = 0; mt < 4; ++mt) { f32x4 acc = {0.f, 0.f, 0.f, 0.f};
#pragma unroll
              for (int ks = 0; ks < 4; ++ks) acc = MFMA16(as_frag(*(const LAS v4u*)(buf + DQ_QA + ((mt * 4 + ks) * 64 + lane) * 16)), Sb[ks], acc);
              acc = acc * *(const LAS f32x4*)(vec + 16 * mt + 4 * q4);
#pragma unroll
              for (int ks = 0; ks < 2; ++ks) acc = MFMA16(as_frag(*(const LAS v4u*)(buf + DQ_IN + ((mt * 2 + ks) * 64 + lane) * 16)), vb[ks], acc);
#pragma unroll
              for (int r = 0; r < 4; ++r) op[(size_t)(16 * mt + r) * 4096] = (bf16)f2bf(acc[r]); } }
        { const float egl = vec[128];
#pragma unroll
          for (int dt = 0; dt < 8; ++dt) { f32x4 acc = S[dt] * egl;
#pragma unroll
              for (int ks = 0; ks < 2; ++ks) acc = MFMA16(as_frag(*(const LAS v4u*)(buf + DQ_KT + ((dt * 2 + ks) * 64 + lane) * 16)), vd[ks], acc);
              S[dt] = acc; } }
        if (n + 1 == nch && !lat) {
            float* so = p.out + (d ? OUT_SB : OUT_SF) + (size_t)(seq * 32 + h) * 16384 + 16 * wave + c16;
#pragma unroll
            for (int dt = 0; dt < 8; ++dt)
#pragma unroll
                for (int r = 0; r < 4; ++r) so[(16 * dt + 4 * q4 + r) * 128] = S[dt][r]; }
        asm volatile("s_waitcnt vmcnt(0) lgkmcnt(0)\n\ts_barrier" ::: "memory");
        if (!has_next) break;
        gpos = n_gpos; gi = n_gi; n = n_n; lat = n_lat; seq = n_seq; h = n_h; d = n_d; nch = lat ? 16 : 4; cur = nxt; par ^= 1;
    }
}

__device__ __forceinline__ void phase_combine(const Params& p, int lane, int wave, int vcu, int G) {
    unsigned char* ws = p.ws;
    const bf16* OF = (const bf16*)(ws + WS_QKV); const bf16* OB = OF + (size_t)MROWS * 4096; const bf16* Z = (const bf16*)(ws + WS_Z); bf16* OG = (bf16*)(ws + WS_KA);
    const int gw = vcu * NWAVES + wave, NGW = G * NWAVES, half = lane >> 5, l32 = lane & 31;
    const f32x4 nw = *(const f32x4*)(p.in[14] + 4 * l32);
    for (int it = gw; it < MROWS * 16; it += NGW) {
        const int row = it >> 4, hv = (it & 15) * 2 + half; const size_t off = (size_t)row * 4096 + hv * 128 + 4 * l32;
        const v2u a = *(const v2u*)(OF + off), b = *(const v2u*)(OB + off), z = *(const v2u*)(Z + off);
        f32x4 o = {bflo(a.x) + bflo(b.x), bfhi(a.x) + bfhi(b.x), bflo(a.y) + bflo(b.y), bfhi(a.y) + bfhi(b.y)};
        float ss = (o[0] * o[0] + o[1] * o[1]) + (o[2] * o[2] + o[3] * o[3]);
#pragma unroll
        for (int m = 1; m < 32; m <<= 1) ss += __shfl_xor(ss, m);
        const float r = 1.0f / sqrtf(ss * (1.0f / 128.0f) + 1e-6f);
        const f32x4 zz = {silu_f(bflo(z.x)), silu_f(bfhi(z.x)), silu_f(bflo(z.y)), silu_f(bfhi(z.y))};
        const f32x4 y = o * r * nw * zz; v2u w; w.x = pk2(y[0], y[1]); w.y = pk2(y[2], y[3]); *(v2u*)(OG + off) = w;
    }
}

__device__ __forceinline__ void phase_spatial(const Params& p, LAS unsigned char* lds, int tid0, int lane0, int wave, int vcu, int G) {
    unsigned char* ws = p.ws;
    LAS bf16* VL = (LAS bf16*)lds;
    LAS bf16* WL = (LAS bf16*)(lds + 67584);
    LAS float* RS = (LAS float*)(lds + 67584 + 34816);
    LAS float* BS = RS + 256;
    LAS bf16* UL = (LAS bf16*)(lds + 67584 + 34816 + 2048);
    const bf16* H = (const bf16*)(ws + WS_QKV); bf16* UV = (bf16*)(ws + WS_Z); const float* STATS = (const float*)(ws + WS_STATS);
    const int per = (768 + G - 1) / G, u0 = vcu * per, u1 = (u0 + per < 768) ? u0 + per : 768;
    int cur_tc = -1;
    for (int u = u0; u < u1; ++u) {
        const int tc = u >> 4, g = u & 15;
        int tid_o = tid0; asm volatile("" : "+v"(tid_o));
        const int tid = tid_o, lane = tid & 63, l31 = lane & 31, hh = lane >> 5, col = 32 * wave + l31;
        LDS_BAR();
        if (tc != cur_tc) {
            const int q = tid >> 2, part = tid & 3; const f32x4* st = (const f32x4*)(STATS + (size_t)(128 * tc + q) * 128 + part * 32); f32x4 x[8];
#pragma unroll
            for (int i = 0; i < 8; ++i) x[i] = st[i];
            float s1 = 0.f, s2 = 0.f;
#pragma unroll
            for (int i = 0; i < 8; ++i) { s1 += x[i][0] + x[i][2]; s2 += x[i][1] + x[i][3]; }
            s1 += __shfl_xor(s1, 1); s1 += __shfl_xor(s1, 2); s2 += __shfl_xor(s2, 1); s2 += __shfl_xor(s2, 2);
            const float mu = s1 * (1.0f / 4096.0f), var = s2 * (1.0f / 4096.0f) - mu * mu;
            if (part == 0) { RS[2 * q] = mu; RS[2 * q + 1] = 1.0f / sqrtf(fmaxf(var, 0.f) + 1e-6f); }
            cur_tc = tc;
        }
        v4u vraw[8], wraw[4], uraw[8];
#pragma unroll
        for (int k = 0; k < 8; ++k) { const int pi = tid + 512 * k, q = pi >> 5, c8 = pi & 31; vraw[k] = *(const v4u*)(H + (size_t)(128 * tc + q) * 8192 + 4096 + 256 * g + 8 * c8); }
#pragma unroll
        for (int k = 0; k < 4; ++k) { const int pi = tid + 512 * k, pr = pi >> 4, c8 = pi & 15; wraw[k] = *(const v4u*)((const bf16*)(ws + WS_WSB) + (size_t)g * 16384 + pr * 128 + 8 * c8); }
#pragma unroll
        for (int k = 0; k < 8; ++k) { const int pi = tid + 512 * k, q = pi >> 5, c8 = pi & 31; uraw[k] = *(const v4u*)(H + (size_t)(128 * tc + q) * 8192 + 256 * g + 8 * c8); }
        const int c8v = tid & 31;
        const float* lw = p.in[18] + 256 * g + 8 * c8v; const float* lb = p.in[19] + 256 * g + 8 * c8v;
        const f32x4 w0 = *(const f32x4*)lw, w1 = *(const f32x4*)(lw + 4), b0 = *(const f32x4*)lb, b1 = *(const f32x4*)(lb + 4);
        f32x4 bsr = {0.f, 0.f, 0.f, 0.f}; if (tid < 32) bsr = *(const f32x4*)(p.in[21] + g * 128 + 4 * tid);
        LDS_BAR();
#pragma unroll
        for (int k = 0; k < 8; ++k) { const int pi = tid + 512 * k, q = pi >> 5, c8 = pi & 31; const v4u raw = vraw[k];
            const float mu = RS[2 * q], rs = RS[2 * q + 1];
            const f32x4 x0 = {bflo(raw.x), bfhi(raw.x), bflo(raw.y), bfhi(raw.y)}, x1 = {bflo(raw.z), bfhi(raw.z), bflo(raw.w), bfhi(raw.w)};
            const f32x4 y0 = (x0 - mu) * rs * w0 + b0, y1 = (x1 - mu) * rs * w1 + b1;
            *(LAS v4u*)(VL + q * 264 + 8 * c8) = pack8f(y0, y1); }
#pragma unroll
        for (int k = 0; k < 4; ++k) { const int pi = tid + 512 * k, pr = pi >> 4, c8 = pi & 15; *(LAS v4u*)(WL + pr * 136 + 8 * c8) = wraw[k]; }
        if (tid < 32) *(LAS f32x4*)(BS + 4 * tid) = bsr;
#pragma unroll
        for (int k = 0; k < 4; ++k) { const int pi = tid + 512 * k, q = pi >> 5, c8 = pi & 31; *(LAS v4u*)(UL + q * 264 + 8 * c8) = uraw[k]; }
        LDS_BAR();
        bf16x8 bfr[8];
        { unsigned t[8][8];
#pragma unroll
          for (int s = 0; s < 8; ++s)
#pragma unroll
              for (int e = 0; e < 8; ++e) t[s][e] = VL[(16 * s + 8 * hh + e) * 264 + col];
          __builtin_amdgcn_sched_barrier(0);
#pragma unroll
          for (int s = 0; s < 8; ++s)
#pragma unroll
              for (int e = 0; e < 8; ++e) bfr[s][e] = (short)t[s][e]; }
        f32x16 acc[4];
#pragma unroll
        for (int rb = 0; rb < 4; ++rb) {
#pragma unroll
            for (int e = 0; e < 16; ++e) acc[rb][e] = 0.f;
            bf16x8 af[8];
#pragma unroll
            for (int s = 0; s < 8; ++s) af[s] = *(const LAS bf16x8*)(WL + (32 * rb + l31) * 136 + 16 * s + 8 * hh);
#pragma unroll
            for (int s = 0; s < 8; ++s) acc[rb] = __builtin_amdgcn_mfma_f32_32x32x16_bf16(af[s], bfr[s], acc[rb], 0, 0, 0);
        }
#pragma unroll
        for (int hf = 0; hf < 2; ++hf) {
            if (hf == 1) { LDS_BAR();
#pragma unroll
                for (int k = 0; k < 4; ++k) { const int pi = tid + 512 * k, q = pi >> 5, c8 = pi & 31; *(LAS v4u*)(UL + q * 264 + 8 * c8) = uraw[4 + k]; }
                LDS_BAR(); }
#pragma unroll
            for (int r2 = 0; r2 < 2; ++r2) { const int rb = 2 * hf + r2; unsigned uv[16];
#pragma unroll
                for (int e = 0; e < 16; ++e) uv[e] = UL[(32 * r2 + (e & 3) + 8 * (e >> 2) + 4 * hh) * 264 + col];
                __builtin_amdgcn_sched_barrier(0);
#pragma unroll
                for (int e = 0; e < 16; ++e) { const int prl = 32 * r2 + (e & 3) + 8 * (e >> 2) + 4 * hh; const float val = acc[rb][e] + BS[64 * hf + prl];
                    UL[prl * 264 + col] = (bf16)f2bf(bf2f((bf16)uv[e]) * val); } }
            LDS_BAR();
#pragma unroll
            for (int k = 0; k < 4; ++k) { const int pi = tid + 512 * k, q = pi >> 5, c8 = pi & 31; *(v4u*)(UV + (size_t)(128 * tc + 64 * hf + q) * 4096 + 256 * g + 8 * c8) = *(const LAS v4u*)(UL + q * 264 + 8 * c8); }
        }
    }
}

#define XB_TMO      128
#define XB_XCNT(j)  (256  + 64 * (j))
#define XB_XSUB(j)  (1280 + 64 * (j))
#define XB_XGEN(j)  (2304 + 64 * (j))
#define XB_TOP      3328
#define XB_TOPGEN   3392
#define XCD_BAR_WORDS 3456
#define XB_SPIN_CAP (1u << 18)

__device__ __forceinline__ unsigned xb_ld(unsigned* p)              { return __hip_atomic_load(p, __ATOMIC_RELAXED, __HIP_MEMORY_SCOPE_AGENT); }
__device__ __forceinline__ unsigned xb_add(unsigned* p, unsigned v) { return __hip_atomic_fetch_add(p, v, __ATOMIC_RELAXED, __HIP_MEMORY_SCOPE_AGENT); }
__device__ __forceinline__ unsigned xb_xcc_id() { return (unsigned)__builtin_amdgcn_s_getreg((3 << 11) | 20) & 0xFu; }
#define XB_SPIN(cond, bar) do { unsigned _sp = 0; while (cond) { __builtin_amdgcn_s_sleep(1); \
    if ((++_sp & 255u) == 0u) { if (xb_ld(&(bar)[XB_TMO])) break; if (_sp > XB_SPIN_CAP) { atomicAdd(&(bar)[XB_TMO], 1u); break; } } } } while (0)

struct XcdBarrier {
    unsigned* bar; unsigned x;
    volatile LAS unsigned* st;
};

__device__ __forceinline__ XcdBarrier xcd_barrier_post(unsigned* bar, volatile LAS unsigned* st) {
    XcdBarrier b; b.bar = bar; b.x = xb_xcc_id(); b.st = st;
    if (threadIdx.x == 0) (void)xb_add(&bar[XB_XCNT(b.x)], 1u);
    return b;
}
__device__ __forceinline__ void xcd_barrier_complete(unsigned* bar, unsigned x, unsigned& nloc, unsigned& nx) {
    const unsigned G = gridDim.x * gridDim.y * gridDim.z;
    unsigned sum, cnt, mine, sp = 0u;
    for (;;) {
        sum = 0u; cnt = 0u; mine = 0u;
#pragma unroll
        for (unsigned j = 0; j < 16; ++j) { const unsigned c = xb_ld(&bar[XB_XCNT(j)]); sum += c; cnt += (c > 0u) ? 1u : 0u; mine = (j == x) ? c : mine; }
        if (sum == G) break;
        __builtin_amdgcn_s_sleep(1);
        if ((++sp & 255u) == 0u) { if (xb_ld(&bar[XB_TMO])) break; if (sp > XB_SPIN_CAP) { atomicAdd(&bar[XB_TMO], 1u); break; } }
    }
    nloc = mine > 0u ? mine : 1u; nx = cnt > 0u ? cnt : 1u;
}

__device__ __forceinline__ void xcd_barrier(const XcdBarrier& b) {
    asm volatile("s_waitcnt vmcnt(0)" ::: "memory");
    __syncthreads();
    if (threadIdx.x == 0) {
        unsigned* bar = b.bar;
        __builtin_amdgcn_s_waitcnt(0);
        unsigned nloc = b.st[0], nx = b.st[1];
        if (nloc == 0u) { xcd_barrier_complete(bar, b.x, nloc, nx); b.st[0] = nloc; b.st[1] = nx; }
        const unsigned old = xb_add(&bar[XB_XSUB(b.x)], 1u);
        const unsigned gen = old / nloc;
        if (old + 1u == (gen + 1u) * nloc) {
            __builtin_amdgcn_fence(__ATOMIC_RELEASE, "agent");
            asm volatile("s_waitcnt vmcnt(0)" ::: "memory");
            const unsigned og = xb_add(&bar[XB_TOP], 1u);
            const unsigned tg = og / nx;
            if (og + 1u == (tg + 1u) * nx) xb_add(&bar[XB_TOPGEN], 1u);
            else XB_SPIN(xb_ld(&bar[XB_TOPGEN]) == tg, bar);
            __builtin_amdgcn_fence(__ATOMIC_ACQUIRE, "agent");
            xb_add(&bar[XB_XGEN(b.x)], 1u);
            asm volatile("s_waitcnt vmcnt(0)" ::: "memory");
        } else {
            XB_SPIN(xb_ld(&bar[XB_XGEN(b.x)]) == gen, bar);
            __builtin_amdgcn_fence(__ATOMIC_ACQUIRE, "agent");
            asm volatile("s_waitcnt vmcnt(0)" ::: "memory");
        }
    }
    __syncthreads();
}

constexpr int XB_LDS_OFF = LDS_BYTES - 256, CW_BAR = 4096;
__device__ __forceinline__ int rep_opaque(int v) { if (v == 0) return 0; asm volatile("" : "+s"(v)); return v; }
#ifndef DN_NAIVE
#define DN_NAIVE 0
#endif
#ifndef USE_CG_SYNC
#define USE_CG_SYNC 0
#endif
constexpr int NPHASE = 19;
__global__ void __launch_bounds__(NWAVES * 64, 2) mega_fwd(Params p) {
    extern __shared__ __attribute__((aligned(16))) unsigned char lds_raw[];
    LAS unsigned char* lds = (LAS unsigned char*)lds_raw;
    const int tid = threadIdx.x, lane = tid & 63, wave = __builtin_amdgcn_readfirstlane(tid >> 6);
    const int G = gridDim.x, bx = blockIdx.x, vcu = (G % 8 == 0) ? (bx % 8) * (G / 8) + bx / 8 : bx;
    unsigned char* ws = p.ws;
    const int lo = p.ph_lo, hi = p.ph_hi;
    XcdBarrier bar; bar.bar = (unsigned*)(ws + WS_CTL) + CW_BAR; bar.x = 0; bar.st = (volatile LAS unsigned*)(lds + XB_LDS_OFF);
    if (!USE_CG_SYNC && hi - lo > 1) {
        if (tid < 64) ((volatile LAS unsigned*)(lds + XB_LDS_OFF))[tid] = 0u;
        __syncthreads();
        bar = xcd_barrier_post((unsigned*)(ws + WS_CTL) + CW_BAR, (volatile LAS unsigned*)(lds + XB_LDS_OFF));
    }
#ifndef PH_MASK
#define PH_MASK 0xFFFFFFFFu
#endif
#ifndef REP_MASK
#define REP_MASK 0u
#endif
#ifndef HOST_REP_MASK
#define HOST_REP_MASK 0u
#endif
#ifndef HOST_VAR_FLAGS
#define HOST_VAR_FLAGS 0
#endif
#define REP(k) ((int)((REP_MASK >> (k)) & 1u))
#define IN(k) (((PH_MASK >> (k)) & 1u) && lo <= (k) && (k) < hi)
#define SEAM(k) do { if (IN(k) && (IN((k) + 1) || ((k) == 3 && IN(5)))) { if (USE_CG_SYNC) cg::this_grid().sync(); else xcd_barrier(bar); } STAMP((k) + 1); } while (0)
#ifdef PROBE_A_LO
    unsigned long long* TS = (unsigned long long*)(ws + WS_CTL + 1024);
#define STAMP(k) do { if (bx == 0 && tid == 0) __hip_atomic_store(TS + (k), __builtin_amdgcn_s_memrealtime(), __ATOMIC_RELAXED, __HIP_MEMORY_SCOPE_AGENT); } while (0)
#else
#define STAMP(k) do { } while (0)
#endif
    const float* MOD = (const float*)(ws + WS_MOD); const float* ZG = (const float*)(ws + WS_CTL + 65536);
    bf16* XN = (bf16*)(ws + WS_XN); float* X = (float*)(ws + WS_X); bf16* Hb = (bf16*)(ws + WS_QKV);

    STAMP(0);
    if (IN(0)) _Pragma("nounroll") for (int rep_ = 0, nrep_ = rep_opaque(REP(0)); rep_ <= nrep_; ++rep_) { phase_prologue(p, lds, tid, lane, wave, vcu, G); } SEAM(0);
    if (IN(1)) _Pragma("nounroll") for (int rep_ = 0, nrep_ = rep_opaque(REP(1)); rep_ <= nrep_; ++rep_) { phase_norm<0>(p, 0, 0, lane, wave, vcu, G); } SEAM(1);
    if (IN(2)) _Pragma("nounroll") for (int rep_ = 0, nrep_ = rep_opaque(REP(2)); rep_ <= nrep_; ++rep_) { pg8::Gemm g{XN, (const bf16*)(ws + WS_WIN), MROWS, NPROJ_PAD, 2048}; pg8::StaticOrder S; S.init(MROWS, NPROJ_PAD, G, bx);
        pg8::EpiProj E{(bf16*)(ws + WS_QKV), (bf16*)(ws + WS_Z), (float*)(ws + WS_AB)};
        pg8::gemm_phase<pg8::EpiProj, pg8::StaticOrder, true, true>(lds, g, S, E); } SEAM(2);
    if (IN(3)) _Pragma("nounroll") for (int rep_ = 0, nrep_ = rep_opaque(REP(3)); rep_ <= nrep_; ++rep_) { phase_dn_front(p, lds, tid, lane, wave, vcu, G); } SEAM(3);
    if (IN(5)) _Pragma("nounroll") for (int rep_ = 0, nrep_ = rep_opaque(REP(5)); rep_ <= nrep_; ++rep_) { phase_dn_seq(p, lds, lane, wave, vcu, G); } SEAM(5);
    if (IN(6)) _Pragma("nounroll") for (int rep_ = 0, nrep_ = rep_opaque(REP(6)); rep_ <= nrep_; ++rep_) { phase_combine(p, lane, wave, vcu, G); } SEAM(6);
    if (IN(7)) _Pragma("nounroll") for (int rep_ = 0, nrep_ = rep_opaque(REP(7)); rep_ <= nrep_; ++rep_) { pg8::Gemm g{(const bf16*)(ws + WS_KA), (const bf16*)(ws + WS_WOUT), MROWS, 2048, 4096}; pg8::StaticOrder S; S.init(MROWS, 2048, G, bx);
        pg8::EpiRes E{X, (rep_ || (p.flags & 256)) ? ZG : MOD + 4096};
        pg8::gemm_phase<pg8::EpiRes, pg8::StaticOrder, true, true>(lds, g, S, E); } SEAM(7);
    if (IN(8)) _Pragma("nounroll") for (int rep_ = 0, nrep_ = rep_opaque(REP(8)); rep_ <= nrep_; ++rep_) { phase_norm<1>(p, 0, 1, lane, wave, vcu, G); } SEAM(8);
    if (IN(9)) _Pragma("nounroll") for (int rep_ = 0, nrep_ = rep_opaque(REP(9)); rep_ <= nrep_; ++rep_) { pg8::Gemm g{XN, (const bf16*)(ws + WS_WFF1), MROWS, 8192, 2048}; pg8::StaticOrder S; S.init(MROWS, 8192, G, bx);
        pg8::EpiAct<0> E{Hb, nullptr, nullptr};
        pg8::gemm_phase<pg8::EpiAct<0>, pg8::StaticOrder, true, true>(lds, g, S, E); } SEAM(9);
    if (IN(10)) _Pragma("nounroll") for (int rep_ = 0, nrep_ = rep_opaque(REP(10)); rep_ <= nrep_; ++rep_) { pg8::Gemm g{Hb, (const bf16*)(ws + WS_WFF2), MROWS, 2048, 8192}; pg8::StaticOrder S; S.init(MROWS, 2048, G, bx);
        pg8::EpiRes E{X, (rep_ || (p.flags & 256)) ? ZG : MOD + 10240};
        pg8::gemm_phase<pg8::EpiRes, pg8::StaticOrder, true, true>(lds, g, S, E); } SEAM(10);
    if (IN(11)) _Pragma("nounroll") for (int rep_ = 0, nrep_ = rep_opaque(REP(11)); rep_ <= nrep_; ++rep_) { phase_norm<1>(p, 1, 0, lane, wave, vcu, G); } SEAM(11);
    if (IN(12)) _Pragma("nounroll") for (int rep_ = 0, nrep_ = rep_opaque(REP(12)); rep_ <= nrep_; ++rep_) { pg8::Gemm g{XN, (const bf16*)(ws + WS_WCMIN), MROWS, 8192, 2048}; pg8::StaticOrder S; S.init(MROWS, 8192, G, bx);
        pg8::EpiAct<1> E{Hb, p.in[17], (float*)(ws + WS_STATS)};
        pg8::gemm_phase<pg8::EpiAct<1>, pg8::StaticOrder, true, true>(lds, g, S, E); } SEAM(12);
    if (IN(13)) _Pragma("nounroll") for (int rep_ = 0, nrep_ = rep_opaque(REP(13)); rep_ <= nrep_; ++rep_) { phase_spatial(p, lds, tid, lane, wave, vcu, G); } SEAM(13);
    if (IN(14)) _Pragma("nounroll") for (int rep_ = 0, nrep_ = rep_opaque(REP(14)); rep_ <= nrep_; ++rep_) { pg8::Gemm g{(const bf16*)(ws + WS_Z), (const bf16*)(ws + WS_WCMOUT), MROWS, 2048, 4096}; pg8::StaticOrder S; S.init(MROWS, 2048, G, bx);
        pg8::EpiRes E{X, (rep_ || (p.flags & 256)) ? ZG : MOD + 3 * 12288 + 4096};
        pg8::gemm_phase<pg8::EpiRes, pg8::StaticOrder, true, true>(lds, g, S, E); } SEAM(14);
    if (IN(15)) _Pragma("nounroll") for (int rep_ = 0, nrep_ = rep_opaque(REP(15)); rep_ <= nrep_; ++rep_) { phase_norm<1>(p, 1, 1, lane, wave, vcu, G); } SEAM(15);
    if (IN(16)) _Pragma("nounroll") for (int rep_ = 0, nrep_ = rep_opaque(REP(16)); rep_ <= nrep_; ++rep_) { pg8::Gemm g{XN, (const bf16*)(ws + WS_WFF1) + (size_t)2048 * 8192, MROWS, 8192, 2048}; pg8::StaticOrder S; S.init(MROWS, 8192, G, bx);
        pg8::EpiAct<0> E{Hb, nullptr, nullptr};
        pg8::gemm_phase<pg8::EpiAct<0>, pg8::StaticOrder, true, true>(lds, g, S, E); } SEAM(16);
    if (IN(17)) _Pragma("nounroll") for (int rep_ = 0, nrep_ = rep_opaque(REP(17)); rep_ <= nrep_; ++rep_) { pg8::Gemm g{Hb, (const bf16*)(ws + WS_WFF2) + (size_t)2048 * 8192, MROWS, 2048, 8192}; pg8::StaticOrder S; S.init(MROWS, 2048, G, bx);
        pg8::EpiRes E{X, (rep_ || (p.flags & 256)) ? ZG : MOD + 3 * 12288 + 10240};
        pg8::gemm_phase<pg8::EpiRes, pg8::StaticOrder, true, true>(lds, g, S, E); } SEAM(17);
    if (IN(18)) _Pragma("nounroll") for (int rep_ = 0, nrep_ = rep_opaque(REP(18)); rep_ <= nrep_; ++rep_) { phase_norm<2>(p, 0, 0, lane, wave, vcu, G); }
#undef IN
#undef SEAM
}

extern "C" void kernel_launch(void* const* d_in, const int* in_sizes, int n_in, void* d_out, int out_size, void* d_ws, size_t ws_size, hipStream_t stream) {
    static int grid = 0;
    if (grid == 0) {
        if (n_in != 26 || ws_size < WS_END) { fprintf(stderr, "kernel_launch: expected 26 inputs and >= %zu bytes of workspace; got %d, %zu\n", (size_t)WS_END, n_in, ws_size); grid = -1; return; }
        int dev = 0, cus = 0, per_cu = 0;
        if (hipGetDevice(&dev) != hipSuccess || hipDeviceGetAttribute(&cus, hipDeviceAttributeMultiprocessorCount, dev) != hipSuccess) { grid = -1; return; }
        if (hipFuncSetAttribute((const void*)mega_fwd, hipFuncAttributeMaxDynamicSharedMemorySize, LDS_BYTES) != hipSuccess) { fprintf(stderr, "kernel_launch: hipFuncSetAttribute failed\n"); grid = -1; return; }
        if (hipOccupancyMaxActiveBlocksPerMultiprocessor(&per_cu, (const void*)mega_fwd, NWAVES * 64, LDS_BYTES) != hipSuccess || per_cu < 1) { fprintf(stderr, "kernel_launch: occupancy query reports %d blocks per CU\n", per_cu); (void)hipGetLastError(); per_cu = 1; }
        grid = cus;
    }
    if (grid < 0) return;
    if (hipMemsetAsync((char*)d_ws + WS_CTL, 0, (REP_MASK || HOST_REP_MASK) ? 262144 : 65536, stream) != hipSuccess) { fprintf(stderr, "kernel_launch: hipMemsetAsync failed\n"); return; }
    Params a{};
    for (int i = 0; i < 26; ++i) a.in[i] = (const float*)d_in[i];
    a.out = (float*)d_out; a.ws = (unsigned char*)d_ws;
#if MK_PER_PHASE
    for (int ph = 0; ph < NPHASE; ++ph) { if (ph == 4) continue; a.ph_lo = ph; a.ph_hi = ph + 1; for (int r = 0; r <= (int)((HOST_REP_MASK >> ph) & 1u); ++r) { a.flags = (r == 0 && ((HOST_REP_MASK >> ph) & 1u)) ? HOST_VAR_FLAGS : 0; hipLaunchKernelGGL(mega_fwd, dim3(grid), dim3(NWAVES * 64), LDS_BYTES, stream, a); } }
#else
    a.ph_lo = 0; a.ph_hi = NPHASE;
    void* args[] = {&a};
    hipError_t e = hipLaunchCooperativeKernel((const void*)mega_fwd, dim3(grid), dim3(NWAVES * 64), args, LDS_BYTES, stream);
    if (e != hipSuccess) fprintf(stderr, "kernel_launch: cooperative launch failed: %s (grid %d)\n", hipGetErrorString(e), grid);
#endif
}
```

```cpp
#include <hip/hip_runtime.h>
#include <hip/hip_cooperative_groups.h>
#include <cstdio>
#include <cstdint>
namespace cg = cooperative_groups;
#ifndef MK_PER_PHASE
#define MK_PER_PHASE 0
#endif
namespace pg8 {
#define PG8_LAS __attribute__((address_space(3)))
typedef unsigned short bf16_t;
typedef short bf16x8 __attribute__((ext_vector_type(8)));
typedef float f32x4 __attribute__((ext_vector_type(4)));
typedef unsigned u32x4 __attribute__((ext_vector_type(4)));
constexpr int BM = 256, BK = 64, HALF = 128, HTB = HALF * BK * 2  , STAGE_BYTES = 8 * HTB, NXCD = 8, WGM = 8;

__host__ __device__ __forceinline__ int lds_byte(int r, int c) { const int st = (r >> 4) * 2 + (c >> 5), rr = r & 15, cc = c & 31, ob = rr * 64 + cc * 2; return st * 1024 + (ob ^ (((ob >> 9) & 1) << 5)); }
__host__ __device__ __forceinline__ void stage_rc(int b, int& R, int& C) { const int st = b / 1024, sb = b % 1024, swz = sb ^ (((sb >> 9) & 1) << 5); R = (st >> 1) * 16 + swz / 64; C = (st & 1) * 32 + (swz % 64) / 2; }
__host__ __device__ __forceinline__ int perm32(int rho) { const int n = rho >> 4, i = rho & 15; return 8 * (i >> 2) + 4 * n + (i & 3); }

struct Unit { int pm, pn; };
struct Gemm { const bf16_t* A; const bf16_t* Bt; int M, N, K; };

struct StaticOrder {
    int nM, nN, nwg, G, c;
    __host__ __device__ void init(int M, int N, int G_, int c_) { nM = M / BM; nN = N / BM; nwg = nM * nN; G = G_; c = c_; }
    __host__ __device__ bool next(int i, Unit& u) const {
        const long L = (long)i * G + c; if (L >= nwg) return false;
        int wgid = (int)L; { const int q = nwg / NXCD, r = nwg % NXCD, xcd = wgid % NXCD, off = wgid / NXCD; wgid = (xcd < r ? xcd * (q + 1) : r * (q + 1) + (xcd - r) * q) + off; }
        const int nig = WGM * nN, gid = wgid / nig, fm = gid * WGM, gsz = (nM - fm) < WGM ? (nM - fm) : WGM;
        u.pm = fm + ((wgid % nig) % gsz); u.pn = (wgid % nig) / gsz; return true;
    }
    __device__ __forceinline__ void a_ready(const Unit&) const {}
    __device__ __forceinline__ void done(const Unit&) const {}
};

typedef float f32x2_t __attribute__((ext_vector_type(2))); typedef __bf16 bf16x2_t __attribute__((ext_vector_type(2)));
__device__ __forceinline__ unsigned cvt_pk_bf16(float lo, float hi) { const f32x2_t v = {lo, hi}; const bf16x2_t b = __builtin_convertvector(v, bf16x2_t); return __builtin_bit_cast(unsigned, b); }
__device__ __forceinline__ u32x4 pack8(const f32x4 v0, const f32x4 v1) { u32x4 w; w.x = cvt_pk_bf16(v0[0], v0[1]); w.y = cvt_pk_bf16(v0[2], v0[3]); w.z = cvt_pk_bf16(v1[0], v1[1]); w.w = cvt_pk_bf16(v1[2], v1[3]); return w; }
__device__ __forceinline__ float gelu_tanh(float x) {
    const float u = 0.7978845608028654f * (x + 0.044715f * x * x * x);
    const float e = __builtin_amdgcn_exp2f(-2.0f * 1.4426950408889634f * u);
    return x * __builtin_amdgcn_rcpf(1.0f + e);
}
struct EpiProj {
    static constexpr bool PERM = true, AFTER_DRAIN = false;
    bf16_t* QKV; bf16_t* Z; float* AB;
    __device__ __forceinline__ void operator()(const f32x4 (&acc)[2][2][4][2], const Unit& u, int wr, int wc, int fr, int fq) const {
        const int row0 = u.pm * BM + wr * 64 + fr, cin = wc * 32 + 8 * fq;
        if (u.pn < 32) {
#pragma unroll
            for (int bj = 0; bj < 2; ++bj) { const int kh = u.pn < 16 ? 2 * (u.pn & 7) + bj : u.pn - 16, dcol = (u.pn < 8 ? 0 : (u.pn < 16 ? 128 : 256 + bj * HALF)) + cin;
                bf16_t* base = QKV + (size_t)kh * 6144 * 512 + dcol;
#pragma unroll
                for (int ai = 0; ai < 2; ++ai)
#pragma unroll
                    for (int m = 0; m < 4; ++m) *(u32x4*)(base + (size_t)(row0 + ai * HALF + m * 16) * 512) = pack8(acc[ai][bj][m][0], acc[ai][bj][m][1]); }
        } else if (u.pn < 48) {
            const int colt = (u.pn - 32) * BM;
#pragma unroll
            for (int ai = 0; ai < 2; ++ai)
#pragma unroll
                for (int m = 0; m < 4; ++m) { bf16_t* rowp = Z + (size_t)(row0 + ai * HALF + m * 16) * 4096 + colt + cin;
#pragma unroll
                    for (int bj = 0; bj < 2; ++bj) *(u32x4*)(rowp + bj * HALF) = pack8(acc[ai][bj][m][0], acc[ai][bj][m][1]); }
        } else {
#pragma unroll
            for (int ai = 0; ai < 2; ++ai)
#pragma unroll
                for (int m = 0; m < 4; ++m) { float* rowp = AB + (size_t)(row0 + ai * HALF + m * 16) * 128 + cin;
                    *(f32x4*)(rowp) = acc[ai][0][m][0]; *(f32x4*)(rowp + 4) = acc[ai][0][m][1]; }
        }
    }
};
struct EpiRes {
    static constexpr bool PERM = false, AFTER_DRAIN = false;
    float* X; const float* gate;
    __device__ __forceinline__ void operator()(const f32x4 (&acc)[2][2][4][2], const Unit& u, int wr, int wc, int fr, int fq) const {
        const int cond = u.pm < 16 ? 0 : (u.pm < 20 ? 1 : 2);
        const int row0 = u.pm * BM + wr * 64 + fr, col0 = u.pn * BM + wc * 32 + 4 * fq;
        const float* gp = gate + cond * 12288 + col0;
        f32x4 gv[2][2];
#pragma unroll
        for (int bj = 0; bj < 2; ++bj)
#pragma unroll
            for (int n = 0; n < 2; ++n) gv[bj][n] = *(const f32x4*)(gp + bj * HALF + n * 16);
#pragma unroll
        for (int ai = 0; ai < 2; ++ai)
#pragma unroll
            for (int m = 0; m < 4; ++m) { float* xp = X + (size_t)(row0 + ai * HALF + m * 16) * 2048 + col0;
#pragma unroll
                for (int bj = 0; bj < 2; ++bj)
#pragma unroll
                    for (int n = 0; n < 2; ++n) { f32x4 x = *(const f32x4*)(xp + bj * HALF + n * 16); x = x + gv[bj][n] * acc[ai][bj][m][n]; *(f32x4*)(xp + bj * HALF + n * 16) = x; } }
    }
};
template <int ACT> struct EpiAct {
    static constexpr bool PERM = true, AFTER_DRAIN = false;
    bf16_t* H; const float* bias; float* stats;
    __device__ __forceinline__ void operator()(const f32x4 (&acc)[2][2][4][2], const Unit& u, int wr, int wc, int fr, int fq) const {
        const int row0 = u.pm * BM + wr * 64 + fr, col0 = u.pn * BM + wc * 32 + 8 * fq;
        f32x4 bv[2][2];
#pragma unroll
        for (int bj = 0; bj < 2; ++bj)
#pragma unroll
            for (int n = 0; n < 2; ++n) bv[bj][n] = (ACT == 1) ? *(const f32x4*)(bias + col0 + bj * HALF + 4 * n) : (f32x4){0.f, 0.f, 0.f, 0.f};
#pragma unroll
        for (int ai = 0; ai < 2; ++ai)
#pragma unroll
            for (int m = 0; m < 4; ++m) { const int row = row0 + ai * HALF + m * 16; bf16_t* rowp = H + (size_t)row * 8192 + col0; float s1 = 0.f, s2 = 0.f;
#pragma unroll
                for (int bj = 0; bj < 2; ++bj) { f32x4 v0 = acc[ai][bj][m][0] + bv[bj][0], v1 = acc[ai][bj][m][1] + bv[bj][1];
#pragma unroll
                    for (int e = 0; e < 4; ++e) {
                        if (ACT == 0) { const float a = fmaxf(v0[e], 0.f), b = fmaxf(v1[e], 0.f); v0[e] = a * a; v1[e] = b * b; }
                        else { v0[e] = gelu_tanh(v0[e]); v1[e] = gelu_tanh(v1[e]); s1 += v0[e] + v1[e]; s2 += v0[e] * v0[e] + v1[e] * v1[e]; } }
                    *(u32x4*)(rowp + bj * HALF) = pack8(v0, v1); }
                if (ACT == 1) { if (u.pn >= 16) { s1 += __shfl_xor(s1, 16); s1 += __shfl_xor(s1, 32); s2 += __shfl_xor(s2, 16); s2 += __shfl_xor(s2, 32);
                    if (fq == 0) { typedef float f32x2 __attribute__((ext_vector_type(2))); *(f32x2*)(stats + (size_t)row * 128 + ((u.pn - 16) * 4 + wc) * 2) = (f32x2){s1, s2}; } } }
            }
    }
};

template <class Epi, class Sched, bool ALIGN_EPI = false, bool SP2 = false>
__device__ __forceinline__ void gemm_phase(PG8_LAS unsigned char* lds, const Gemm g, const Sched& S, const Epi& E) {
    const int tid = threadIdx.x, wid = __builtin_amdgcn_readfirstlane(tid >> 6), lane = tid & 63, wr = wid >> 2, wc = wid & 3, fr = lane & 15, fq = lane >> 4;
    const int K = g.K, nt = K / BK;
    unsigned voffA[2], voffB[2];
#pragma unroll
    for (int i = 0; i < 2; ++i) { int R, C; stage_rc(tid * 16 + i * 8192, R, C); const int Rb = Epi::PERM ? ((R & ~31) + perm32(R & 31)) : R;
        voffA[i] = (unsigned)(R * K + C) * 2u; voffB[i] = (unsigned)(Rb * K + C) * 2u; }
    const size_t kstep = (size_t)(BK * 2);
    const size_t hstep = (size_t)HALF * K * 2;
    const size_t tstep = 2 * hstep;
    const unsigned ldsw = (unsigned)wid * 1024u;
    const int aoff = lds_byte(wr * 64 + fr, fq * 8), boff = lds_byte(wc * 32 + fr, fq * 8);
#define PG8_SA(b, h) (((b) * 2 + (h)) * HTB)
#define PG8_SB(b, h) ((4 + (b) * 2 + (h)) * HTB)
#define PG8_STAGE(bufoff, gbase, voff) do { _Pragma("unroll") for (int _i = 0; _i < 2; ++_i) \
        __builtin_amdgcn_global_load_lds((const unsigned*)((const char*)(gbase) + (voff)[_i]), (PG8_LAS unsigned*)(lds + (bufoff) + ldsw + _i * 8192), 16, 0, 0); } while (0)
#define PG8_LDA(dst, b, h) do { _Pragma("unroll") for (int m = 0; m < 4; ++m) _Pragma("unroll") for (int k = 0; k < 2; ++k) dst[m][k] = *(const PG8_LAS bf16x8*)(lds + PG8_SA(b, h) + aoff + m * 2048 + k * 1024); } while (0)
#define PG8_LDB(dst, b, h) do { _Pragma("unroll") for (int n = 0; n < 2; ++n) _Pragma("unroll") for (int k = 0; k < 2; ++k) dst[n][k] = *(const PG8_LAS bf16x8*)(lds + PG8_SB(b, h) + boff + n * 2048 + k * 1024); } while (0)
#define PG8_MMA(ai, bj, At, Bt) do { __builtin_amdgcn_s_setprio(1); _Pragma("unroll") for (int m = 0; m < 4; ++m) _Pragma("unroll") for (int n = 0; n < 2; ++n) _Pragma("unroll") for (int k = 0; k < 2; ++k) \
        acc[ai][bj][m][n] = __builtin_amdgcn_mfma_f32_16x16x32_bf16(Bt[n][k], At[m][k], acc[ai][bj][m][n], 0, 0, 0); __builtin_amdgcn_s_setprio(0); } while (0)
#define PG8_WAIT_V(n) asm volatile("s_waitcnt vmcnt(" #n ")" ::: "memory")
#define PG8_WAIT_L(n) asm volatile("s_waitcnt lgkmcnt(" #n ")" ::: "memory")
#define PG8_BAR __builtin_amdgcn_s_barrier()
#define PG8_SCHED __builtin_amdgcn_sched_barrier(0)
    Unit cur, nxt; int ui = 0;
    if (!S.next(0, cur)) return;
    f32x4 acc[2][2][4][2];
#pragma unroll
    for (int a = 0; a < 2; ++a)
#pragma unroll
        for (int b = 0; b < 2; ++b)
#pragma unroll
            for (int m = 0; m < 4; ++m)
#pragma unroll
                for (int n = 0; n < 2; ++n) acc[a][b][m][n] = (f32x4){0.f, 0.f, 0.f, 0.f};
    bf16x8 At[4][2], B0[2][2], B1[2][2];
    const char* cA = (const char*)g.A + (size_t)cur.pm * tstep; const char* cB = (const char*)g.Bt + (size_t)cur.pn * tstep;
    S.a_ready(cur);
    if constexpr (SP2) {
        PG8_STAGE(PG8_SB(0, 0), cB, voffB); PG8_STAGE(PG8_SB(0, 1), cB + hstep, voffB); PG8_STAGE(PG8_SA(0, 0), cA, voffA); PG8_STAGE(PG8_SA(0, 1), cA + hstep, voffA);
        if (wr == 1) PG8_BAR;
        PG8_WAIT_V(2); PG8_BAR;
        PG8_STAGE(PG8_SB(1, 0), cB + kstep, voffB); PG8_STAGE(PG8_SA(1, 0), cA + kstep, voffA); PG8_STAGE(PG8_SB(1, 1), cB + hstep + kstep, voffB);
        PG8_WAIT_V(6); PG8_BAR;
    } else {
        PG8_STAGE(PG8_SB(0, 0), cB, voffB); PG8_STAGE(PG8_SA(0, 0), cA, voffA); PG8_STAGE(PG8_SB(0, 1), cB + hstep, voffB); PG8_STAGE(PG8_SA(0, 1), cA + hstep, voffA);
        if (wr == 1) PG8_BAR;
        PG8_WAIT_V(4); PG8_BAR;
        PG8_STAGE(PG8_SB(1, 0), cB + kstep, voffB); PG8_STAGE(PG8_SA(1, 0), cA + kstep, voffA); PG8_STAGE(PG8_SB(1, 1), cB + hstep + kstep, voffB);
        PG8_WAIT_V(6); PG8_BAR;
    }
    for (;;) {
        const bool has_next = S.next(ui + 1, nxt);
        const char* nA = has_next ? (const char*)g.A + (size_t)nxt.pm * tstep : cA; const char* nB = has_next ? (const char*)g.Bt + (size_t)nxt.pn * tstep : cB;
        for (int t = 0; t < nt; t += 2) {
            const bool last = (t == nt - 2);
            const char* a1 = cA + (size_t)(t + 1) * kstep;
            const char* a2 = last ? nA : cA + (size_t)(t + 2) * kstep; const char* b2 = last ? nB : cB + (size_t)(t + 2) * kstep;
            const char* a3 = a2 + kstep; const char* b3 = b2 + kstep;
            if (last && has_next) S.a_ready(nxt);
            if constexpr (SP2) {
            PG8_LDB(B0, 0, 0); PG8_LDB(B1, 0, 1); PG8_SCHED; PG8_LDA(At, 0, 0); PG8_STAGE(PG8_SA(1, 1), a1 + hstep, voffA);
            PG8_WAIT_V(8); PG8_WAIT_L(0); PG8_BAR; PG8_MMA(0, 0, At, B0); PG8_MMA(0, 1, At, B1); PG8_BAR; PG8_SCHED;
            PG8_LDA(At, 0, 1); PG8_STAGE(PG8_SB(0, 0), b2, voffB); PG8_STAGE(PG8_SB(0, 1), b2 + hstep, voffB); PG8_STAGE(PG8_SA(0, 0), a2, voffA);
            PG8_WAIT_V(8); PG8_WAIT_L(0); PG8_BAR; PG8_MMA(1, 0, At, B0); PG8_MMA(1, 1, At, B1); PG8_BAR; PG8_SCHED;
            PG8_LDB(B0, 1, 0); PG8_LDB(B1, 1, 1); PG8_SCHED; PG8_LDA(At, 1, 0); PG8_STAGE(PG8_SA(0, 1), a2 + hstep, voffA);
            PG8_WAIT_V(8); PG8_WAIT_L(0); PG8_BAR; PG8_MMA(0, 0, At, B0); PG8_MMA(0, 1, At, B1); PG8_BAR; PG8_SCHED;
            PG8_LDA(At, 1, 1); PG8_STAGE(PG8_SB(1, 0), b3, voffB); PG8_STAGE(PG8_SB(1, 1), b3 + hstep, voffB); PG8_STAGE(PG8_SA(1, 0), a3, voffA);
            PG8_WAIT_V(8); PG8_WAIT_L(0); PG8_BAR; PG8_MMA(1, 0, At, B0); PG8_MMA(1, 1, At, B1); PG8_BAR; PG8_SCHED;
            } else {
            PG8_LDB(B0, 0, 0); PG8_SCHED; PG8_LDA(At, 0, 0); PG8_STAGE(PG8_SA(1, 1), a1 + hstep, voffA);
            PG8_WAIT_L(8); PG8_BAR; PG8_WAIT_L(0); PG8_MMA(0, 0, At, B0); PG8_BAR; PG8_SCHED;
            PG8_LDB(B1, 0, 1); PG8_STAGE(PG8_SB(0, 0), b2, voffB);
            PG8_BAR; PG8_WAIT_L(0); PG8_MMA(0, 1, At, B1); PG8_BAR;
            PG8_LDA(At, 0, 1); PG8_STAGE(PG8_SA(0, 0), a2, voffA);
            PG8_BAR; PG8_WAIT_L(0); PG8_MMA(1, 0, At, B0); PG8_BAR; PG8_SCHED;
            PG8_STAGE(PG8_SB(0, 1), b2 + hstep, voffB);
            PG8_WAIT_V(6); PG8_BAR; PG8_MMA(1, 1, At, B1); PG8_BAR;
            PG8_LDB(B0, 1, 0); PG8_SCHED; PG8_LDA(At, 1, 0); PG8_STAGE(PG8_SA(0, 1), a2 + hstep, voffA);
            PG8_WAIT_L(8); PG8_BAR; PG8_WAIT_L(0); PG8_MMA(0, 0, At, B0); PG8_BAR; PG8_SCHED;
            PG8_LDB(B1, 1, 1); PG8_STAGE(PG8_SB(1, 0), b3, voffB);
            PG8_BAR; PG8_WAIT_L(0); PG8_MMA(0, 1, At, B1); PG8_BAR;
            PG8_LDA(At, 1, 1); PG8_STAGE(PG8_SA(1, 0), a3, voffA);
            PG8_BAR; PG8_WAIT_L(0); PG8_MMA(1, 0, At, B0); PG8_BAR; PG8_SCHED;
            PG8_STAGE(PG8_SB(1, 1), b3 + hstep, voffB);
            PG8_WAIT_V(6); PG8_BAR; PG8_MMA(1, 1, At, B1); PG8_BAR;
            }
        }
        if constexpr (ALIGN_EPI) { if (wr == 0) PG8_BAR; }
        if constexpr (!Epi::AFTER_DRAIN) { E(acc, cur, wr, wc, fr, fq); S.done(cur); }
        if (!has_next) break;
#pragma unroll
        for (int a = 0; a < 2; ++a)
#pragma unroll
            for (int b = 0; b < 2; ++b)
#pragma unroll
                for (int m = 0; m < 4; ++m)
#pragma unroll
                    for (int n = 0; n < 2; ++n) acc[a][b][m][n] = (f32x4){0.f, 0.f, 0.f, 0.f};
        cur = nxt; cA = nA; cB = nB; ++ui;
        if constexpr (ALIGN_EPI) { if (wr == 1) PG8_BAR; }
    }
    PG8_WAIT_V(0);
    if constexpr (!ALIGN_EPI) { if (wr == 0) PG8_BAR; }
    PG8_BAR;
    if constexpr (Epi::AFTER_DRAIN) { E.fused(acc, cur, wr, wc, fr, fq, lds, wid, lane); S.done(cur); }
#undef PG8_SA
#undef PG8_SB
#undef PG8_STAGE
#undef PG8_LDA
#undef PG8_LDB
#undef PG8_MMA
#undef PG8_WAIT_V
#undef PG8_WAIT_L
#undef PG8_BAR
#undef PG8_SCHED
}
}
#define LAS __attribute__((address_space(3)))
typedef unsigned short bf16;
typedef unsigned v4u __attribute__((ext_vector_type(4)));
typedef unsigned v2u __attribute__((ext_vector_type(2)));
typedef float f32x4 __attribute__((ext_vector_type(4)));
typedef float f32x2 __attribute__((ext_vector_type(2)));
typedef float f32x16 __attribute__((ext_vector_type(16)));
typedef short bf16x8 __attribute__((ext_vector_type(8)));

constexpr int NWAVES = 8;
constexpr int DM = 2048, MROWS = 6144;
constexpr int NPROJ = 12416, NPROJ_PAD = 12544;
constexpr int LDS_BYTES = 147456;
constexpr size_t MiB = 1u << 20;
constexpr size_t WS_CTL = 0, WS_MOD = 1 * MiB, WS_AB = 2 * MiB, WS_STATS = 6 * MiB, WS_VEC = 10 * MiB;
constexpr size_t WS_WIN = 16 * MiB, WS_WOUT = 65 * MiB, WS_WCMIN = 81 * MiB, WS_WCMOUT = 113 * MiB, WS_WFF1 = 129 * MiB, WS_WFF2 = 193 * MiB, WS_WSB = 257 * MiB;
constexpr size_t WS_X = 258 * MiB, WS_XN = 306 * MiB, WS_QKV = 330 * MiB  , WS_Z = 426 * MiB  ;
constexpr size_t WS_KA = 474 * MiB  , WS_QA = 498 * MiB, WS_KT = 522 * MiB, WS_VT = 546 * MiB, WS_TB = 594 * MiB, WS_IN = 642 * MiB, WS_END = 690 * MiB;
constexpr size_t OUT_SF = (size_t)MROWS * DM, OUT_SB = OUT_SF + (size_t)16 * 32 * 128 * 128;

struct Params { const float* in[26]; float* out; unsigned char* ws; int ph_lo, ph_hi, flags, pad; };

__device__ __forceinline__ unsigned f2bf(float f) { unsigned u = __builtin_bit_cast(unsigned, f); return (u + 0x7fffu + ((u >> 16) & 1u)) >> 16; }
__device__ __forceinline__ unsigned pk2(float lo, float hi) { return pg8::cvt_pk_bf16(lo, hi); }
__device__ __forceinline__ float bflo(unsigned u) { return __builtin_bit_cast(float, u << 16); }
__device__ __forceinline__ float bfhi(unsigned u) { return __builtin_bit_cast(float, u & 0xffff0000u); }
__device__ __forceinline__ float bf2f(bf16 b) { return __builtin_bit_cast(float, (unsigned)b << 16); }
__device__ __forceinline__ float wave_sum(float v) {
#pragma unroll
    for (int o = 1; o < 64; o <<= 1) v += __shfl_xor(v, o);
    return v;
}
__device__ __forceinline__ float silu_f(float x) { return x * __builtin_amdgcn_rcpf(1.0f + __expf(-x)); }
#define LDS_WAIT() asm volatile("s_waitcnt lgkmcnt(0)" ::: "memory")
#define LDS_BAR() asm volatile("s_waitcnt lgkmcnt(0)\n\ts_barrier" ::: "memory")

__device__ __forceinline__ void transpose_item(const float* W, int K, int N, bf16* WT, LAS float* scr, int item, int lane) {
    const int nblk = N >> 6, kb = item / nblk, nb = item - kb * nblk, k0 = kb * 64, n0 = nb * 64;
    const float* src = W + (size_t)k0 * N + n0 + lane;
    float v[64];
#pragma unroll
    for (int i = 0; i < 64; ++i) v[i] = src[(size_t)i * N];
#pragma unroll
    for (int i = 0; i < 64; ++i) scr[i * 65 + lane] = v[i];
    LDS_WAIT();
    const int c = lane & 7;
#pragma unroll
    for (int j = 0; j < 8; ++j) { const int n = (lane >> 3) + 8 * j; const LAS float* s = scr + (8 * c) * 65 + n;
        v4u o; o.x = pk2(s[0 * 65], s[1 * 65]); o.y = pk2(s[2 * 65], s[3 * 65]); o.z = pk2(s[4 * 65], s[5 * 65]); o.w = pk2(s[6 * 65], s[7 * 65]);
        *(v4u*)(WT + (size_t)(n0 + n) * K + k0 + 8 * c) = o; }
    LDS_WAIT();
}
__device__ __forceinline__ void convert_items(const Params& p, LAS unsigned char* lds, int lo, int hi, int worker, int nworkers, int wave, int lane) {
    unsigned char* ws = p.ws;
    LAS float* scr = (LAS float*)(lds + wave * 16640);
    constexpr int I0 = 32 * 194, I1 = 64 * 32, I2 = 32 * 128, I3 = 64 * 32, I4 = 32 * 128, I6 = 128 * 32;
    for (int it = lo + worker; it < hi; it += nworkers) {
        int r = it;
        if (r < I0) { transpose_item(p.in[10], 2048, NPROJ, (bf16*)(ws + WS_WIN), scr, r, lane); continue; } r -= I0;
        if (r < I1) { transpose_item(p.in[15], 4096, 2048, (bf16*)(ws + WS_WOUT), scr, r, lane); continue; } r -= I1;
        if (r < I2) { transpose_item(p.in[16], 2048, 8192, (bf16*)(ws + WS_WCMIN), scr, r, lane); continue; } r -= I2;
        if (r < I3) { transpose_item(p.in[22], 4096, 2048, (bf16*)(ws + WS_WCMOUT), scr, r, lane); continue; } r -= I3;
        if (r < 2 * I4) { const int l = r / I4; transpose_item(p.in[23] + (size_t)l * 2048 * 8192, 2048, 8192, (bf16*)(ws + WS_WFF1) + (size_t)l * 2048 * 8192, scr, r - l * I4, lane); continue; } r -= 2 * I4;
        { const int l = r / I6; transpose_item(p.in[24] + (size_t)l * 2048 * 8192, 8192, 2048, (bf16*)(ws + WS_WFF2) + (size_t)l * 2048 * 8192, scr, r - l * I6, lane); }
    }
}
__device__ __forceinline__ void phase_prologue(const Params& p, LAS unsigned char* lds, int tid, int lane, int wave, int vcu, int G) {
    unsigned char* ws = p.ws;
    {
        LAS float* sc = (LAS float*)lds; LAS float* red = sc + 3 * 2048;
        for (int i = tid; i < 3 * 2048; i += 512) { const int cnd = i >> 11, k = i & 2047; const float x = cnd == 0 ? p.in[5][k] : p.in[4][(cnd - 1) * 2048 + k]; sc[i] = silu_f(x); }
        __syncthreads();
        float* MOD = (float*)(ws + WS_MOD);
        for (int strip = vcu; strip < 256; strip += G) {
            const int l = strip >> 7, n0 = (strip & 127) * 96;
            if (tid < 504) {
                const int cl = tid % 24, g = tid / 24;
                const float* W = p.in[8] + (size_t)l * 2048 * 12288 + n0 + 4 * cl;
                f32x4 a0 = {0.f, 0.f, 0.f, 0.f}, a1 = a0, a2 = a0;
#pragma unroll 14
                for (int k = g; k < 2048; k += 21) { const f32x4 w = *(const f32x4*)(W + (size_t)k * 12288); a0 += w * sc[k]; a1 += w * sc[2048 + k]; a2 += w * sc[4096 + k]; }
                LAS float* r = red + g * 288 + 4 * cl;
                *(LAS f32x4*)(r) = a0; *(LAS f32x4*)(r + 96) = a1; *(LAS f32x4*)(r + 192) = a2;
            }
            __syncthreads();
            if (tid < 288) { float s = 0.f;
#pragma unroll
                for (int g = 0; g < 21; ++g) s += red[g * 288 + tid];
                const int cnd = tid / 96, c = tid % 96; MOD[(l * 3 + cnd) * 12288 + n0 + c] = s + p.in[9][l * 12288 + n0 + c]; }
            __syncthreads();
        }
    }
    {
        const int gw = vcu * NWAVES + wave, NGW = G * NWAVES;
        if (G == 256) { convert_items(p, lds, 0, 8256, gw, NGW, wave, lane); convert_items(p, lds, 14400, 18496, gw, NGW, wave, lane); }
        else convert_items(p, lds, 0, 30784, gw, NGW, wave, lane);
    }
    {
        const int gt = vcu * 512 + tid, NT = G * 512;
        const float* wsf = p.in[20]; v4u* dst = (v4u*)(ws + WS_WSB);
        for (int i = gt; i < 32768; i += NT) { const f32x4 a = *(const f32x4*)(wsf + 8 * i), b = *(const f32x4*)(wsf + 8 * i + 4); v4u o; o.x = pk2(a[0], a[1]); o.y = pk2(a[2], a[3]); o.z = pk2(b[0], b[1]); o.w = pk2(b[2], b[3]); dst[i] = o; }
        v4u* pad = (v4u*)((bf16*)(ws + WS_WIN) + (size_t)NPROJ * 2048);
        for (int i = gt; i < 32768; i += NT) pad[i] = (v4u){0u, 0u, 0u, 0u};
    }
}

template <int MODE>
__device__ __forceinline__ void phase_norm(const Params& p, int layer, int which, int lane, int wave, int vcu, int G) {
    unsigned char* ws = p.ws; float* X = (float*)(ws + WS_X); bf16* XN = (bf16*)(ws + WS_XN); const float* MOD = (const float*)(ws + WS_MOD);
    const int gw = vcu * NWAVES + wave, NGW = G * NWAVES;
    for (int row = gw; row < MROWS; row += NGW) {
        f32x4 v[8];
        const float* src = MODE == 0 ? (row < 4096 ? p.in[0] + (size_t)row * DM : p.in[1] + (size_t)(row - 4096) * DM) : X + (size_t)row * DM;
#pragma unroll
        for (int j = 0; j < 8; ++j) v[j] = *(const f32x4*)(src + 4 * (lane + 64 * j));
        if (MODE == 0) {
            if (row >= 4096) {
                const int pos = (row - 4096) & 1023; const float gr = (float)(pos >> 6), gc = (float)(pos & 63);
#pragma unroll
                for (int j = 0; j < 8; ++j) { const float base = (j >> 1) < 2 ? gr : gc;
#pragma unroll
                    for (int e = 0; e < 4; ++e) { const int i = (4 * (lane + 64 * j) + e) & 511; const float fr = expf(-(float)i * (9.210340371976184f / 512.0f)); const float ang = base * fr;
                        v[j][e] += ((j >> 1) & 1) ? cosf(ang) : sinf(ang); } }
            }
#pragma unroll
            for (int j = 0; j < 8; ++j) *(f32x4*)(X + (size_t)row * DM + 4 * (lane + 64 * j)) = v[j];
        }
        float ss = 0.f;
#pragma unroll
        for (int j = 0; j < 8; ++j) ss += (v[j][0] * v[j][0] + v[j][1] * v[j][1]) + (v[j][2] * v[j][2] + v[j][3] * v[j][3]);
        ss = wave_sum(ss);
        const float r = 1.0f / sqrtf(ss * (1.0f / DM) + 1e-6f);
        if (MODE == 2) {
#pragma unroll
            for (int j = 0; j < 8; ++j) { const f32x4 w = *(const f32x4*)(p.in[25] + 4 * (lane + 64 * j)); f32x4 y = v[j] * r * w;
#ifdef PROBE_A_LO
                { const unsigned long long* TS = (const unsigned long long*)(ws + WS_CTL + 1024);
                  const float ta = (float)(long long)(__hip_atomic_load(TS + PROBE_A_HI, __ATOMIC_RELAXED, __HIP_MEMORY_SCOPE_AGENT) - __hip_atomic_load(TS + PROBE_A_LO, __ATOMIC_RELAXED, __HIP_MEMORY_SCOPE_AGENT)) * 0.01f;
                  const float tb = (float)(long long)(__hip_atomic_load(TS + PROBE_B_HI, __ATOMIC_RELAXED, __HIP_MEMORY_SCOPE_AGENT) - __hip_atomic_load(TS + PROBE_B_LO, __ATOMIC_RELAXED, __HIP_MEMORY_SCOPE_AGENT)) * 0.01f;
                  if (row < 4096) y = y * (1.0f + ta * 1e-4f);
                  if (row == 4096 && j == 0 && lane == 0) y[0] += tb * 0.01f; }
#endif
                *(f32x4*)(p.out + (size_t)row * DM + 4 * (lane + 64 * j)) = y; }
        } else {
            const int cond = row < 4096 ? 0 : (row < 5120 ? 1 : 2);
            const float* nw = p.in[which ? 7 : 6] + layer * DM; const float* mb = MOD + (size_t)(layer * 3 + cond) * 12288 + (which ? 6144 : 0);
#pragma unroll
            for (int j = 0; j < 8; ++j) { const int c = 4 * (lane + 64 * j); const f32x4 w = *(const f32x4*)(nw + c), sh = *(const f32x4*)(mb + c), sc = *(const f32x4*)(mb + 2048 + c);
                const f32x4 y = v[j] * r * w * (sc + 1.0f) + sh; v2u o; o.x = pk2(y[0], y[1]); o.y = pk2(y[2], y[3]); *(v2u*)(XN + (size_t)row * DM + c) = o; }
        }
    }
}

__device__ __forceinline__ bf16x8 as_frag(const v4u v) { return __builtin_bit_cast(bf16x8, v); }
__device__ __forceinline__ v4u pack8f(const f32x4 a, const f32x4 b) { v4u o; o.x = pk2(a[0], a[1]); o.y = pk2(a[2], a[3]); o.z = pk2(b[0], b[1]); o.w = pk2(b[2], b[3]); return o; }
#define MFMA16(a, b, c) __builtin_amdgcn_mfma_f32_16x16x32_bf16((a), (b), (c), 0, 0, 0)

#define INV_LD(i, j) (*(const LAS f32x4*)(As + (i) * 68 + 4 * (j)))
#define INV_SB() __builtin_amdgcn_sched_barrier(0)
__device__ __forceinline__ void tri_inverse_64(LAS float* As, const int lane) {
    f32x4 pa0, pa1, pa2, pa3, pa4, pa5, pa6, pa7, pb0, pb1, pb2, pb3, pb4, pb5, pb6, pb7, l0, l1, l2, l3, l4, l5, l6, l7;
    float x0, x1, x2, x3, x4, x5, x6, x7, x8, x9, x10, x11, x12, x13, x14, x15, x16, x17, x18, x19, x20, x21, x22, x23, x24, x25, x26, x27, x28, x29, x30, x31, x32, x33, x34, x35, x36, x37, x38, x39, x40, x41, x42, x43, x44, x45, x46, x47, x48, x49, x50, x51, x52, x53, x54, x55, x56, x57, x58, x59, x60, x61, x62, x63;
    { int li = lane; asm volatile("" : "+v"(li)); x0 = (li == 0) ? 1.f : 0.f; }
    pb0 = INV_LD(1, 0);
    pa0 = INV_LD(2, 0); INV_SB();
    { int li = lane; asm volatile("" : "+v"(li)); float a0 = (li == 1) ? 1.f : 0.f, a1 = 0.f, a2 = 0.f, a3 = 0.f; a0 -= pb0[0] * x0; x1 = (a0 + a1) + (a2 + a3); } INV_SB();
    pb0 = INV_LD(3, 0); INV_SB();
    { int li = lane; asm volatile("" : "+v"(li)); float a0 = (li == 2) ? 1.f : 0.f, a1 = 0.f, a2 = 0.f, a3 = 0.f; a0 -= pa0[0] * x0; a1 -= pa0[1] * x1; x2 = (a0 + a1) + (a2 + a3); } INV_SB();
    pa0 = INV_LD(4, 0); INV_SB();
    { int li = lane; asm volatile("" : "+v"(li)); float a0 = (li == 3) ? 1.f : 0.f, a1 = 0.f, a2 = 0.f, a3 = 0.f; a0 -= pb0[0] * x0; a1 -= pb0[1] * x1; a2 -= pb0[2] * x2; x3 = (a0 + a1) + (a2 + a3); } INV_SB();
    pb0 = INV_LD(5, 0); pb1 = INV_LD(5, 1); INV_SB();
    { int li = lane; asm volatile("" : "+v"(li)); float a0 = (li == 4) ? 1.f : 0.f, a1 = 0.f, a2 = 0.f, a3 = 0.f; a0 -= pa0[0] * x0; a1 -= pa0[1] * x1; a2 -= pa0[2] * x2; a3 -= pa0[3] * x3; x4 = (a0 + a1) + (a2 + a3); } INV_SB();
    pa0 = INV_LD(6, 0); pa1 = INV_LD(6, 1); INV_SB();
    { int li = lane; asm volatile("" : "+v"(li)); float a0 = (li == 5) ? 1.f : 0.f, a1 = 0.f, a2 = 0.f, a3 = 0.f; a0 -= pb0[0] * x0; a1 -= pb0[1] * x1; a2 -= pb0[2] * x2; a3 -= pb0[3] * x3; a0 -= pb1[0] * x4; x5 = (a0 + a1) + (a2 + a3); } INV_SB();
    pb0 = INV_LD(7, 0); pb1 = INV_LD(7, 1); INV_SB();
    { int li = lane; asm volatile("" : "+v"(li)); float a0 = (li == 6) ? 1.f : 0.f, a1 = 0.f, a2 = 0.f, a3 = 0.f; a0 -= pa0[0] * x0; a1 -= pa0[1] * x1; a2 -= pa0[2] * x2; a3 -= pa0[3] * x3; a0 -= pa1[0] * x4; a1 -= pa1[1] * x5; x6 = (a0 + a1) + (a2 + a3); } INV_SB();
    pa0 = INV_LD(8, 0); pa1 = INV_LD(8, 1); INV_SB();
    { int li = lane; asm volatile("" : "+v"(li)); float a0 = (li == 7) ? 1.f : 0.f, a1 = 0.f, a2 = 0.f, a3 = 0.f; a0 -= pb0[0] * x0; a1 -= pb0[1] * x1; a2 -= pb0[2] * x2; a3 -= pb0[3] * x3; a0 -= pb1[0] * x4; a1 -= pb1[1] * x5; a2 -= pb1[2] * x6; x7 = (a0 + a1) + (a2 + a3); } INV_SB();
    pb0 = INV_LD(9, 0); pb1 = INV_LD(9, 1); pb2 = INV_LD(9, 2); INV_SB();
    { int li = lane; asm volatile("" : "+v"(li)); float a0 = (li == 8) ? 1.f : 0.f, a1 = 0.f, a2 = 0.f, a3 = 0.f; a0 -= pa0[0] * x0; a1 -= pa0[1] * x1; a2 -= pa0[2] * x2; a3 -= pa0[3] * x3; a0 -= pa1[0] * x4; a1 -= pa1[1] * x5; a2 -= pa1[2] * x6; a3 -= pa1[3] * x7; x8 = (a0 + a1) + (a2 + a3); } INV_SB();
    pa0 = INV_LD(10, 0); pa1 = INV_LD(10, 1); pa2 = INV_LD(10, 2); INV_SB();
    { int li = lane; asm volatile("" : "+v"(li)); float a0 = (li == 9) ? 1.f : 0.f, a1 = 0.f, a2 = 0.f, a3 = 0.f; a0 -= pb0[0] * x0; a1 -= pb0[1] * x1; a2 -= pb0[2] * x2; a3 -= pb0[3] * x3; a0 -= pb1[0] * x4; a1 -= pb1[1] * x5; a2 -= pb1[2] * x6; a3 -= pb1[3] * x7; a0 -= pb2[0] * x8; x9 = (a0 + a1) + (a2 + a3); } INV_SB();
    pb0 = INV_LD(11, 0); pb1 = INV_LD(11, 1); pb2 = INV_LD(11, 2); INV_SB();
    { int li = lane; asm volatile("" : "+v"(li)); float a0 = (li == 10) ? 1.f : 0.f, a1 = 0.f, a2 = 0.f, a3 = 0.f; a0 -= pa0[0] * x0; a1 -= pa0[1] * x1; a2 -= pa0[2] * x2; a3 -= pa0[3] * x3; a0 -= pa1[0] * x4; a1 -= pa1[1] * x5; a2 -= pa1[2] * x6; a3 -= pa1[3] * x7; a0 -= pa2[0] * x8; a1 -= pa2[1] * x9; x10 = (a0 + a1) + (a2 + a3); } INV_SB();
    pa0 = INV_LD(12, 0); pa1 = INV_LD(12, 1); pa2 = INV_LD(12, 2); INV_SB();
    { int li = lane; asm volatile("" : "+v"(li)); float a0 = (li == 11) ? 1.f : 0.f, a1 = 0.f, a2 = 0.f, a3 = 0.f; a0 -= pb0[0] * x0; a1 -= pb0[1] * x1; a2 -= pb0[2] * x2; a3 -= pb0[3] * x3; a0 -= pb1[0] * x4; a1 -= pb1[1] * x5; a2 -= pb1[2] * x6; a3 -= pb1[3] * x7; a0 -= pb2[0] * x8; a1 -= pb2[1] * x9; a2 -= pb2[2] * x10; x11 = (a0 + a1) + (a2 + a3); } INV_SB();
    pb0 = INV_LD(13, 0); pb1 = INV_LD(13, 1); pb2 = INV_LD(13, 2); pb3 = INV_LD(13, 3); INV_SB();
    { int li = lane; asm volatile("" : "+v"(li)); float a0 = (li == 12) ? 1.f : 0.f, a1 = 0.f, a2 = 0.f, a3 = 0.f; a0 -= pa0[0] * x0; a1 -= pa0[1] * x1; a2 -= pa0[2] * x2; a3 -= pa0[3] * x3; a0 -= pa1[0] * x4; a1 -= pa1[1] * x5; a2 -= pa1[2] * x6; a3 -= pa1[3] * x7; a0 -= pa2[0] * x8; a1 -= pa2[1] * x9; a2 -= pa2[2] * x10; a3 -= pa2[3] * x11; x12 = (a0 + a1) + (a2 + a3); } INV_SB();
    pa0 = INV_LD(14, 0); pa1 = INV_LD(14, 1); pa2 = INV_LD(14, 2); pa3 = INV_LD(14, 3); INV_SB();
    { int li = lane; asm volatile("" : "+v"(li)); float a0 = (li == 13) ? 1.f : 0.f, a1 = 0.f, a2 = 0.f, a3 = 0.f; a0 -= pb0[0] * x0; a1 -= pb0[1] * x1; a2 -= pb0[2] * x2; a3 -= pb0[3] * x3; a0 -= pb1[0] * x4; a1 -= pb1[1] * x5; a2 -= pb1[2] * x6; a3 -= pb1[3] * x7; a0 -= pb2[0] * x8; a1 -= pb2[1] * x9; a2 -= pb2[2] * x10; a3 -= pb2[3] * x11; a0 -= pb3[0] * x12; x13 = (a0 + a1) + (a2 + a3); } INV_SB();
    pb0 = INV_LD(15, 0); pb1 = INV_LD(15, 1); pb2 = INV_LD(15, 2); pb3 = INV_LD(15, 3); INV_SB();
    { int li = lane; asm volatile("" : "+v"(li)); float a0 = (li == 14) ? 1.f : 0.f, a1 = 0.f, a2 = 0.f, a3 = 0.f; a0 -= pa0[0] * x0; a1 -= pa0[1] * x1; a2 -= pa0[2] * x2; a3 -= pa0[3] * x3; a0 -= pa1[0] * x4; a1 -= pa1[1] * x5; a2 -= pa1[2] * x6; a3 -= pa1[3] * x7; a0 -= pa2[0] * x8; a1 -= pa2[1] * x9; a2 -= pa2[2] * x10; a3 -= pa2[3] * x11; a0 -= pa3[0] * x12; a1 -= pa3[1] * x13; x14 = (a0 + a1) + (a2 + a3); } INV_SB();
    pa0 = INV_LD(16, 0); pa1 = INV_LD(16, 1); pa2 = INV_LD(16, 2); pa3 = INV_LD(16, 3); INV_SB();
    { int li = lane; asm volatile("" : "+v"(li)); float a0 = (li == 15) ? 1.f : 0.f, a1 = 0.f, a2 = 0.f, a3 = 0.f; a0 -= pb0[0] * x0; a1 -= pb0[1] * x1; a2 -= pb0[2] * x2; a3 -= pb0[3] * x3; a0 -= pb1[0] * x4; a1 -= pb1[1] * x5; a2 -= pb1[2] * x6; a3 -= pb1[3] * x7; a0 -= pb2[0] * x8; a1 -= pb2[1] * x9; a2 -= pb2[2] * x10; a3 -= pb2[3] * x11; a0 -= pb3[0] * x12; a1 -= pb3[1] * x13; a2 -= pb3[2] * x14; x15 = (a0 + a1) + (a2 + a3); } INV_SB();
    pb0 = INV_LD(17, 0); pb1 = INV_LD(17, 1); pb2 = INV_LD(17, 2); pb3 = INV_LD(17, 3); pb4 = INV_LD(17, 4); INV_SB();
    { int li = lane; asm volatile("" : "+v"(li)); float a0 = (li == 16) ? 1.f : 0.f, a1 = 0.f, a2 = 0.f, a3 = 0.f; a0 -= pa0[0] * x0; a1 -= pa0[1] * x1; a2 -= pa0[2] * x2; a3 -= pa0[3] * x3; a0 -= pa1[0] * x4; a1 -= pa1[1] * x5; a2 -= pa1[2] * x6; a3 -= pa1[3] * x7; a0 -= pa2[0] * x8; a1 -= pa2[1] * x9; a2 -= pa2[2] * x10; a3 -= pa2[3] * x11; a0 -= pa3[0] * x12; a1 -= pa3[1] * x13; a2 -= pa3[2] * x14; a3 -= pa3[3] * x15; x16 = (a0 + a1) + (a2 + a3); } INV_SB();
    pa0 = INV_LD(18, 0); pa1 = INV_LD(18, 1); pa2 = INV_LD(18, 2); pa3 = INV_LD(18, 3); pa4 = INV_LD(18, 4); INV_SB();
    { int li = lane; asm volatile("" : "+v"(li)); float a0 = (li == 17) ? 1.f : 0.f, a1 = 0.f, a2 = 0.f, a3 = 0.f; a0 -= pb0[0] * x0; a1 -= pb0[1] * x1; a2 -= pb0[2] * x2; a3 -= pb0[3] * x3; a0 -= pb1[0] * x4; a1 -= pb1[1] * x5; a2 -= pb1[2] * x6; a3 -= pb1[3] * x7; a0 -= pb2[0] * x8; a1 -= pb2[1] * x9; a2 -= pb2[2] * x10; a3 -= pb2[3] * x11; a0 -= pb3[0] * x12; a1 -= pb3[1] * x13; a2 -= pb3[2] * x14; a3 -= pb3[3] * x15; a0 -= pb4[0] * x16; x17 = (a0 + a1) + (a2 + a3); } INV_SB();
    pb0 = INV_LD(19, 0); pb1 = INV_LD(19, 1); pb2 = INV_LD(19, 2); pb3 = INV_LD(19, 3); pb4 = INV_LD(19, 4); INV_SB();
    { int li = lane; asm volatile("" : "+v"(li)); float a0 = (li == 18) ? 1.f : 0.f, a1 = 0.f, a2 = 0.f, a3 = 0.f; a0 -= pa0[0] * x0; a1 -= pa0[1] * x1; a2 -= pa0[2] * x2; a3 -= pa0[3] * x3; a0 -= pa1[0] * x4; a1 -= pa1[1] * x5; a2 -= pa1[2] * x6; a3 -= pa1[3] * x7; a0 -= pa2[0] * x8; a1 -= pa2[1] * x9; a2 -= pa2[2] * x10; a3 -= pa2[3] * x11; a0 -= pa3[0] * x12; a1 -= pa3[1] * x13; a2 -= pa3[2] * x14; a3 -= pa3[3] * x15; a0 -= pa4[0] * x16; a1 -= pa4[1] * x17; x18 = (a0 + a1) + (a2 + a3); } INV_SB();
    pa0 = INV_LD(20, 0); pa1 = INV_LD(20, 1); pa2 = INV_LD(20, 2); pa3 = INV_LD(20, 3); pa4 = INV_LD(20, 4); INV_SB();
    { int li = lane; asm volatile("" : "+v"(li)); float a0 = (li == 19) ? 1.f : 0.f, a1 = 0.f, a2 = 0.f, a3 = 0.f; a0 -= pb0[0] * x0; a1 -= pb0[1] * x1; a2 -= pb0[2] * x2; a3 -= pb0[3] * x3; a0 -= pb1[0] * x4; a1 -= pb1[1] * x5; a2 -= pb1[2] * x6; a3 -= pb1[3] * x7; a0 -= pb2[0] * x8; a1 -= pb2[1] * x9; a2 -= pb2[2] * x10; a3 -= pb2[3] * x11; a0 -= pb3[0] * x12; a1 -= pb3[1] * x13; a2 -= pb3[2] * x14; a3 -= pb3[3] * x15; a0 -= pb4[0] * x16; a1 -= pb4[1] * x17; a2 -= pb4[2] * x18; x19 = (a0 + a1) + (a2 + a3); } INV_SB();
    pb0 = INV_LD(21, 0); pb1 = INV_LD(21, 1); pb2 = INV_LD(21, 2); pb3 = INV_LD(21, 3); pb4 = INV_LD(21, 4); pb5 = INV_LD(21, 5); INV_SB();
    { int li = lane; asm volatile("" : "+v"(li)); float a0 = (li == 20) ? 1.f : 0.f, a1 = 0.f, a2 = 0.f, a3 = 0.f; a0 -= pa0[0] * x0; a1 -= pa0[1] * x1; a2 -= pa0[2] * x2; a3 -= pa0[3] * x3; a0 -= pa1[0] * x4; a1 -= pa1[1] * x5; a2 -= pa1[2] * x6; a3 -= pa1[3] * x7; a0 -= pa2[0] * x8; a1 -= pa2[1] * x9; a2 -= pa2[2] * x10; a3 -= pa2[3] * x11; a0 -= pa3[0] * x12; a1 -= pa3[1] * x13; a2 -= pa3[2] * x14; a3 -= pa3[3] * x15; a0 -= pa4[0] * x16; a1 -= pa4[1] * x17; a2 -= pa4[2] * x18; a3 -= pa4[3] * x19; x20 = (a0 + a1) + (a2 + a3); } INV_SB();
    pa0 = INV_LD(22, 0); pa1 = INV_LD(22, 1); pa2 = INV_LD(22, 2); pa3 = INV_LD(22, 3); pa4 = INV_LD(22, 4); pa5 = INV_LD(22, 5); INV_SB();
    { int li = lane; asm volatile("" : "+v"(li)); float a0 = (li == 21) ? 1.f : 0.f, a1 = 0.f, a2 = 0.f, a3 = 0.f; a0 -= pb0[0] * x0; a1 -= pb0[1] * x1; a2 -= pb0[2] * x2; a3 -= pb0[3] * x3; a0 -= pb1[0] * x4; a1 -= pb1[1] * x5; a2 -= pb1[2] * x6; a3 -= pb1[3] * x7; a0 -= pb2[0] * x8; a1 -= pb2[1] * x9; a2 -= pb2[2] * x10; a3 -= pb2[3] * x11; a0 -= pb3[0] * x12; a1 -= pb3[1] * x13; a2 -= pb3[2] * x14; a3 -= pb3[3] * x15; a0 -= pb4[0] * x16; a1 -= pb4[1] * x17; a2 -= pb4[2] * x18; a3 -= pb4[3] * x19; a0 -= pb5[0] * x20; x21 = (a0 + a1) + (a2 + a3); } INV_SB();
    pb0 = INV_LD(23, 0); pb1 = INV_LD(23, 1); pb2 = INV_LD(23, 2); pb3 = INV_LD(23, 3); pb4 = INV_LD(23, 4); pb5 = INV_LD(23, 5); INV_SB();
    { int li = lane; asm volatile("" : "+v"(li)); float a0 = (li == 22) ? 1.f : 0.f, a1 = 0.f, a2 = 0.f, a3 = 0.f; a0 -= pa0[0] * x0; a1 -= pa0[1] * x1; a2 -= pa0[2] * x2; a3 -= pa0[3] * x3; a0 -= pa1[0] * x4; a1 -= pa1[1] * x5; a2 -= pa1[2] * x6; a3 -= pa1[3] * x7; a0 -= pa2[0] * x8; a1 -= pa2[1] * x9; a2 -= pa2[2] * x10; a3 -= pa2[3] * x11; a0 -= pa3[0] * x12; a1 -= pa3[1] * x13; a2 -= pa3[2] * x14; a3 -= pa3[3] * x15; a0 -= pa4[0] * x16; a1 -= pa4[1] * x17; a2 -= pa4[2] * x18; a3 -= pa4[3] * x19; a0 -= pa5[0] * x20; a1 -= pa5[1] * x21; x22 = (a0 + a1) + (a2 + a3); } INV_SB();
    pa0 = INV_LD(24, 0); pa1 = INV_LD(24, 1); pa2 = INV_LD(24, 2); pa3 = INV_LD(24, 3); pa4 = INV_LD(24, 4); pa5 = INV_LD(24, 5); INV_SB();
    { int li = lane; asm volatile("" : "+v"(li)); float a0 = (li == 23) ? 1.f : 0.f, a1 = 0.f, a2 = 0.f, a3 = 0.f; a0 -= pb0[0] * x0; a1 -= pb0[1] * x1; a2 -= pb0[2] * x2; a3 -= pb0[3] * x3; a0 -= pb1[0] * x4; a1 -= pb1[1] * x5; a2 -= pb1[2] * x6; a3 -= pb1[3] * x7; a0 -= pb2[0] * x8; a1 -= pb2[1] * x9; a2 -= pb2[2] * x10; a3 -= pb2[3] * x11; a0 -= pb3[0] * x12; a1 -= pb3[1] * x13; a2 -= pb3[2] * x14; a3 -= pb3[3] * x15; a0 -= pb4[0] * x16; a1 -= pb4[1] * x17; a2 -= pb4[2] * x18; a3 -= pb4[3] * x19; a0 -= pb5[0] * x20; a1 -= pb5[1] * x21; a2 -= pb5[2] * x22; x23 = (a0 + a1) + (a2 + a3); } INV_SB();
    pb0 = INV_LD(25, 0); pb1 = INV_LD(25, 1); pb2 = INV_LD(25, 2); pb3 = INV_LD(25, 3); pb4 = INV_LD(25, 4); pb5 = INV_LD(25, 5); pb6 = INV_LD(25, 6); INV_SB();
    { int li = lane; asm volatile("" : "+v"(li)); float a0 = (li == 24) ? 1.f : 0.f, a1 = 0.f, a2 = 0.f, a3 = 0.f; a0 -= pa0[0] * x0; a1 -= pa0[1] * x1; a2 -= pa0[2] * x2; a3 -= pa0[3] * x3; a0 -= pa1[0] * x4; a1 -= pa1[1] * x5; a2 -= pa1[2] * x6; a3 -= pa1[3] * x7; a0 -= pa2[0] * x8; a1 -= pa2[1] * x9; a2 -= pa2[2] * x10; a3 -= pa2[3] * x11; a0 -= pa3[0] * x12; a1 -= pa3[1] * x13; a2 -= pa3[2] * x14; a3 -= pa3[3] * x15; a0 -= pa4[0] * x16; a1 -= pa4[1] * x17; a2 -= pa4[2] * x18; a3 -= pa4[3] * x19; a0 -= pa5[0] * x20; a1 -= pa5[1] * x21; a2 -= pa5[2] * x22; a3 -= pa5[3] * x23; x24 = (a0 + a1) + (a2 + a3); } INV_SB();
    pa0 = INV_LD(26, 0); pa1 = INV_LD(26, 1); pa2 = INV_LD(26, 2); pa3 = INV_LD(26, 3); pa4 = INV_LD(26, 4); pa5 = INV_LD(26, 5); pa6 = INV_LD(26, 6); INV_SB();
    { int li = lane; asm volatile("" : "+v"(li)); float a0 = (li == 25) ? 1.f : 0.f, a1 = 0.f, a2 = 0.f, a3 = 0.f; a0 -= pb0[0] * x0; a1 -= pb0[1] * x1; a2 -= pb0[2] * x2; a3 -= pb0[3] * x3; a0 -= pb1[0] * x4; a1 -= pb1[1] * x5; a2 -= pb1[2] * x6; a3 -= pb1[3] * x7; a0 -= pb2[0] * x8; a1 -= pb2[1] * x9; a2 -= pb2[2] * x10; a3 -= pb2[3] * x11; a0 -= pb3[0] * x12; a1 -= pb3[1] * x13; a2 -= pb3[2] * x14; a3 -= pb3[3] * x15; a0 -= pb4[0] * x16; a1 -= pb4[1] * x17; a2 -= pb4[2] * x18; a3 -= pb4[3] * x19; a0 -= pb5[0] * x20; a1 -= pb5[1] * x21; a2 -= pb5[2] * x22; a3 -= pb5[3] * x23; a0 -= pb6[0] * x24; x25 = (a0 + a1) + (a2 + a3); } INV_SB();
    pb0 = INV_LD(27, 0); pb1 = INV_LD(27, 1); pb2 = INV_LD(27, 2); pb3 = INV_LD(27, 3); pb4 = INV_LD(27, 4); pb5 = INV_LD(27, 5); pb6 = INV_LD(27, 6); INV_SB();
    { int li = lane; asm volatile("" : "+v"(li)); float a0 = (li == 26) ? 1.f : 0.f, a1 = 0.f, a2 = 0.f, a3 = 0.f; a0 -= pa0[0] * x0; a1 -= pa0[1] * x1; a2 -= pa0[2] * x2; a3 -= pa0[3] * x3; a0 -= pa1[0] * x4; a1 -= pa1[1] * x5; a2 -= pa1[2] * x6; a3 -= pa1[3] * x7; a0 -= pa2[0] * x8; a1 -= pa2[1] * x9; a2 -= pa2[2] * x10; a3 -= pa2[3] * x11; a0 -= pa3[0] * x12; a1 -= pa3[1] * x13; a2 -= pa3[2] * x14; a3 -= pa3[3] * x15; a0 -= pa4[0] * x16; a1 -= pa4[1] * x17; a2 -= pa4[2] * x18; a3 -= pa4[3] * x19; a0 -= pa5[0] * x20; a1 -= pa5[1] * x21; a2 -= pa5[2] * x22; a3 -= pa5[3] * x23; a0 -= pa6[0] * x24; a1 -= pa6[1] * x25; x26 = (a0 + a1) + (a2 + a3); } INV_SB();
    pa0 = INV_LD(28, 0); pa1 = INV_LD(28, 1); pa2 = INV_LD(28, 2); pa3 = INV_LD(28, 3); pa4 = INV_LD(28, 4); pa5 = INV_LD(28, 5); pa6 = INV_LD(28, 6); INV_SB();
    { int li = lane; asm volatile("" : "+v"(li)); float a0 = (li == 27) ? 1.f : 0.f, a1 = 0.f, a2 = 0.f, a3 = 0.f; a0 -= pb0[0] * x0; a1 -= pb0[1] * x1; a2 -= pb0[2] * x2; a3 -= pb0[3] * x3; a0 -= pb1[0] * x4; a1 -= pb1[1] * x5; a2 -= pb1[2] * x6; a3 -= pb1[3] * x7; a0 -= pb2[0] * x8; a1 -= pb2[1] * x9; a2 -= pb2[2] * x10; a3 -= pb2[3] * x11; a0 -= pb3[0] * x12; a1 -= pb3[1] * x13; a2 -= pb3[2] * x14; a3 -= pb3[3] * x15; a0 -= pb4[0] * x16; a1 -= pb4[1] * x17; a2 -= pb4[2] * x18; a3 -= pb4[3] * x19; a0 -= pb5[0] * x20; a1 -= pb5[1] * x21; a2 -= pb5[2] * x22; a3 -= pb5[3] * x23; a0 -= pb6[0] * x24; a1 -= pb6[1] * x25; a2 -= pb6[2] * x26; x27 = (a0 + a1) + (a2 + a3); } INV_SB();
    pb0 = INV_LD(29, 0); pb1 = INV_LD(29, 1); pb2 = INV_LD(29, 2); pb3 = INV_LD(29, 3); pb4 = INV_LD(29, 4); pb5 = INV_LD(29, 5); pb6 = INV_LD(29, 6); pb7 = INV_LD(29, 7); INV_SB();
    { int li = lane; asm volatile("" : "+v"(li)); float a0 = (li == 28) ? 1.f : 0.f, a1 = 0.f, a2 = 0.f, a3 = 0.f; a0 -= pa0[0] * x0; a1 -= pa0[1] * x1; a2 -= pa0[2] * x2; a3 -= pa0[3] * x3; a0 -= pa1[0] * x4; a1 -= pa1[1] * x5; a2 -= pa1[2] * x6; a3 -= pa1[3] * x7; a0 -= pa2[0] * x8; a1 -= pa2[1] * x9; a2 -= pa2[2] * x10; a3 -= pa2[3] * x11; a0 -= pa3[0] * x12; a1 -= pa3[1] * x13; a2 -= pa3[2] * x14; a3 -= pa3[3] * x15; a0 -= pa4[0] * x16; a1 -= pa4[1] * x17; a2 -= pa4[2] * x18; a3 -= pa4[3] * x19; a0 -= pa5[0] * x20; a1 -= pa5[1] * x21; a2 -= pa5[2] * x22; a3 -= pa5[3] * x23; a0 -= pa6[0] * x24; a1 -= pa6[1] * x25; a2 -= pa6[2] * x26; a3 -= pa6[3] * x27; x28 = (a0 + a1) + (a2 + a3); } INV_SB();
    pa0 = INV_LD(30, 0); pa1 = INV_LD(30, 1); pa2 = INV_LD(30, 2); pa3 = INV_LD(30, 3); pa4 = INV_LD(30, 4); pa5 = INV_LD(30, 5); pa6 = INV_LD(30, 6); pa7 = INV_LD(30, 7); INV_SB();
    { int li = lane; asm volatile("" : "+v"(li)); float a0 = (li == 29) ? 1.f : 0.f, a1 = 0.f, a2 = 0.f, a3 = 0.f; a0 -= pb0[0] * x0; a1 -= pb0[1] * x1; a2 -= pb0[2] * x2; a3 -= pb0[3] * x3; a0 -= pb1[0] * x4; a1 -= pb1[1] * x5; a2 -= pb1[2] * x6; a3 -= pb1[3] * x7; a0 -= pb2[0] * x8; a1 -= pb2[1] * x9; a2 -= pb2[2] * x10; a3 -= pb2[3] * x11; a0 -= pb3[0] * x12; a1 -= pb3[1] * x13; a2 -= pb3[2] * x14; a3 -= pb3[3] * x15; a0 -= pb4[0] * x16; a1 -= pb4[1] * x17; a2 -= pb4[2] * x18; a3 -= pb4[3] * x19; a0 -= pb5[0] * x20; a1 -= pb5[1] * x21; a2 -= pb5[2] * x22; a3 -= pb5[3] * x23; a0 -= pb6[0] * x24; a1 -= pb6[1] * x25; a2 -= pb6[2] * x26; a3 -= pb6[3] * x27; a0 -= pb7[0] * x28; x29 = (a0 + a1) + (a2 + a3); } INV_SB();
    pb0 = INV_LD(31, 0); pb1 = INV_LD(31, 1); pb2 = INV_LD(31, 2); pb3 = INV_LD(31, 3); pb4 = INV_LD(31, 4); pb5 = INV_LD(31, 5); pb6 = INV_LD(31, 6); pb7 = INV_LD(31, 7); INV_SB();
    { int li = lane; asm volatile("" : "+v"(li)); float a0 = (li == 30) ? 1.f : 0.f, a1 = 0.f, a2 = 0.f, a3 = 0.f; a0 -= pa0[0] * x0; a1 -= pa0[1] * x1; a2 -= pa0[2] * x2; a3 -= pa0[3] * x3; a0 -= pa1[0] * x4; a1 -= pa1[1] * x5; a2 -= pa1[2] * x6; a3 -= pa1[3] * x7; a0 -= pa2[0] * x8; a1 -= pa2[1] * x9; a2 -= pa2[2] * x10; a3 -= pa2[3] * x11; a0 -= pa3[0] * x12; a1 -= pa3[1] * x13; a2 -= pa3[2] * x14; a3 -= pa3[3] * x15; a0 -= pa4[0] * x16; a1 -= pa4[1] * x17; a2 -= pa4[2] * x18; a3 -= pa4[3] * x19; a0 -= pa5[0] * x20; a1 -= pa5[1] * x21; a2 -= pa5[2] * x22; a3 -= pa5[3] * x23; a0 -= pa6[0] * x24; a1 -= pa6[1] * x25; a2 -= pa6[2] * x26; a3 -= pa6[3] * x27; a0 -= pa7[0] * x28; a1 -= pa7[1] * x29; x30 = (a0 + a1) + (a2 + a3); } INV_SB();
    pa0 = INV_LD(32, 0); pa1 = INV_LD(32, 1); pa2 = INV_LD(32, 2); pa3 = INV_LD(32, 3); pa4 = INV_LD(32, 4); pa5 = INV_LD(32, 5); pa6 = INV_LD(32, 6); pa7 = INV_LD(32, 7); INV_SB();
    { int li = lane; asm volatile("" : "+v"(li)); float a0 = (li == 31) ? 1.f : 0.f, a1 = 0.f, a2 = 0.f, a3 = 0.f; a0 -= pb0[0] * x0; a1 -= pb0[1] * x1; a2 -= pb0[2] * x2; a3 -= pb0[3] * x3; a0 -= pb1[0] * x4; a1 -= pb1[1] * x5; a2 -= pb1[2] * x6; a3 -= pb1[3] * x7; a0 -= pb2[0] * x8; a1 -= pb2[1] * x9; a2 -= pb2[2] * x10; a3 -= pb2[3] * x11; a0 -= pb3[0] * x12; a1 -= pb3[1] * x13; a2 -= pb3[2] * x14; a3 -= pb3[3] * x15; a0 -= pb4[0] * x16; a1 -= pb4[1] * x17; a2 -= pb4[2] * x18; a3 -= pb4[3] * x19; a0 -= pb5[0] * x20; a1 -= pb5[1] * x21; a2 -= pb5[2] * x22; a3 -= pb5[3] * x23; a0 -= pb6[0] * x24; a1 -= pb6[1] * x25; a2 -= pb6[2] * x26; a3 -= pb6[3] * x27; a0 -= pb7[0] * x28; a1 -= pb7[1] * x29; a2 -= pb7[2] * x30; x31 = (a0 + a1) + (a2 + a3); } INV_SB();
    pb0 = INV_LD(33, 0); pb1 = INV_LD(33, 1); pb2 = INV_LD(33, 2); pb3 = INV_LD(33, 3); pb4 = INV_LD(33, 4); pb5 = INV_LD(33, 5); pb6 = INV_LD(33, 6); pb7 = INV_LD(33, 7); INV_SB();
    { int li = lane; asm volatile("" : "+v"(li)); float a0 = (li == 32) ? 1.f : 0.f, a1 = 0.f, a2 = 0.f, a3 = 0.f; a0 -= pa0[0] * x0; a1 -= pa0[1] * x1; a2 -= pa0[2] * x2; a3 -= pa0[3] * x3; a0 -= pa1[0] * x4; a1 -= pa1[1] * x5; a2 -= pa1[2] * x6; a3 -= pa1[3] * x7; a0 -= pa2[0] * x8; a1 -= pa2[1] * x9; a2 -= pa2[2] * x10; a3 -= pa2[3] * x11; a0 -= pa3[0] * x12; a1 -= pa3[1] * x13; a2 -= pa3[2] * x14; a3 -= pa3[3] * x15; a0 -= pa4[0] * x16; a1 -= pa4[1] * x17; a2 -= pa4[2] * x18; a3 -= pa4[3] * x19; a0 -= pa5[0] * x20; a1 -= pa5[1] * x21; a2 -= pa5[2] * x22; a3 -= pa5[3] * x23; a0 -= pa6[0] * x24; a1 -= pa6[1] * x25; a2 -= pa6[2] * x26; a3 -= pa6[3] * x27; a0 -= pa7[0] * x28; a1 -= pa7[1] * x29; a2 -= pa7[2] * x30; a3 -= pa7[3] * x31; x32 = (a0 + a1) + (a2 + a3); } INV_SB();
    l0 = INV_LD(33, 8); pa0 = INV_LD(34, 0); pa1 = INV_LD(34, 1); pa2 = INV_LD(34, 2); pa3 = INV_LD(34, 3); pa4 = INV_LD(34, 4); pa5 = INV_LD(34, 5); pa6 = INV_LD(34, 6); pa7 = INV_LD(34, 7); INV_SB();
    { int li = lane; asm volatile("" : "+v"(li)); float a0 = (li == 33) ? 1.f : 0.f, a1 = 0.f, a2 = 0.f, a3 = 0.f; a0 -= pb0[0] * x0; a1 -= pb0[1] * x1; a2 -= pb0[2] * x2; a3 -= pb0[3] * x3; a0 -= pb1[0] * x4; a1 -= pb1[1] * x5; a2 -= pb1[2] * x6; a3 -= pb1[3] * x7; a0 -= pb2[0] * x8; a1 -= pb2[1] * x9; a2 -= pb2[2] * x10; a3 -= pb2[3] * x11; a0 -= pb3[0] * x12; a1 -= pb3[1] * x13; a2 -= pb3[2] * x14; a3 -= pb3[3] * x15; a0 -= pb4[0] * x16; a1 -= pb4[1] * x17; a2 -= pb4[2] * x18; a3 -= pb4[3] * x19; a0 -= pb5[0] * x20; a1 -= pb5[1] * x21; a2 -= pb5[2] * x22; a3 -= pb5[3] * x23; a0 -= pb6[0] * x24; a1 -= pb6[1] * x25; a2 -= pb6[2] * x26; a3 -= pb6[3] * x27; a0 -= pb7[0] * x28; a1 -= pb7[1] * x29; a2 -= pb7[2] * x30; a3 -= pb7[3] * x31; a0 -= l0[0] * x32; x33 = (a0 + a1) + (a2 + a3); } INV_SB();
    l0 = INV_LD(34, 8); pb0 = INV_LD(35, 0); pb1 = INV_LD(35, 1); pb2 = INV_LD(35, 2); pb3 = INV_LD(35, 3); pb4 = INV_LD(35, 4); pb5 = INV_LD(35, 5); pb6 = INV_LD(35, 6); pb7 = INV_LD(35, 7); INV_SB();
    { int li = lane; asm volatile("" : "+v"(li)); float a0 = (li == 34) ? 1.f : 0.f, a1 = 0.f, a2 = 0.f, a3 = 0.f; a0 -= pa0[0] * x0; a1 -= pa0[1] * x1; a2 -= pa0[2] * x2; a3 -= pa0[3] * x3; a0 -= pa1[0] * x4; a1 -= pa1[1] * x5; a2 -= pa1[2] * x6; a3 -= pa1[3] * x7; a0 -= pa2[0] * x8; a1 -= pa2[1] * x9; a2 -= pa2[2] * x10; a3 -= pa2[3] * x11; a0 -= pa3[0] * x12; a1 -= pa3[1] * x13; a2 -= pa3[2] * x14; a3 -= pa3[3] * x15; a0 -= pa4[0] * x16; a1 -= pa4[1] * x17; a2 -= pa4[2] * x18; a3 -= pa4[3] * x19; a0 -= pa5[0] * x20; a1 -= pa5[1] * x21; a2 -= pa5[2] * x22; a3 -= pa5[3] * x23; a0 -= pa6[0] * x24; a1 -= pa6[1] * x25; a2 -= pa6[2] * x26; a3 -= pa6[3] * x27; a0 -= pa7[0] * x28; a1 -= pa7[1] * x29; a2 -= pa7[2] * x30; a3 -= pa7[3] * x31; a0 -= l0[0] * x32; a1 -= l0[1] * x33; x34 = (a0 + a1) + (a2 + a3); } INV_SB();
    l0 = INV_LD(35, 8); pa0 = INV_LD(36, 0); pa1 = INV_LD(36, 1); pa2 = INV_LD(36, 2); pa3 = INV_LD(36, 3); pa4 = INV_LD(36, 4); pa5 = INV_LD(36, 5); pa6 = INV_LD(36, 6); pa7 = INV_LD(36, 7); INV_SB();
    { int li = lane; asm volatile("" : "+v"(li)); float a0 = (li == 35) ? 1.f : 0.f, a1 = 0.f, a2 = 0.f, a3 = 0.f; a0 -= pb0[0] * x0; a1 -= pb0[1] * x1; a2 -= pb0[2] * x2; a3 -= pb0[3] * x3; a0 -= pb1[0] * x4; a1 -= pb1[1] * x5; a2 -= pb1[2] * x6; a3 -= pb1[3] * x7; a0 -= pb2[0] * x8; a1 -= pb2[1] * x9; a2 -= pb2[2] * x10; a3 -= pb2[3] * x11; a0 -= pb3[0] * x12; a1 -= pb3[1] * x13; a2 -= pb3[2] * x14; a3 -= pb3[3] * x15; a0 -= pb4[0] * x16; a1 -= pb4[1] * x17; a2 -= pb4[2] * x18; a3 -= pb4[3] * x19; a0 -= pb5[0] * x20; a1 -= pb5[1] * x21; a2 -= pb5[2] * x22; a3 -= pb5[3] * x23; a0 -= pb6[0] * x24; a1 -= pb6[1] * x25; a2 -= pb6[2] * x26; a3 -= pb6[3] * x27; a0 -= pb7[0] * x28; a1 -= pb7[1] * x29; a2 -= pb7[2] * x30; a3 -= pb7[3] * x31; a0 -= l0[0] * x32; a1 -= l0[1] * x33; a2 -= l0[2] * x34; x35 = (a0 + a1) + (a2 + a3); } INV_SB();
    l0 = INV_LD(36, 8); pb0 = INV_LD(37, 0); pb1 = INV_LD(37, 1); pb2 = INV_LD(37, 2); pb3 = INV_LD(37, 3); pb4 = INV_LD(37, 4); pb5 = INV_LD(37, 5); pb6 = INV_LD(37, 6); pb7 = INV_LD(37, 7); INV_SB();
    { int li = lane; asm volatile("" : "+v"(li)); float a0 = (li == 36) ? 1.f : 0.f, a1 = 0.f, a2 = 0.f, a3 = 0.f; a0 -= pa0[0] * x0; a1 -= pa0[1] * x1; a2 -= pa0[2] * x2; a3 -= pa0[3] * x3; a0 -= pa1[0] * x4; a1 -= pa1[1] * x5; a2 -= pa1[2] * x6; a3 -= pa1[3] * x7; a0 -= pa2[0] * x8; a1 -= pa2[1] * x9; a2 -= pa2[2] * x10; a3 -= pa2[3] * x11; a0 -= pa3[0] * x12; a1 -= pa3[1] * x13; a2 -= pa3[2] * x14; a3 -= pa3[3] * x15; a0 -= pa4[0] * x16; a1 -= pa4[1] * x17; a2 -= pa4[2] * x18; a3 -= pa4[3] * x19; a0 -= pa5[0] * x20; a1 -= pa5[1] * x21; a2 -= pa5[2] * x22; a3 -= pa5[3] * x23; a0 -= pa6[0] * x24; a1 -= pa6[1] * x25; a2 -= pa6[2] * x26; a3 -= pa6[3] * x27; a0 -= pa7[0] * x28; a1 -= pa7[1] * x29; a2 -= pa7[2] * x30; a3 -= pa7[3] * x31; a0 -= l0[0] * x32; a1 -= l0[1] * x33; a2 -= l0[2] * x34; a3 -= l0[3] * x35; x36 = (a0 + a1) + (a2 + a3); } INV_SB();
    l0 = INV_LD(37, 8); l1 = INV_LD(37, 9); pa0 = INV_LD(38, 0); pa1 = INV_LD(38, 1); pa2 = INV_LD(38, 2); pa3 = INV_LD(38, 3); pa4 = INV_LD(38, 4); pa5 = INV_LD(38, 5); pa6 = INV_LD(38, 6); pa7 = INV_LD(38, 7); INV_SB();
    { int li = lane; asm volatile("" : "+v"(li)); float a0 = (li == 37) ? 1.f : 0.f, a1 = 0.f, a2 = 0.f, a3 = 0.f; a0 -= pb0[0] * x0; a1 -= pb0[1] * x1; a2 -= pb0[2] * x2; a3 -= pb0[3] * x3; a0 -= pb1[0] * x4; a1 -= pb1[1] * x5; a2 -= pb1[2] * x6; a3 -= pb1[3] * x7; a0 -= pb2[0] * x8; a1 -= pb2[1] * x9; a2 -= pb2[2] * x10; a3 -= pb2[3] * x11; a0 -= pb3[0] * x12; a1 -= pb3[1] * x13; a2 -= pb3[2] * x14; a3 -= pb3[3] * x15; a0 -= pb4[0] * x16; a1 -= pb4[1] * x17; a2 -= pb4[2] * x18; a3 -= pb4[3] * x19; a0 -= pb5[0] * x20; a1 -= pb5[1] * x21; a2 -= pb5[2] * x22; a3 -= pb5[3] * x23; a0 -= pb6[0] * x24; a1 -= pb6[1] * x25; a2 -= pb6[2] * x26; a3 -= pb6[3] * x27; a0 -= pb7[0] * x28; a1 -= pb7[1] * x29; a2 -= pb7[2] * x30; a3 -= pb7[3] * x31; a0 -= l0[0] * x32; a1 -= l0[1] * x33; a2 -= l0[2] * x34; a3 -= l0[3] * x35; a0 -= l1[0] * x36; x37 = (a0 + a1) + (a2 + a3); } INV_SB();
    l0 = INV_LD(38, 8); l1 = INV_LD(38, 9); pb0 = INV_LD(39, 0); pb1 = INV_LD(39, 1); pb2 = INV_LD(39, 2); pb3 = INV_LD(39, 3); pb4 = INV_LD(39, 4); pb5 = INV_LD(39, 5); pb6 = INV_LD(39, 6); pb7 = INV_LD(39, 7); INV_SB();
    { int li = lane; asm volatile("" : "+v"(li)); float a0 = (li == 38) ? 1.f : 0.f, a1 = 0.f, a2 = 0.f, a3 = 0.f; a0 -= pa0[0] * x0; a1 -= pa0[1] * x1; a2 -= pa0[2] * x2; a3 -= pa0[3] * x3; a0 -= pa1[0] * x4; a1 -= pa1[1] * x5; a2 -= pa1[2] * x6; a3 -= pa1[3] * x7; a0 -= pa2[0] * x8; a1 -= pa2[1] * x9; a2 -= pa2[2] * x10; a3 -= pa2[3] * x11; a0 -= pa3[0] * x12; a1 -= pa3[1] * x13; a2 -= pa3[2] * x14; a3 -= pa3[3] * x15; a0 -= pa4[0] * x16; a1 -= pa4[1] * x17; a2 -= pa4[2] * x18; a3 -= pa4[3] * x19; a0 -= pa5[0] * x20; a1 -= pa5[1] * x21; a2 -= pa5[2] * x22; a3 -= pa5[3] * x23; a0 -= pa6[0] * x24; a1 -= pa6[1] * x25; a2 -= pa6[2] * x26; a3 -= pa6[3] * x27; a0 -= pa7[0] * x28; a1 -= pa7[1] * x29; a2 -= pa7[2] * x30; a3 -= pa7[3] * x31; a0 -= l0[0] * x32; a1 -= l0[1] * x33; a2 -= l0[2] * x34; a3 -= l0[3] * x35; a0 -= l1[0] * x36; a1 -= l1[1] * x37; x38 = (a0 + a1) + (a2 + a3); } INV_SB();
    l0 = INV_LD(39, 8); l1 = INV_LD(39, 9); pa0 = INV_LD(40, 0); pa1 = INV_LD(40, 1); pa2 = INV_LD(40, 2); pa3 = INV_LD(40, 3); pa4 = INV_LD(40, 4); pa5 = INV_LD(40, 5); pa6 = INV_LD(40, 6); pa7 = INV_LD(40, 7); INV_SB();
    { int li = lane; asm volatile("" : "+v"(li)); float a0 = (li == 39) ? 1.f : 0.f, a1 = 0.f, a2 = 0.f, a3 = 0.f; a0 -= pb0[0] * x0; a1 -= pb0[1] * x1; a2 -= pb0[2] * x2; a3 -= pb0[3] * x3; a0 -= pb1[0] * x4; a1 -= pb1[1] * x5; a2 -= pb1[2] * x6; a3 -= pb1[3] * x7; a0 -= pb2[0] * x8; a1 -= pb2[1] * x9; a2 -= pb2[2] * x10; a3 -= pb2[3] * x11; a0 -= pb3[0] * x12; a1 -= pb3[1] * x13; a2 -= pb3[2] * x14; a3 -= pb3[3] * x15; a0 -= pb4[0] * x16; a1 -= pb4[1] * x17; a2 -= pb4[2] * x18; a3 -= pb4[3] * x19; a0 -= pb5[0] * x20; a1 -= pb5[1] * x21; a2 -= pb5[2] * x22; a3 -= pb5[3] * x23; a0 -= pb6[0] * x24; a1 -= pb6[1] * x25; a2 -= pb6[2] * x26; a3 -= pb6[3] * x27; a0 -= pb7[0] * x28; a1 -= pb7[1] * x29; a2 -= pb7[2] * x30; a3 -= pb7[3] * x31; a0 -= l0[0] * x32; a1 -= l0[1] * x33; a2 -= l0[2] * x34; a3 -= l0[3] * x35; a0 -= l1[0] * x36; a1 -= l1[1] * x37; a2 -= l1[2] * x38; x39 = (a0 + a1) + (a2 + a3); } INV_SB();
    l0 = INV_LD(40, 8); l1 = INV_LD(40, 9); pb0 = INV_LD(41, 0); pb1 = INV_LD(41, 1); pb2 = INV_LD(41, 2); pb3 = INV_LD(41, 3); pb4 = INV_LD(41, 4); pb5 = INV_LD(41, 5); pb6 = INV_LD(41, 6); pb7 = INV_LD(41, 7); INV_SB();
    { int li = lane; asm volatile("" : "+v"(li)); float a0 = (li == 40) ? 1.f : 0.f, a1 = 0.f, a2 = 0.f, a3 = 0.f; a0 -= pa0[0] * x0; a1 -= pa0[1] * x1; a2 -= pa0[2] * x2; a3 -= pa0[3] * x3; a0 -= pa1[0] * x4; a1 -= pa1[1] * x5; a2 -= pa1[2] * x6; a3 -= pa1[3] * x7; a0 -= pa2[0] * x8; a1 -= pa2[1] * x9; a2 -= pa2[2] * x10; a3 -= pa2[3] * x11; a0 -= pa3[0] * x12; a1 -= pa3[1] * x13; a2 -= pa3[2] * x14; a3 -= pa3[3] * x15; a0 -= pa4[0] * x16; a1 -= pa4[1] * x17; a2 -= pa4[2] * x18; a3 -= pa4[3] * x19; a0 -= pa5[0] * x20; a1 -= pa5[1] * x21; a2 -= pa5[2] * x22; a3 -= pa5[3] * x23; a0 -= pa6[0] * x24; a1 -= pa6[1] * x25; a2 -= pa6[2] * x26; a3 -= pa6[3] * x27; a0 -= pa7[0] * x28; a1 -= pa7[1] * x29; a2 -= pa7[2] * x30; a3 -= pa7[3] * x31; a0 -= l0[0] * x32; a1 -= l0[1] * x33; a2 -= l0[2] * x34; a3 -= l0[3] * x35; a0 -= l1[0] * x36; a1 -= l1[1] * x37; a2 -= l1[2] * x38; a3 -= l1[3] * x39; x40 = (a0 + a1) + (a2 + a3); } INV_SB();
    l0 = INV_LD(41, 8); l1 = INV_LD(41, 9); l2 = INV_LD(41, 10); pa0 = INV_LD(42, 0); pa1 = INV_LD(42, 1); pa2 = INV_LD(42, 2); pa3 = INV_LD(42, 3); pa4 = INV_LD(42, 4); pa5 = INV_LD(42, 5); pa6 = INV_LD(42, 6); pa7 = INV_LD(42, 7); INV_SB();
    { int li = lane; asm volatile("" : "+v"(li)); float a0 = (li == 41) ? 1.f : 0.f, a1 = 0.f, a2 = 0.f, a3 = 0.f; a0 -= pb0[0] * x0; a1 -= pb0[1] * x1; a2 -= pb0[2] * x2; a3 -= pb0[3] * x3; a0 -= pb1[0] * x4; a1 -= pb1[1] * x5; a2 -= pb1[2] * x6; a3 -= pb1[3] * x7; a0 -= pb2[0] * x8; a1 -= pb2[1] * x9; a2 -= pb2[2] * x10; a3 -= pb2[3] * x11; a0 -= pb3[0] * x12; a1 -= pb3[1] * x13; a2 -= pb3[2] * x14; a3 -= pb3[3] * x15; a0 -= pb4[0] * x16; a1 -= pb4[1] * x17; a2 -= pb4[2] * x18; a3 -= pb4[3] * x19; a0 -= pb5[0] * x20; a1 -= pb5[1] * x21; a2 -= pb5[2] * x22; a3 -= pb5[3] * x23; a0 -= pb6[0] * x24; a1 -= pb6[1] * x25; a2 -= pb6[2] * x26; a3 -= pb6[3] * x27; a0 -= pb7[0] * x28; a1 -= pb7[1] * x29; a2 -= pb7[2] * x30; a3 -= pb7[3] * x31; a0 -= l0[0] * x32; a1 -= l0[1] * x33; a2 -= l0[2] * x34; a3 -= l0[3] * x35; a0 -= l1[0] * x36; a1 -= l1[1] * x37; a2 -= l1[2] * x38; a3 -= l1[3] * x39; a0 -= l2[0] * x40; x41 = (a0 + a1) + (a2 + a3); } INV_SB();
    l0 = INV_LD(42, 8); l1 = INV_LD(42, 9); l2 = INV_LD(42, 10); pb0 = INV_LD(43, 0); pb1 = INV_LD(43, 1); pb2 = INV_LD(43, 2); pb3 = INV_LD(43, 3); pb4 = INV_LD(43, 4); pb5 = INV_LD(43, 5); pb6 = INV_LD(43, 6); pb7 = INV_LD(43, 7); INV_SB();
    { int li = lane; asm volatile("" : "+v"(li)); float a0 = (li == 42) ? 1.f : 0.f, a1 = 0.f, a2 = 0.f, a3 = 0.f; a0 -= pa0[0] * x0; a1 -= pa0[1] * x1; a2 -= pa0[2] * x2; a3 -= pa0[3] * x3; a0 -= pa1[0] * x4; a1 -= pa1[1] * x5; a2 -= pa1[2] * x6; a3 -= pa1[3] * x7; a0 -= pa2[0] * x8; a1 -= pa2[1] * x9; a2 -= pa2[2] * x10; a3 -= pa2[3] * x11; a0 -= pa3[0] * x12; a1 -= pa3[1] * x13; a2 -= pa3[2] * x14; a3 -= pa3[3] * x15; a0 -= pa4[0] * x16; a1 -= pa4[1] * x17; a2 -= pa4[2] * x18; a3 -= pa4[3] * x19; a0 -= pa5[0] * x20; a1 -= pa5[1] * x21; a2 -= pa5[2] * x22; a3 -= pa5[3] * x23; a0 -= pa6[0] * x24; a1 -= pa6[1] * x25; a2 -= pa6[2] * x26; a3 -= pa6[3] * x27; a0 -= pa7[0] * x28; a1 -= pa7[1] * x29; a2 -= pa7[2] * x30; a3 -= pa7[3] * x31; a0 -= l0[0] * x32; a1 -= l0[1] * x33; a2 -= l0[2] * x34; a3 -= l0[3] * x35; a0 -= l1[0] * x36; a1 -= l1[1] * x37; a2 -= l1[2] * x38; a3 -= l1[3] * x39; a0 -= l2[0] * x40; a1 -= l2[1] * x41; x42 = (a0 + a1) + (a2 + a3); } INV_SB();
    l0 = INV_LD(43, 8); l1 = INV_LD(43, 9); l2 = INV_LD(43, 10); pa0 = INV_LD(44, 0); pa1 = INV_LD(44, 1); pa2 = INV_LD(44, 2); pa3 = INV_LD(44, 3); pa4 = INV_LD(44, 4); pa5 = INV_LD(44, 5); pa6 = INV_LD(44, 6); pa7 = INV_LD(44, 7); INV_SB();
    { int li = lane; asm volatile("" : "+v"(li)); float a0 = (li == 43) ? 1.f : 0.f, a1 = 0.f, a2 = 0.f, a3 = 0.f; a0 -= pb0[0] * x0; a1 -= pb0[1] * x1; a2 -= pb0[2] * x2; a3 -= pb0[3] * x3; a0 -= pb1[0] * x4; a1 -= pb1[1] * x5; a2 -= pb1[2] * x6; a3 -= pb1[3] * x7; a0 -= pb2[0] * x8; a1 -= pb2[1] * x9; a2 -= pb2[2] * x10; a3 -= pb2[3] * x11; a0 -= pb3[0] * x12; a1 -= pb3[1] * x13; a2 -= pb3[2] * x14; a3 -= pb3[3] * x15; a0 -= pb4[0] * x16; a1 -= pb4[1] * x17; a2 -= pb4[2] * x18; a3 -= pb4[3] * x19; a0 -= pb5[0] * x20; a1 -= pb5[1] * x21; a2 -= pb5[2] * x22; a3 -= pb5[3] * x23; a0 -= pb6[0] * x24; a1 -= pb6[1] * x25; a2 -= pb6[2] * x26; a3 -= pb6[3] * x27; a0 -= pb7[0] * x28; a1 -= pb7[1] * x29; a2 -= pb7[2] * x30; a3 -= pb7[3] * x31; a0 -= l0[0] * x32; a1 -= l0[1] * x33; a2 -= l0[2] * x34; a3 -= l0[3] * x35; a0 -= l1[0] * x36; a1 -= l1[1] * x37; a2 -= l1[2] * x38; a3 -= l1[3] * x39; a0 -= l2[0] * x40; a1 -= l2[1] * x41; a2 -= l2[2] * x42; x43 = (a0 + a1) + (a2 + a3); } INV_SB();
    l0 = INV_LD(44, 8); l1 = INV_LD(44, 9); l2 = INV_LD(44, 10); pb0 = INV_LD(45, 0); pb1 = INV_LD(45, 1); pb2 = INV_LD(45, 2); pb3 = INV_LD(45, 3); pb4 = INV_LD(45, 4); pb5 = INV_LD(45, 5); pb6 = INV_LD(45, 6); pb7 = INV_LD(45, 7); INV_SB();
    { int li = lane; asm volatile("" : "+v"(li)); float a0 = (li == 44) ? 1.f : 0.f, a1 = 0.f, a2 = 0.f, a3 = 0.f; a0 -= pa0[0] * x0; a1 -= pa0[1] * x1; a2 -= pa0[2] * x2; a3 -= pa0[3] * x3; a0 -= pa1[0] * x4; a1 -= pa1[1] * x5; a2 -= pa1[2] * x6; a3 -= pa1[3] * x7; a0 -= pa2[0] * x8; a1 -= pa2[1] * x9; a2 -= pa2[2] * x10; a3 -= pa2[3] * x11; a0 -= pa3[0] * x12; a1 -= pa3[1] * x13; a2 -= pa3[2] * x14; a3 -= pa3[3] * x15; a0 -= pa4[0] * x16; a1 -= pa4[1] * x17; a2 -= pa4[2] * x18; a3 -= pa4[3] * x19; a0 -= pa5[0] * x20; a1 -= pa5[1] * x21; a2 -= pa5[2] * x22; a3 -= pa5[3] * x23; a0 -= pa6[0] * x24; a1 -= pa6[1] * x25; a2 -= pa6[2] * x26; a3 -= pa6[3] * x27; a0 -= pa7[0] * x28; a1 -= pa7[1] * x29; a2 -= pa7[2] * x30; a3 -= pa7[3] * x31; a0 -= l0[0] * x32; a1 -= l0[1] * x33; a2 -= l0[2] * x34; a3 -= l0[3] * x35; a0 -= l1[0] * x36; a1 -= l1[1] * x37; a2 -= l1[2] * x38; a3 -= l1[3] * x39; a0 -= l2[0] * x40; a1 -= l2[1] * x41; a2 -= l2[2] * x42; a3 -= l2[3] * x43; x44 = (a0 + a1) + (a2 + a3); } INV_SB();
    l0 = INV_LD(45, 8); l1 = INV_LD(45, 9); l2 = INV_LD(45, 10); l3 = INV_LD(45, 11); pa0 = INV_LD(46, 0); pa1 = INV_LD(46, 1); pa2 = INV_LD(46, 2); pa3 = INV_LD(46, 3); pa4 = INV_LD(46, 4); pa5 = INV_LD(46, 5); pa6 = INV_LD(46, 6); pa7 = INV_LD(46, 7); INV_SB();
    { int li = lane; asm volatile("" : "+v"(li)); float a0 = (li == 45) ? 1.f : 0.f, a1 = 0.f, a2 = 0.f, a3 = 0.f; a0 -= pb0[0] * x0; a1 -= pb0[1] * x1; a2 -= pb0[2] * x2; a3 -= pb0[3] * x3; a0 -= pb1[0] * x4; a1 -= pb1[1] * x5; a2 -= pb1[2] * x6; a3 -= pb1[3] * x7; a0 -= pb2[0] * x8; a1 -= pb2[1] * x9; a2 -= pb2[2] * x10; a3 -= pb2[3] * x11; a0 -= pb3[0] * x12; a1 -= pb3[1] * x13; a2 -= pb3[2] * x14; a3 -= pb3[3] * x15; a0 -= pb4[0] * x16; a1 -= pb4[1] * x17; a2 -= pb4[2] * x18; a3 -= pb4[3] * x19; a0 -= pb5[0] * x20; a1 -= pb5[1] * x21; a2 -= pb5[2] * x22; a3 -= pb5[3] * x23; a0 -= pb6[0] * x24; a1 -= pb6[1] * x25; a2 -= pb6[2] * x26; a3 -= pb6[3] * x27; a0 -= pb7[0] * x28; a1 -= pb7[1] * x29; a2 -= pb7[2] * x30; a3 -= pb7[3] * x31; a0 -= l0[0] * x32; a1 -= l0[1] * x33; a2 -= l0[2] * x34; a3 -= l0[3] * x35; a0 -= l1[0] * x36; a1 -= l1[1] * x37; a2 -= l1[2] * x38; a3 -= l1[3] * x39; a0 -= l2[0] * x40; a1 -= l2[1] * x41; a2 -= l2[2] * x42; a3 -= l2[3] * x43; a0 -= l3[0] * x44; x45 = (a0 + a1) + (a2 + a3); } INV_SB();
    l0 = INV_LD(46, 8); l1 = INV_LD(46, 9); l2 = INV_LD(46, 10); l3 = INV_LD(46, 11); pb0 = INV_LD(47, 0); pb1 = INV_LD(47, 1); pb2 = INV_LD(47, 2); pb3 = INV_LD(47, 3); pb4 = INV_LD(47, 4); pb5 = INV_LD(47, 5); pb6 = INV_LD(47, 6); pb7 = INV_LD(47, 7); INV_SB();
    { int li = lane; asm volatile("" : "+v"(li)); float a0 = (li == 46) ? 1.f : 0.f, a1 = 0.f, a2 = 0.f, a3 = 0.f; a0 -= pa0[0] * x0; a1 -= pa0[1] * x1; a2 -= pa0[2] * x2; a3 -= pa0[3] * x3; a0 -= pa1[0] * x4; a1 -= pa1[1] * x5; a2 -= pa1[2] * x6; a3 -= pa1[3] * x7; a0 -= pa2[0] * x8; a1 -= pa2[1] * x9; a2 -= pa2[2] * x10; a3 -= pa2[3] * x11; a0 -= pa3[0] * x12; a1 -= pa3[1] * x13; a2 -= pa3[2] * x14; a3 -= pa3[3] * x15; a0 -= pa4[0] * x16; a1 -= pa4[1] * x17; a2 -= pa4[2] * x18; a3 -= pa4[3] * x19; a0 -= pa5[0] * x20; a1 -= pa5[1] * x21; a2 -= pa5[2] * x22; a3 -= pa5[3] * x23; a0 -= pa6[0] * x24; a1 -= pa6[1] * x25; a2 -= pa6[2] * x26; a3 -= pa6[3] * x27; a0 -= pa7[0] * x28; a1 -= pa7[1] * x29; a2 -= pa7[2] * x30; a3 -= pa7[3] * x31; a0 -= l0[0] * x32; a1 -= l0[1] * x33; a2 -= l0[2] * x34; a3 -= l0[3] * x35; a0 -= l1[0] * x36; a1 -= l1[1] * x37; a2 -= l1[2] * x38; a3 -= l1[3] * x39; a0 -= l2[0] * x40; a1 -= l2[1] * x41; a2 -= l2[2] * x42; a3 -= l2[3] * x43; a0 -= l3[0] * x44; a1 -= l3[1] * x45; x46 = (a0 + a1) + (a2 + a3); } INV_SB();
    l0 = INV_LD(47, 8); l1 = INV_LD(47, 9); l2 = INV_LD(47, 10); l3 = INV_LD(47, 11); pa0 = INV_LD(48, 0); pa1 = INV_LD(48, 1); pa2 = INV_LD(48, 2); pa3 = INV_LD(48, 3); pa4 = INV_LD(48, 4); pa5 = INV_LD(48, 5); pa6 = INV_LD(48, 6); pa7 = INV_LD(48, 7); INV_SB();
    { int li = lane; asm volatile("" : "+v"(li)); float a0 = (li == 47) ? 1.f : 0.f, a1 = 0.f, a2 = 0.f, a3 = 0.f; a0 -= pb0[0] * x0; a1 -= pb0[1] * x1; a2 -= pb0[2] * x2; a3 -= pb0[3] * x3; a0 -= pb1[0] * x4; a1 -= pb1[1] * x5; a2 -= pb1[2] * x6; a3 -= pb1[3] * x7; a0 -= pb2[0] * x8; a1 -= pb2[1] * x9; a2 -= pb2[2] * x10; a3 -= pb2[3] * x11; a0 -= pb3[0] * x12; a1 -= pb3[1] * x13; a2 -= pb3[2] * x14; a3 -= pb3[3] * x15; a0 -= pb4[0] * x16; a1 -= pb4[1] * x17; a2 -= pb4[2] * x18; a3 -= pb4[3] * x19; a0 -= pb5[0] * x20; a1 -= pb5[1] * x21; a2 -= pb5[2] * x22; a3 -= pb5[3] * x23; a0 -= pb6[0] * x24; a1 -= pb6[1] * x25; a2 -= pb6[2] * x26; a3 -= pb6[3] * x27; a0 -= pb7[0] * x28; a1 -= pb7[1] * x29; a2 -= pb7[2] * x30; a3 -= pb7[3] * x31; a0 -= l0[0] * x32; a1 -= l0[1] * x33; a2 -= l0[2] * x34; a3 -= l0[3] * x35; a0 -= l1[0] * x36; a1 -= l1[1] * x37; a2 -= l1[2] * x38; a3 -= l1[3] * x39; a0 -= l2[0] * x40; a1 -= l2[1] * x41; a2 -= l2[2] * x42; a3 -= l2[3] * x43; a0 -= l3[0] * x44; a1 -= l3[1] * x45; a2 -= l3[2] * x46; x47 = (a0 + a1) + (a2 + a3); } INV_SB();
    l0 = INV_LD(48, 8); l1 = INV_LD(48, 9); l2 = INV_LD(48, 10); l3 = INV_LD(48, 11); pb0 = INV_LD(49, 0); pb1 = INV_LD(49, 1); pb2 = INV_LD(49, 2); pb3 = INV_LD(49, 3); pb4 = INV_LD(49, 4); pb5 = INV_LD(49, 5); pb6 = INV_LD(49, 6); pb7 = INV_LD(49, 7); INV_SB();
    { int li = lane; asm volatile("" : "+v"(li)); float a0 = (li == 48) ? 1.f : 0.f, a1 = 0.f, a2 = 0.f, a3 = 0.f; a0 -= pa0[0] * x0; a1 -= pa0[1] * x1; a2 -= pa0[2] * x2; a3 -= pa0[3] * x3; a0 -= pa1[0] * x4; a1 -= pa1[1] * x5; a2 -= pa1[2] * x6; a3 -= pa1[3] * x7; a0 -= pa2[0] * x8; a1 -= pa2[1] * x9; a2 -= pa2[2] * x10; a3 -= pa2[3] * x11; a0 -= pa3[0] * x12; a1 -= pa3[1] * x13; a2 -= pa3[2] * x14; a3 -= pa3[3] * x15; a0 -= pa4[0] * x16; a1 -= pa4[1] * x17; a2 -= pa4[2] * x18; a3 -= pa4[3] * x19; a0 -= pa5[0] * x20; a1 -= pa5[1] * x21; a2 -= pa5[2] * x22; a3 -= pa5[3] * x23; a0 -= pa6[0] * x24; a1 -= pa6[1] * x25; a2 -= pa6[2] * x26; a3 -= pa6[3] * x27; a0 -= pa7[0] * x28; a1 -= pa7[1] * x29; a2 -= pa7[2] * x30; a3 -= pa7[3] * x31; a0 -= l0[0] * x32; a1 -= l0[1] * x33; a2 -= l0[2] * x34; a3 -= l0[3] * x35; a0 -= l1[0] * x36; a1 -= l1[1] * x37; a2 -= l1[2] * x38; a3 -= l1[3] * x39; a0 -= l2[0] * x40; a1 -= l2[1] * x41; a2 -= l2[2] * x42; a3 -= l2[3] * x43; a0 -= l3[0] * x44; a1 -= l3[1] * x45; a2 -= l3[2] * x46; a3 -= l3[3] * x47; x48 = (a0 + a1) + (a2 + a3); } INV_SB();
    l0 = INV_LD(49, 8); l1 = INV_LD(49, 9); l2 = INV_LD(49, 10); l3 = INV_LD(49, 11); l4 = INV_LD(49, 12); pa0 = INV_LD(50, 0); pa1 = INV_LD(50, 1); pa2 = INV_LD(50, 2); pa3 = INV_LD(50, 3); pa4 = INV_LD(50, 4); pa5 = INV_LD(50, 5); pa6 = INV_LD(50, 6); pa7 = INV_LD(50, 7); INV_SB();
    { int li = lane; asm volatile("" : "+v"(li)); float a0 = (li == 49) ? 1.f : 0.f, a1 = 0.f, a2 = 0.f, a3 = 0.f; a0 -= pb0[0] * x0; a1 -= pb0[1] * x1; a2 -= pb0[2] * x2; a3 -= pb0[3] * x3; a0 -= pb1[0] * x4; a1 -= pb1[1] * x5; a2 -= pb1[2] * x6; a3 -= pb1[3] * x7; a0 -= pb2[0] * x8; a1 -= pb2[1] * x9; a2 -= pb2[2] * x10; a3 -= pb2[3] * x11; a0 -= pb3[0] * x12; a1 -= pb3[1] * x13; a2 -= pb3[2] * x14; a3 -= pb3[3] * x15; a0 -= pb4[0] * x16; a1 -= pb4[1] * x17; a2 -= pb4[2] * x18; a3 -= pb4[3] * x19; a0 -= pb5[0] * x20; a1 -= pb5[1] * x21; a2 -= pb5[2] * x22; a3 -= pb5[3] * x23; a0 -= pb6[0] * x24; a1 -= pb6[1] * x25; a2 -= pb6[2] * x26; a3 -= pb6[3] * x27; a0 -= pb7[0] * x28; a1 -= pb7[1] * x29; a2 -= pb7[2] * x30; a3 -= pb7[3] * x31; a0 -= l0[0] * x32; a1 -= l0[1] * x33; a2 -= l0[2] * x34; a3 -= l0[3] * x35; a0 -= l1[0] * x36; a1 -= l1[1] * x37; a2 -= l1[2] * x38; a3 -= l1[3] * x39; a0 -= l2[0] * x40; a1 -= l2[1] * x41; a2 -= l2[2] * x42; a3 -= l2[3] * x43; a0 -= l3[0] * x44; a1 -= l3[1] * x45; a2 -= l3[2] * x46; a3 -= l3[3] * x47; a0 -= l4[0] * x48; x49 = (a0 + a1) + (a2 + a3); } INV_SB();
    l0 = INV_LD(50, 8); l1 = INV_LD(50, 9); l2 = INV_LD(50, 10); l3 = INV_LD(50, 11); l4 = INV_LD(50, 12); pb0 = INV_LD(51, 0); pb1 = INV_LD(51, 1); pb2 = INV_LD(51, 2); pb3 = INV_LD(51, 3); pb4 = INV_LD(51, 4); pb5 = INV_LD(51, 5); pb6 = INV_LD(51, 6); pb7 = INV_LD(51, 7); INV_SB();
    { int li = lane; asm volatile("" : "+v"(li)); float a0 = (li == 50) ? 1.f : 0.f, a1 = 0.f, a2 = 0.f, a3 = 0.f; a0 -= pa0[0] * x0; a1 -= pa0[1] * x1; a2 -= pa0[2] * x2; a3 -= pa0[3] * x3; a0 -= pa1[0] * x4; a1 -= pa1[1] * x5; a2 -= pa1[2] * x6; a3 -= pa1[3] * x7; a0 -= pa2[0] * x8; a1 -= pa2[1] * x9; a2 -= pa2[2] * x10; a3 -= pa2[3] * x11; a0 -= pa3[0] * x12; a1 -= pa3[1] * x13; a2 -= pa3[2] * x14; a3 -= pa3[3] * x15; a0 -= pa4[0] * x16; a1 -= pa4[1] * x17; a2 -= pa4[2] * x18; a3 -= pa4[3] * x19; a0 -= pa5[0] * x20; a1 -= pa5[1] * x21; a2 -= pa5[2] * x22; a3 -= pa5[3] * x23; a0 -= pa6[0] * x24; a1 -= pa6[1] * x25; a2 -= pa6[2] * x26; a3 -= pa6[3] * x27; a0 -= pa7[0] * x28; a1 -= pa7[1] * x29; a2 -= pa7[2] * x30; a3 -= pa7[3] * x31; a0 -= l0[0] * x32; a1 -= l0[1] * x33; a2 -= l0[2] * x34; a3 -= l0[3] * x35; a0 -= l1[0] * x36; a1 -= l1[1] * x37; a2 -= l1[2] * x38; a3 -= l1[3] * x39; a0 -= l2[0] * x40; a1 -= l2[1] * x41; a2 -= l2[2] * x42; a3 -= l2[3] * x43; a0 -= l3[0] * x44; a1 -= l3[1] * x45; a2 -= l3[2] * x46; a3 -= l3[3] * x47; a0 -= l4[0] * x48; a1 -= l4[1] * x49; x50 = (a0 + a1) + (a2 + a3); } INV_SB();
    l0 = INV_LD(51, 8); l1 = INV_LD(51, 9); l2 = INV_LD(51, 10); l3 = INV_LD(51, 11); l4 = INV_LD(51, 12); pa0 = INV_LD(52, 0); pa1 = INV_LD(52, 1); pa2 = INV_LD(52, 2); pa3 = INV_LD(52, 3); pa4 = INV_LD(52, 4); pa5 = INV_LD(52, 5); pa6 = INV_LD(52, 6); pa7 = INV_LD(52, 7); INV_SB();
    { int li = lane; asm volatile("" : "+v"(li)); float a0 = (li == 51) ? 1.f : 0.f, a1 = 0.f, a2 = 0.f, a3 = 0.f; a0 -= pb0[0] * x0; a1 -= pb0[1] * x1; a2 -= pb0[2] * x2; a3 -= pb0[3] * x3; a0 -= pb1[0] * x4; a1 -= pb1[1] * x5; a2 -= pb1[2] * x6; a3 -= pb1[3] * x7; a0 -= pb2[0] * x8; a1 -= pb2[1] * x9; a2 -= pb2[2] * x10; a3 -= pb2[3] * x11; a0 -= pb3[0] * x12; a1 -= pb3[1] * x13; a2 -= pb3[2] * x14; a3 -= pb3[3] * x15; a0 -= pb4[0] * x16; a1 -= pb4[1] * x17; a2 -= pb4[2] * x18; a3 -= pb4[3] * x19; a0 -= pb5[0] * x20; a1 -= pb5[1] * x21; a2 -= pb5[2] * x22; a3 -= pb5[3] * x23; a0 -= pb6[0] * x24; a1 -= pb6[1] * x25; a2 -= pb6[2] * x26; a3 -= pb6[3] * x27; a0 -= pb7[0] * x28; a1 -= pb7[1] * x29; a2 -= pb7[2] * x30; a3 -= pb7[3] * x31; a0 -= l0[0] * x32; a1 -= l0[1] * x33; a2 -= l0[2] * x34; a3 -= l0[3] * x35; a0 -= l1[0] * x36; a1 -= l1[1] * x37; a2 -= l1[2] * x38; a3 -= l1[3] * x39; a0 -= l2[0] * x40; a1 -= l2[1] * x41; a2 -= l2[2] * x42; a3 -= l2[3] * x43; a0 -= l3[0] * x44; a1 -= l3[1] * x45; a2 -= l3[2] * x46; a3 -= l3[3] * x47; a0 -= l4[0] * x48; a1 -= l4[1] * x49; a2 -= l4[2] * x50; x51 = (a0 + a1) + (a2 + a3); } INV_SB();
    l0 = INV_LD(52, 8); l1 = INV_LD(52, 9); l2 = INV_LD(52, 10); l3 = INV_LD(52, 11); l4 = INV_LD(52, 12); pb0 = INV_LD(53, 0); pb1 = INV_LD(53, 1); pb2 = INV_LD(53, 2); pb3 = INV_LD(53, 3); pb4 = INV_LD(53, 4); pb5 = INV_LD(53, 5); pb6 = INV_LD(53, 6); pb7 = INV_LD(53, 7); INV_SB();
    { int li = lane; asm volatile("" : "+v"(li)); float a0 = (li == 52) ? 1.f : 0.f, a1 = 0.f, a2 = 0.f, a3 = 0.f; a0 -= pa0[0] * x0; a1 -= pa0[1] * x1; a2 -= pa0[2] * x2; a3 -= pa0[3] * x3; a0 -= pa1[0] * x4; a1 -= pa1[1] * x5; a2 -= pa1[2] * x6; a3 -= pa1[3] * x7; a0 -= pa2[0] * x8; a1 -= pa2[1] * x9; a2 -= pa2[2] * x10; a3 -= pa2[3] * x11; a0 -= pa3[0] * x12; a1 -= pa3[1] * x13; a2 -= pa3[2] * x14; a3 -= pa3[3] * x15; a0 -= pa4[0] * x16; a1 -= pa4[1] * x17; a2 -= pa4[2] * x18; a3 -= pa4[3] * x19; a0 -= pa5[0] * x20; a1 -= pa5[1] * x21; a2 -= pa5[2] * x22; a3 -= pa5[3] * x23; a0 -= pa6[0] * x24; a1 -= pa6[1] * x25; a2 -= pa6[2] * x26; a3 -= pa6[3] * x27; a0 -= pa7[0] * x28; a1 -= pa7[1] * x29; a2 -= pa7[2] * x30; a3 -= pa7[3] * x31; a0 -= l0[0] * x32; a1 -= l0[1] * x33; a2 -= l0[2] * x34; a3 -= l0[3] * x35; a0 -= l1[0] * x36; a1 -= l1[1] * x37; a2 -= l1[2] * x38; a3 -= l1[3] * x39; a0 -= l2[0] * x40; a1 -= l2[1] * x41; a2 -= l2[2] * x42; a3 -= l2[3] * x43; a0 -= l3[0] * x44; a1 -= l3[1] * x45; a2 -= l3[2] * x46; a3 -= l3[3] * x47; a0 -= l4[0] * x48; a1 -= l4[1] * x49; a2 -= l4[2] * x50; a3 -= l4[3] * x51; x52 = (a0 + a1) + (a2 + a3); } INV_SB();
    l0 = INV_LD(53, 8); l1 = INV_LD(53, 9); l2 = INV_LD(53, 10); l3 = INV_LD(53, 11); l4 = INV_LD(53, 12); l5 = INV_LD(53, 13); pa0 = INV_LD(54, 0); pa1 = INV_LD(54, 1); pa2 = INV_LD(54, 2); pa3 = INV_LD(54, 3); pa4 = INV_LD(54, 4); pa5 = INV_LD(54, 5); pa6 = INV_LD(54, 6); pa7 = INV_LD(54, 7); INV_SB();
    { int li = lane; asm volatile("" : "+v"(li)); float a0 = (li == 53) ? 1.f : 0.f, a1 = 0.f, a2 = 0.f, a3 = 0.f; a0 -= pb0[0] * x0; a1 -= pb0[1] * x1; a2 -= pb0[2] * x2; a3 -= pb0[3] * x3; a0 -= pb1[0] * x4; a1 -= pb1[1] * x5; a2 -= pb1[2] * x6; a3 -= pb1[3] * x7; a0 -= pb2[0] * x8; a1 -= pb2[1] * x9; a2 -= pb2[2] * x10; a3 -= pb2[3] * x11; a0 -= pb3[0] * x12; a1 -= pb3[1] * x13; a2 -= pb3[2] * x14; a3 -= pb3[3] * x15; a0 -= pb4[0] * x16; a1 -= pb4[1] * x17; a2 -= pb4[2] * x18; a3 -= pb4[3] * x19; a0 -= pb5[0] * x20; a1 -= pb5[1] * x21; a2 -= pb5[2] * x22; a3 -= pb5[3] * x23; a0 -= pb6[0] * x24; a1 -= pb6[1] * x25; a2 -= pb6[2] * x26; a3 -= pb6[3] * x27; a0 -= pb7[0] * x28; a1 -= pb7[1] * x29; a2 -= pb7[2] * x30; a3 -= pb7[3] * x31; a0 -= l0[0] * x32; a1 -= l0[1] * x33; a2 -= l0[2] * x34; a3 -= l0[3] * x35; a0 -= l1[0] * x36; a1 -= l1[1] * x37; a2 -= l1[2] * x38; a3 -= l1[3] * x39; a0 -= l2[0] * x40; a1 -= l2[1] * x41; a2 -= l2[2] * x42; a3 -= l2[3] * x43; a0 -= l3[0] * x44; a1 -= l3[1] * x45; a2 -= l3[2] * x46; a3 -= l3[3] * x47; a0 -= l4[0] * x48; a1 -= l4[1] * x49; a2 -= l4[2] * x50; a3 -= l4[3] * x51; a0 -= l5[0] * x52; x53 = (a0 + a1) + (a2 + a3); } INV_SB();
    l0 = INV_LD(54, 8); l1 = INV_LD(54, 9); l2 = INV_LD(54, 10); l3 = INV_LD(54, 11); l4 = INV_LD(54, 12); l5 = INV_LD(54, 13); pb0 = INV_LD(55, 0); pb1 = INV_LD(55, 1); pb2 = INV_LD(55, 2); pb3 = INV_LD(55, 3); pb4 = INV_LD(55, 4); pb5 = INV_LD(55, 5); pb6 = INV_LD(55, 6); pb7 = INV_LD(55, 7); INV_SB();
    { int li = lane; asm volatile("" : "+v"(li)); float a0 = (li == 54) ? 1.f : 0.f, a1 = 0.f, a2 = 0.f, a3 = 0.f; a0 -= pa0[0] * x0; a1 -= pa0[1] * x1; a2 -= pa0[2] * x2; a3 -= pa0[3] * x3; a0 -= pa1[0] * x4; a1 -= pa1[1] * x5; a2 -= pa1[2] * x6; a3 -= pa1[3] * x7; a0 -= pa2[0] * x8; a1 -= pa2[1] * x9; a2 -= pa2[2] * x10; a3 -= pa2[3] * x11; a0 -= pa3[0] * x12; a1 -= pa3[1] * x13; a2 -= pa3[2] * x14; a3 -= pa3[3] * x15; a0 -= pa4[0] * x16; a1 -= pa4[1] * x17; a2 -= pa4[2] * x18; a3 -= pa4[3] * x19; a0 -= pa5[0] * x20; a1 -= pa5[1] * x21; a2 -= pa5[2] * x22; a3 -= pa5[3] * x23; a0 -= pa6[0] * x24; a1 -= pa6[1] * x25; a2 -= pa6[2] * x26; a3 -= pa6[3] * x27; a0 -= pa7[0] * x28; a1 -= pa7[1] * x29; a2 -= pa7[2] * x30; a3 -= pa7[3] * x31; a0 -= l0[0] * x32; a1 -= l0[1] * x33; a2 -= l0[2] * x34; a3 -= l0[3] * x35; a0 -= l1[0] * x36; a1 -= l1[1] * x37; a2 -= l1[2] * x38; a3 -= l1[3] * x39; a0 -= l2[0] * x40; a1 -= l2[1] * x41; a2 -= l2[2] * x42; a3 -= l2[3] * x43; a0 -= l3[0] * x44; a1 -= l3[1] * x45; a2 -= l3[2] * x46; a3 -= l3[3] * x47; a0 -= l4[0] * x48; a1 -= l4[1] * x49; a2 -= l4[2] * x50; a3 -= l4[3] * x51; a0 -= l5[0] * x52; a1 -= l5[1] * x53; x54 = (a0 + a1) + (a2 + a3); } INV_SB();
    l0 = INV_LD(55, 8); l1 = INV_LD(55, 9); l2 = INV_LD(55, 10); l3 = INV_LD(55, 11); l4 = INV_LD(55, 12); l5 = INV_LD(55, 13); pa0 = INV_LD(56, 0); pa1 = INV_LD(56, 1); pa2 = INV_LD(56, 2); pa3 = INV_LD(56, 3); pa4 = INV_LD(56, 4); pa5 = INV_LD(56, 5); pa6 = INV_LD(56, 6); pa7 = INV_LD(56, 7); INV_SB();
    { int li = lane; asm volatile("" : "+v"(li)); float a0 = (li == 55) ? 1.f : 0.f, a1 = 0.f, a2 = 0.f, a3 = 0.f; a0 -= pb0[0] * x0; a1 -= pb0[1] * x1; a2 -= pb0[2] * x2; a3 -= pb0[3] * x3; a0 -= pb1[0] * x4; a1 -= pb1[1] * x5; a2 -= pb1[2] * x6; a3 -= pb1[3] * x7; a0 -= pb2[0] * x8; a1 -= pb2[1] * x9; a2 -= pb2[2] * x10; a3 -= pb2[3] * x11; a0 -= pb3[0] * x12; a1 -= pb3[1] * x13; a2 -= pb3[2] * x14; a3 -= pb3[3] * x15; a0 -= pb4[0] * x16; a1 -= pb4[1] * x17; a2 -= pb4[2] * x18; a3 -= pb4[3] * x19; a0 -= pb5[0] * x20; a1 -= pb5[1] * x21; a2 -= pb5[2] * x22; a3 -= pb5[3] * x23; a0 -= pb6[0] * x24; a1 -= pb6[1] * x25; a2 -= pb6[2] * x26; a3 -= pb6[3] * x27; a0 -= pb7[0] * x28; a1 -= pb7[1] * x29; a2 -= pb7[2] * x30; a3 -= pb7[3] * x31; a0 -= l0[0] * x32; a1 -= l0[1] * x33; a2 -= l0[2] * x34; a3 -= l0[3] * x35; a0 -= l1[0] * x36; a1 -= l1[1] * x37; a2 -= l1[2] * x38; a3 -= l1[3] * x39; a0 -= l2[0] * x40; a1 -= l2[1] * x41; a2 -= l2[2] * x42; a3 -= l2[3] * x43; a0 -= l3[0] * x44; a1 -= l3[1] * x45; a2 -= l3[2] * x46; a3 -= l3[3] * x47; a0 -= l4[0] * x48; a1 -= l4[1] * x49; a2 -= l4[2] * x50; a3 -= l4[3] * x51; a0 -= l5[0] * x52; a1 -= l5[1] * x53; a2 -= l5[2] * x54; x55 = (a0 + a1) + (a2 + a3); } INV_SB();
    l0 = INV_LD(56, 8); l1 = INV_LD(56, 9); l2 = INV_LD(56, 10); l3 = INV_LD(56, 11); l4 = INV_LD(56, 12); l5 = INV_LD(56, 13); pb0 = INV_LD(57, 0); pb1 = INV_LD(57, 1); pb2 = INV_LD(57, 2); pb3 = INV_LD(57, 3); pb4 = INV_LD(57, 4); pb5 = INV_LD(57, 5); pb6 = INV_LD(57, 6); pb7 = INV_LD(57, 7); INV_SB();
    { int li = lane; asm volatile("" : "+v"(li)); float a0 = (li == 56) ? 1.f : 0.f, a1 = 0.f, a2 = 0.f, a3 = 0.f; a0 -= pa0[0] * x0; a1 -= pa0[1] * x1; a2 -= pa0[2] * x2; a3 -= pa0[3] * x3; a0 -= pa1[0] * x4; a1 -= pa1[1] * x5; a2 -= pa1[2] * x6; a3 -= pa1[3] * x7; a0 -= pa2[0] * x8; a1 -= pa2[1] * x9; a2 -= pa2[2] * x10; a3 -= pa2[3] * x11; a0 -= pa3[0] * x12; a1 -= pa3[1] * x13; a2 -= pa3[2] * x14; a3 -= pa3[3] * x15; a0 -= pa4[0] * x16; a1 -= pa4[1] * x17; a2 -= pa4[2] * x18; a3 -= pa4[3] * x19; a0 -= pa5[0] * x20; a1 -= pa5[1] * x21; a2 -= pa5[2] * x22; a3 -= pa5[3] * x23; a0 -= pa6[0] * x24; a1 -= pa6[1] * x25; a2 -= pa6[2] * x26; a3 -= pa6[3] * x27; a0 -= pa7[0] * x28; a1 -= pa7[1] * x29; a2 -= pa7[2] * x30; a3 -= pa7[3] * x31; a0 -= l0[0] * x32; a1 -= l0[1] * x33; a2 -= l0[2] * x34; a3 -= l0[3] * x35; a0 -= l1[0] * x36; a1 -= l1[1] * x37; a2 -= l1[2] * x38; a3 -= l1[3] * x39; a0 -= l2[0] * x40; a1 -= l2[1] * x41; a2 -= l2[2] * x42; a3 -= l2[3] * x43; a0 -= l3[0] * x44; a1 -= l3[1] * x45; a2 -= l3[2] * x46; a3 -= l3[3] * x47; a0 -= l4[0] * x48; a1 -= l4[1] * x49; a2 -= l4[2] * x50; a3 -= l4[3] * x51; a0 -= l5[0] * x52; a1 -= l5[1] * x53; a2 -= l5[2] * x54; a3 -= l5[3] * x55; x56 = (a0 + a1) + (a2 + a3); } INV_SB();
    l0 = INV_LD(57, 8); l1 = INV_LD(57, 9); l2 = INV_LD(57, 10); l3 = INV_LD(57, 11); l4 = INV_LD(57, 12); l5 = INV_LD(57, 13); l6 = INV_LD(57, 14); pa0 = INV_LD(58, 0); pa1 = INV_LD(58, 1); pa2 = INV_LD(58, 2); pa3 = INV_LD(58, 3); pa4 = INV_LD(58, 4); pa5 = INV_LD(58, 5); pa6 = INV_LD(58, 6); pa7 = INV_LD(58, 7); INV_SB();
    { int li = lane; asm volatile("" : "+v"(li)); float a0 = (li == 57) ? 1.f : 0.f, a1 = 0.f, a2 = 0.f, a3 = 0.f; a0 -= pb0[0] * x0; a1 -= pb0[1] * x1; a2 -= pb0[2] * x2; a3 -= pb0[3] * x3; a0 -= pb1[0] * x4; a1 -= pb1[1] * x5; a2 -= pb1[2] * x6; a3 -= pb1[3] * x7; a0 -= pb2[0] * x8; a1 -= pb2[1] * x9; a2 -= pb2[2] * x10; a3 -= pb2[3] * x11; a0 -= pb3[0] * x12; a1 -= pb3[1] * x13; a2 -= pb3[2] * x14; a3 -= pb3[3] * x15; a0 -= pb4[0] * x16; a1 -= pb4[1] * x17; a2 -= pb4[2] * x18; a3 -= pb4[3] * x19; a0 -= pb5[0] * x20; a1 -= pb5[1] * x21; a2 -= pb5[2] * x22; a3 -= pb5[3] * x23; a0 -= pb6[0] * x24; a1 -= pb6[1] * x25; a2 -= pb6[2] * x26; a3 -= pb6[3] * x27; a0 -= pb7[0] * x28; a1 -= pb7[1] * x29; a2 -= pb7[2] * x30; a3 -= pb7[3] * x31; a0 -= l0[0] * x32; a1 -= l0[1] * x33; a2 -= l0[2] * x34; a3 -= l0[3] * x35; a0 -= l1[0] * x36; a1 -= l1[1] * x37; a2 -= l1[2] * x38; a3 -= l1[3] * x39; a0 -= l2[0] * x40; a1 -= l2[1] * x41; a2 -= l2[2] * x42; a3 -= l2[3] * x43; a0 -= l3[0] * x44; a1 -= l3[1] * x45; a2 -= l3[2] * x46; a3 -= l3[3] * x47; a0 -= l4[0] * x48; a1 -= l4[1] * x49; a2 -= l4[2] * x50; a3 -= l4[3] * x51; a0 -= l5[0] * x52; a1 -= l5[1] * x53; a2 -= l5[2] * x54; a3 -= l5[3] * x55; a0 -= l6[0] * x56; x57 = (a0 + a1) + (a2 + a3); } INV_SB();
    l0 = INV_LD(58, 8); l1 = INV_LD(58, 9); l2 = INV_LD(58, 10); l3 = INV_LD(58, 11); l4 = INV_LD(58, 12); l5 = INV_LD(58, 13); l6 = INV_LD(58, 14); pb0 = INV_LD(59, 0); pb1 = INV_LD(59, 1); pb2 = INV_LD(59, 2); pb3 = INV_LD(59, 3); pb4 = INV_LD(59, 4); pb5 = INV_LD(59, 5); pb6 = INV_LD(59, 6); pb7 = INV_LD(59, 7); INV_SB();
    { int li = lane; asm volatile("" : "+v"(li)); float a0 = (li == 58) ? 1.f : 0.f, a1 = 0.f, a2 = 0.f, a3 = 0.f; a0 -= pa0[0] * x0; a1 -= pa0[1] * x1; a2 -= pa0[2] * x2; a3 -= pa0[3] * x3; a0 -= pa1[0] * x4; a1 -= pa1[1] * x5; a2 -= pa1[2] * x6; a3 -= pa1[3] * x7; a0 -= pa2[0] * x8; a1 -= pa2[1] * x9; a2 -= pa2[2] * x10; a3 -= pa2[3] * x11; a0 -= pa3[0] * x12; a1 -= pa3[1] * x13; a2 -= pa3[2] * x14; a3 -= pa3[3] * x15; a0 -= pa4[0] * x16; a1 -= pa4[1] * x17; a2 -= pa4[2] * x18; a3 -= pa4[3] * x19; a0 -= pa5[0] * x20; a1 -= pa5[1] * x21; a2 -= pa5[2] * x22; a3 -= pa5[3] * x23; a0 -= pa6[0] * x24; a1 -= pa6[1] * x25; a2 -= pa6[2] * x26; a3 -= pa6[3] * x27; a0 -= pa7[0] * x28; a1 -= pa7[1] * x29; a2 -= pa7[2] * x30; a3 -= pa7[3] * x31; a0 -= l0[0] * x32; a1 -= l0[1] * x33; a2 -= l0[2] * x34; a3 -= l0[3] * x35; a0 -= l1[0] * x36; a1 -= l1[1] * x37; a2 -= l1[2] * x38; a3 -= l1[3] * x39; a0 -= l2[0] * x40; a1 -= l2[1] * x41; a2 -= l2[2] * x42; a3 -= l2[3] * x43; a0 -= l3[0] * x44; a1 -= l3[1] * x45; a2 -= l3[2] * x46; a3 -= l3[3] * x47; a0 -= l4[0] * x48; a1 -= l4[1] * x49; a2 -= l4[2] * x50; a3 -= l4[3] * x51; a0 -= l5[0] * x52; a1 -= l5[1] * x53; a2 -= l5[2] * x54; a3 -= l5[3] * x55; a0 -= l6[0] * x56; a1 -= l6[1] * x57; x58 = (a0 + a1) + (a2 + a3); } INV_SB();
    l0 = INV_LD(59, 8); l1 = INV_LD(59, 9); l2 = INV_LD(59, 10); l3 = INV_LD(59, 11); l4 = INV_LD(59, 12); l5 = INV_LD(59, 13); l6 = INV_LD(59, 14); pa0 = INV_LD(60, 0); pa1 = INV_LD(60, 1); pa2 = INV_LD(60, 2); pa3 = INV_LD(60, 3); pa4 = INV_LD(60, 4); pa5 = INV_LD(60, 5); pa6 = INV_LD(60, 6); pa7 = INV_LD(60, 7); INV_SB();
    { int li = lane; asm volatile("" : "+v"(li)); float a0 = (li == 59) ? 1.f : 0.f, a1 = 0.f, a2 = 0.f, a3 = 0.f; a0 -= pb0[0] * x0; a1 -= pb0[1] * x1; a2 -= pb0[2] * x2; a3 -= pb0[3] * x3; a0 -= pb1[0] * x4; a1 -= pb1[1] * x5; a2 -= pb1[2] * x6; a3 -= pb1[3] * x7; a0 -= pb2[0] * x8; a1 -= pb2[1] * x9; a2 -= pb2[2] * x10; a3 -= pb2[3] * x11; a0 -= pb3[0] * x12; a1 -= pb3[1] * x13; a2 -= pb3[2] * x14; a3 -= pb3[3] * x15; a0 -= pb4[0] * x16; a1 -= pb4[1] * x17; a2 -= pb4[2] * x18; a3 -= pb4[3] * x19; a0 -= pb5[0] * x20; a1 -= pb5[1] * x21; a2 -= pb5[2] * x22; a3 -= pb5[3] * x23; a0 -= pb6[0] * x24; a1 -= pb6[1] * x25; a2 -= pb6[2] * x26; a3 -= pb6[3] * x27; a0 -= pb7[0] * x28; a1 -= pb7[1] * x29; a2 -= pb7[2] * x30; a3 -= pb7[3] * x31; a0 -= l0[0] * x32; a1 -= l0[1] * x33; a2 -= l0[2] * x34; a3 -= l0[3] * x35; a0 -= l1[0] * x36; a1 -= l1[1] * x37; a2 -= l1[2] * x38; a3 -= l1[3] * x39; a0 -= l2[0] * x40; a1 -= l2[1] * x41; a2 -= l2[2] * x42; a3 -= l2[3] * x43; a0 -= l3[0] * x44; a1 -= l3[1] * x45; a2 -= l3[2] * x46; a3 -= l3[3] * x47; a0 -= l4[0] * x48; a1 -= l4[1] * x49; a2 -= l4[2] * x50; a3 -= l4[3] * x51; a0 -= l5[0] * x52; a1 -= l5[1] * x53; a2 -= l5[2] * x54; a3 -= l5[3] * x55; a0 -= l6[0] * x56; a1 -= l6[1] * x57; a2 -= l6[2] * x58; x59 = (a0 + a1) + (a2 + a3); } INV_SB();
    l0 = INV_LD(60, 8); l1 = INV_LD(60, 9); l2 = INV_LD(60, 10); l3 = INV_LD(60, 11); l4 = INV_LD(60, 12); l5 = INV_LD(60, 13); l6 = INV_LD(60, 14); pb0 = INV_LD(61, 0); pb1 = INV_LD(61, 1); pb2 = INV_LD(61, 2); pb3 = INV_LD(61, 3); pb4 = INV_LD(61, 4); pb5 = INV_LD(61, 5); pb6 = INV_LD(61, 6); pb7 = INV_LD(61, 7); INV_SB();
    { int li = lane; asm volatile("" : "+v"(li)); float a0 = (li == 60) ? 1.f : 0.f, a1 = 0.f, a2 = 0.f, a3 = 0.f; a0 -= pa0[0] * x0; a1 -= pa0[1] * x1; a2 -= pa0[2] * x2; a3 -= pa0[3] * x3; a0 -= pa1[0] * x4; a1 -= pa1[1] * x5; a2 -= pa1[2] * x6; a3 -= pa1[3] * x7; a0 -= pa2[0] * x8; a1 -= pa2[1] * x9; a2 -= pa2[2] * x10; a3 -= pa2[3] * x11; a0 -= pa3[0] * x12; a1 -= pa3[1] * x13; a2 -= pa3[2] * x14; a3 -= pa3[3] * x15; a0 -= pa4[0] * x16; a1 -= pa4[1] * x17; a2 -= pa4[2] * x18; a3 -= pa4[3] * x19; a0 -= pa5[0] * x20; a1 -= pa5[1] * x21; a2 -= pa5[2] * x22; a3 -= pa5[3] * x23; a0 -= pa6[0] * x24; a1 -= pa6[1] * x25; a2 -= pa6[2] * x26; a3 -= pa6[3] * x27; a0 -= pa7[0] * x28; a1 -= pa7[1] * x29; a2 -= pa7[2] * x30; a3 -= pa7[3] * x31; a0 -= l0[0] * x32; a1 -= l0[1] * x33; a2 -= l0[2] * x34; a3 -= l0[3] * x35; a0 -= l1[0] * x36; a1 -= l1[1] * x37; a2 -= l1[2] * x38; a3 -= l1[3] * x39; a0 -= l2[0] * x40; a1 -= l2[1] * x41; a2 -= l2[2] * x42; a3 -= l2[3] * x43; a0 -= l3[0] * x44; a1 -= l3[1] * x45; a2 -= l3[2] * x46; a3 -= l3[3] * x47; a0 -= l4[0] * x48; a1 -= l4[1] * x49; a2 -= l4[2] * x50; a3 -= l4[3] * x51; a0 -= l5[0] * x52; a1 -= l5[1] * x53; a2 -= l5[2] * x54; a3 -= l5[3] * x55; a0 -= l6[0] * x56; a1 -= l6[1] * x57; a2 -= l6[2] * x58; a3 -= l6[3] * x59; x60 = (a0 + a1) + (a2 + a3); } INV_SB();
    l0 = INV_LD(61, 8); l1 = INV_LD(61, 9); l2 = INV_LD(61, 10); l3 = INV_LD(61, 11); l4 = INV_LD(61, 12); l5 = INV_LD(61, 13); l6 = INV_LD(61, 14); l7 = INV_LD(61, 15); pa0 = INV_LD(62, 0); pa1 = INV_LD(62, 1); pa2 = INV_LD(62, 2); pa3 = INV_LD(62, 3); pa4 = INV_LD(62, 4); pa5 = INV_LD(62, 5); pa6 = INV_LD(62, 6); pa7 = INV_LD(62, 7); INV_SB();
    { int li = lane; asm volatile("" : "+v"(li)); float a0 = (li == 61) ? 1.f : 0.f, a1 = 0.f, a2 = 0.f, a3 = 0.f; a0 -= pb0[0] * x0; a1 -= pb0[1] * x1; a2 -= pb0[2] * x2; a3 -= pb0[3] * x3; a0 -= pb1[0] * x4; a1 -= pb1[1] * x5; a2 -= pb1[2] * x6; a3 -= pb1[3] * x7; a0 -= pb2[0] * x8; a1 -= pb2[1] * x9; a2 -= pb2[2] * x10; a3 -= pb2[3] * x11; a0 -= pb3[0] * x12; a1 -= pb3[1] * x13; a2 -= pb3[2] * x14; a3 -= pb3[3] * x15; a0 -= pb4[0] * x16; a1 -= pb4[1] * x17; a2 -= pb4[2] * x18; a3 -= pb4[3] * x19; a0 -= pb5[0] * x20; a1 -= pb5[1] * x21; a2 -= pb5[2] * x22; a3 -= pb5[3] * x23; a0 -= pb6[0] * x24; a1 -= pb6[1] * x25; a2 -= pb6[2] * x26; a3 -= pb6[3] * x27; a0 -= pb7[0] * x28; a1 -= pb7[1] * x29; a2 -= pb7[2] * x30; a3 -= pb7[3] * x31; a0 -= l0[0] * x32; a1 -= l0[1] * x33; a2 -= l0[2] * x34; a3 -= l0[3] * x35; a0 -= l1[0] * x36; a1 -= l1[1] * x37; a2 -= l1[2] * x38; a3 -= l1[3] * x39; a0 -= l2[0] * x40; a1 -= l2[1] * x41; a2 -= l2[2] * x42; a3 -= l2[3] * x43; a0 -= l3[0] * x44; a1 -= l3[1] * x45; a2 -= l3[2] * x46; a3 -= l3[3] * x47; a0 -= l4[0] * x48; a1 -= l4[1] * x49; a2 -= l4[2] * x50; a3 -= l4[3] * x51; a0 -= l5[0] * x52; a1 -= l5[1] * x53; a2 -= l5[2] * x54; a3 -= l5[3] * x55; a0 -= l6[0] * x56; a1 -= l6[1] * x57; a2 -= l6[2] * x58; a3 -= l6[3] * x59; a0 -= l7[0] * x60; x61 = (a0 + a1) + (a2 + a3); } INV_SB();
    l0 = INV_LD(62, 8); l1 = INV_LD(62, 9); l2 = INV_LD(62, 10); l3 = INV_LD(62, 11); l4 = INV_LD(62, 12); l5 = INV_LD(62, 13); l6 = INV_LD(62, 14); l7 = INV_LD(62, 15); pb0 = INV_LD(63, 0); pb1 = INV_LD(63, 1); pb2 = INV_LD(63, 2); pb3 = INV_LD(63, 3); pb4 = INV_LD(63, 4); pb5 = INV_LD(63, 5); pb6 = INV_LD(63, 6); pb7 = INV_LD(63, 7); INV_SB();
    { int li = lane; asm volatile("" : "+v"(li)); float a0 = (li == 62) ? 1.f : 0.f, a1 = 0.f, a2 = 0.f, a3 = 0.f; a0 -= pa0[0] * x0; a1 -= pa0[1] * x1; a2 -= pa0[2] * x2; a3 -= pa0[3] * x3; a0 -= pa1[0] * x4; a1 -= pa1[1] * x5; a2 -= pa1[2] * x6; a3 -= pa1[3] * x7; a0 -= pa2[0] * x8; a1 -= pa2[1] * x9; a2 -= pa2[2] * x10; a3 -= pa2[3] * x11; a0 -= pa3[0] * x12; a1 -= pa3[1] * x13; a2 -= pa3[2] * x14; a3 -= pa3[3] * x15; a0 -= pa4[0] * x16; a1 -= pa4[1] * x17; a2 -= pa4[2] * x18; a3 -= pa4[3] * x19; a0 -= pa5[0] * x20; a1 -= pa5[1] * x21; a2 -= pa5[2] * x22; a3 -= pa5[3] * x23; a0 -= pa6[0] * x24; a1 -= pa6[1] * x25; a2 -= pa6[2] * x26; a3 -= pa6[3] * x27; a0 -= pa7[0] * x28; a1 -= pa7[1] * x29; a2 -= pa7[2] * x30; a3 -= pa7[3] * x31; a0 -= l0[0] * x32; a1 -= l0[1] * x33; a2 -= l0[2] * x34; a3 -= l0[3] * x35; a0 -= l1[0] * x36; a1 -= l1[1] * x37; a2 -= l1[2] * x38; a3 -= l1[3] * x39; a0 -= l2[0] * x40; a1 -= l2[1] * x41; a2 -= l2[2] * x42; a3 -= l2[3] * x43; a0 -= l3[0] * x44; a1 -= l3[1] * x45; a2 -= l3[2] * x46; a3 -= l3[3] * x47; a0 -= l4[0] * x48; a1 -= l4[1] * x49; a2 -= l4[2] * x50; a3 -= l4[3] * x51; a0 -= l5[0] * x52; a1 -= l5[1] * x53; a2 -= l5[2] * x54; a3 -= l5[3] * x55; a0 -= l6[0] * x56; a1 -= l6[1] * x57; a2 -= l6[2] * x58; a3 -= l6[3] * x59; a0 -= l7[0] * x60; a1 -= l7[1] * x61; x62 = (a0 + a1) + (a2 + a3); } INV_SB();
    l0 = INV_LD(63, 8); l1 = INV_LD(63, 9); l2 = INV_LD(63, 10); l3 = INV_LD(63, 11); l4 = INV_LD(63, 12); l5 = INV_LD(63, 13); l6 = INV_LD(63, 14); l7 = INV_LD(63, 15); INV_SB();
    { int li = lane; asm volatile("" : "+v"(li)); float a0 = (li == 63) ? 1.f : 0.f, a1 = 0.f, a2 = 0.f, a3 = 0.f; a0 -= pb0[0] * x0; a1 -= pb0[1] * x1; a2 -= pb0[2] * x2; a3 -= pb0[3] * x3; a0 -= pb1[0] * x4; a1 -= pb1[1] * x5; a2 -= pb1[2] * x6; a3 -= pb1[3] * x7; a0 -= pb2[0] * x8; a1 -= pb2[1] * x9; a2 -= pb2[2] * x10; a3 -= pb2[3] * x11; a0 -= pb3[0] * x12; a1 -= pb3[1] * x13; a2 -= pb3[2] * x14; a3 -= pb3[3] * x15; a0 -= pb4[0] * x16; a1 -= pb4[1] * x17; a2 -= pb4[2] * x18; a3 -= pb4[3] * x19; a0 -= pb5[0] * x20; a1 -= pb5[1] * x21; a2 -= pb5[2] * x22; a3 -= pb5[3] * x23; a0 -= pb6[0] * x24; a1 -= pb6[1] * x25; a2 -= pb6[2] * x26; a3 -= pb6[3] * x27; a0 -= pb7[0] * x28; a1 -= pb7[1] * x29; a2 -= pb7[2] * x30; a3 -= pb7[3] * x31; a0 -= l0[0] * x32; a1 -= l0[1] * x33; a2 -= l0[2] * x34; a3 -= l0[3] * x35; a0 -= l1[0] * x36; a1 -= l1[1] * x37; a2 -= l1[2] * x38; a3 -= l1[3] * x39; a0 -= l2[0] * x40; a1 -= l2[1] * x41; a2 -= l2[2] * x42; a3 -= l2[3] * x43; a0 -= l3[0] * x44; a1 -= l3[1] * x45; a2 -= l3[2] * x46; a3 -= l3[3] * x47; a0 -= l4[0] * x48; a1 -= l4[1] * x49; a2 -= l4[2] * x50; a3 -= l4[3] * x51; a0 -= l5[0] * x52; a1 -= l5[1] * x53; a2 -= l5[2] * x54; a3 -= l5[3] * x55; a0 -= l6[0] * x56; a1 -= l6[1] * x57; a2 -= l6[2] * x58; a3 -= l6[3] * x59; a0 -= l7[0] * x60; a1 -= l7[1] * x61; a2 -= l7[2] * x62; x63 = (a0 + a1) + (a2 + a3); } INV_SB();
    asm volatile("s_waitcnt lgkmcnt(0)" ::: "memory");
    As[0 * 65 + lane] = x0; As[1 * 65 + lane] = x1; As[2 * 65 + lane] = x2; As[3 * 65 + lane] = x3; As[4 * 65 + lane] = x4; As[5 * 65 + lane] = x5; As[6 * 65 + lane] = x6; As[7 * 65 + lane] = x7;
    As[8 * 65 + lane] = x8; As[9 * 65 + lane] = x9; As[10 * 65 + lane] = x10; As[11 * 65 + lane] = x11; As[12 * 65 + lane] = x12; As[13 * 65 + lane] = x13; As[14 * 65 + lane] = x14; As[15 * 65 + lane] = x15;
    As[16 * 65 + lane] = x16; As[17 * 65 + lane] = x17; As[18 * 65 + lane] = x18; As[19 * 65 + lane] = x19; As[20 * 65 + lane] = x20; As[21 * 65 + lane] = x21; As[22 * 65 + lane] = x22; As[23 * 65 + lane] = x23;
    As[24 * 65 + lane] = x24; As[25 * 65 + lane] = x25; As[26 * 65 + lane] = x26; As[27 * 65 + lane] = x27; As[28 * 65 + lane] = x28; As[29 * 65 + lane] = x29; As[30 * 65 + lane] = x30; As[31 * 65 + lane] = x31;
    As[32 * 65 + lane] = x32; As[33 * 65 + lane] = x33; As[34 * 65 + lane] = x34; As[35 * 65 + lane] = x35; As[36 * 65 + lane] = x36; As[37 * 65 + lane] = x37; As[38 * 65 + lane] = x38; As[39 * 65 + lane] = x39;
    As[40 * 65 + lane] = x40; As[41 * 65 + lane] = x41; As[42 * 65 + lane] = x42; As[43 * 65 + lane] = x43; As[44 * 65 + lane] = x44; As[45 * 65 + lane] = x45; As[46 * 65 + lane] = x46; As[47 * 65 + lane] = x47;
    As[48 * 65 + lane] = x48; As[49 * 65 + lane] = x49; As[50 * 65 + lane] = x50; As[51 * 65 + lane] = x51; As[52 * 65 + lane] = x52; As[53 * 65 + lane] = x53; As[54 * 65 + lane] = x54; As[55 * 65 + lane] = x55;
    As[56 * 65 + lane] = x56; As[57 * 65 + lane] = x57; As[58 * 65 + lane] = x58; As[59 * 65 + lane] = x59; As[60 * 65 + lane] = x60; As[61 * 65 + lane] = x61; As[62 * 65 + lane] = x62; As[63 * 65 + lane] = x63;
    asm volatile("s_waitcnt lgkmcnt(0)" ::: "memory");
}
__device__ __forceinline__ void dnf_load_x(const bf16* QKV, int u, int tid, unsigned (&xr)[36]) {
    const int c = u >> 4, kh = u & 15;
    int s0, s1; if (c < 64) { s0 = (c >> 2) * 256; s1 = s0 + 256; } else { s0 = 4096 + ((c - 64) >> 4) * 1024; s1 = s0 + 1024; }
    const int cp = tid & 255, th = tid >> 8;
    const int r0 = c * 64 + th * 32 - 2;
    const bf16* base = QKV + (size_t)kh * 6144 * 512 + 2 * cp;
#pragma unroll
    for (int i = 0; i < 36; ++i) { const int rr = r0 + i; const bool ok = rr >= s0 && rr < s1; const unsigned v = *(const unsigned*)(base + (size_t)(ok ? rr : s0) * 512); xr[i] = ok ? v : 0u; }
}
__device__ __forceinline__ void phase_dn_front(const Params& p, LAS unsigned char* lds, int tid0, int lane0, int wave, int vcu, int G) {
    unsigned char* ws = p.ws; const int fl = p.flags;
    LAS float* XQK = (LAS float*)lds;
    LAS bf16* XV = (LAS bf16*)(lds + 66560);
    LAS float* Gm = (LAS float*)lds; LAS float* Pm = Gm + 64 * 65;
    LAS float* As = (LAS float*)(lds + 33280) + (wave & 3) * (64 * 68);
    LAS v4u* FB = (LAS v4u*)(lds + 105472);
    LAS float* RN = (LAS float*)(lds + 138240);
    LAS float* gcs = (LAS float*)(lds + 138752); LAS float* bes = gcs + 256;
    const bf16* QKV = (const bf16*)(ws + WS_QKV); const float* cw = p.in[11];
    const float* AB = (const float*)(ws + WS_AB); float* VEC = (float*)(ws + WS_VEC);
    unsigned xr[36]; float w0[5], w1[5];
    if (vcu < 1536) dnf_load_x(QKV, vcu, tid0, xr);
    for (int u = vcu; u < 1536; u += G) {
        const int c = u >> 4, kh = u & 15;
        int tid_o = tid0; asm volatile("" : "+v"(tid_o));
        const int tid = tid_o, lane = tid & 63, c16 = lane & 15, q4 = lane >> 4;
        if (!(fl & 4)) {
            const int cp = tid & 255, th = tid >> 8;
            int gcol, lcol; if (cp < 64) { gcol = kh * 128 + 2 * cp; lcol = 2 * cp; } else if (cp < 128) { gcol = 2048 + kh * 128 + 2 * (cp - 64); lcol = 128 + 2 * (cp - 64); } else { gcol = 4096 + kh * 256 + 2 * (cp - 128); lcol = 2 * (cp - 128); }
            if ((G & 15) != 0 || u == vcu) {
#pragma unroll
                for (int j = 0; j < 5; ++j) { w0[j] = cw[j * 8192 + gcol]; w1[j] = cw[j * 8192 + gcol + 1]; } }
#pragma unroll
            for (int i = 0; i < 32; ++i) {
                float a0 = 0.f, a1 = 0.f;
#pragma unroll
                for (int j = 0; j < 5; ++j) { a0 += w0[j] * bflo(xr[i + j]); a1 += w1[j] * bfhi(xr[i + j]); }
                a0 = silu_f(a0); a1 = silu_f(a1);
                const int t = th * 32 + i;
                if (cp < 128) *(LAS f32x2*)(XQK + t * 260 + lcol) = (f32x2){a0, a1}; else *(LAS unsigned*)(XV + t * 264 + lcol) = pk2(a0, a1);
            }
        }
        LDS_BAR();
        if (!(fl & 4))
        { float ra[8][4];
#pragma unroll
          for (int tt = 0; tt < 8; ++tt) { const LAS float* r = XQK + (wave * 8 + tt) * 260; ra[tt][0] = r[lane]; ra[tt][1] = r[64 + lane]; ra[tt][2] = r[128 + lane]; ra[tt][3] = r[192 + lane]; }
          __builtin_amdgcn_sched_barrier(0);
          float sq[8], sk[8];
#pragma unroll
          for (int tt = 0; tt < 8; ++tt) { sq[tt] = ra[tt][0] * ra[tt][0] + ra[tt][1] * ra[tt][1]; sk[tt] = ra[tt][2] * ra[tt][2] + ra[tt][3] * ra[tt][3]; }
#pragma unroll
          for (int o = 1; o < 64; o <<= 1) {
#pragma unroll
              for (int tt = 0; tt < 8; ++tt) { sq[tt] += __shfl_xor(sq[tt], o); sk[tt] += __shfl_xor(sk[tt], o); } }
#pragma unroll
          for (int tt = 0; tt < 8; ++tt) if (lane == tt) { const int t = wave * 8 + tt; RN[t] = (1.0f / sqrtf(sq[tt] + 1e-6f)) * 0.08838834764831845f; RN[64 + t] = 1.0f / sqrtf(sk[tt] + 1e-6f); } }
        LDS_BAR();
        if (!(fl & 2)) {
            v4u* KAo = (v4u*)(ws + WS_KA) + (size_t)u * 1024; v4u* QAo = (v4u*)(ws + WS_QA) + (size_t)u * 1024; v4u* KTo = (v4u*)(ws + WS_KT) + (size_t)u * 1024;
            v4u* VTo = (v4u*)(ws + WS_VT) + (size_t)(c * 32 + 2 * kh) * 1024;
            for (int pi = tid; pi < 1024; pi += 512) {
                const int mt = pi >> 8, ks = (pi >> 6) & 3, ln = pi & 63, t = 16 * mt + (ln & 15), kq = ln >> 4;
                const LAS float* rq = XQK + t * 260 + 32 * ks + 4 * kq;
                const v4u oq = pack8f(*(const LAS f32x4*)rq * RN[t], *(const LAS f32x4*)(rq + 16) * RN[t]);
                const v4u ok = pack8f(*(const LAS f32x4*)(rq + 128) * RN[64 + t], *(const LAS f32x4*)(rq + 144) * RN[64 + t]);
                QAo[pi] = oq; KAo[pi] = ok; FB[pi] = ok; FB[1024 + pi] = oq;
            }
            for (int pi = tid; pi < 1024; pi += 512) {
                const int mt = pi >> 7, ks = (pi >> 6) & 1, ln = pi & 63, dk = 16 * mt + (ln & 15), kq = ln >> 4, tb = 32 * ks + 4 * kq;
                float e[8], rn[8];
#pragma unroll
                for (int j = 0; j < 8; ++j) { const int t = tb + 16 * (j >> 2) + (j & 3); e[j] = XQK[t * 260 + 128 + dk]; rn[j] = RN[64 + t]; }
                __builtin_amdgcn_sched_barrier(0);
#pragma unroll
                for (int j = 0; j < 8; ++j) e[j] *= rn[j];
                v4u o; o.x = pk2(e[0], e[1]); o.y = pk2(e[2], e[3]); o.z = pk2(e[4], e[5]); o.w = pk2(e[6], e[7]); KTo[pi] = o;
            }
            for (int pi = tid; pi < 2048; pi += 512) {
                const int e2 = pi >> 10, q = pi & 1023, sl = q >> 7, hf = (q >> 6) & 1, ln = q & 63, dv = 16 * sl + (ln & 15), qq = ln >> 4;
                unsigned e[8];
#pragma unroll
                for (int j = 0; j < 8; ++j) { const int t = 16 * (2 * hf + (j >> 2)) + 4 * qq + (j & 3); e[j] = XV[t * 264 + e2 * 128 + dv]; }
                __builtin_amdgcn_sched_barrier(0);
                v4u o; o.x = e[0] | (e[1] << 16); o.y = e[2] | (e[3] << 16); o.z = e[4] | (e[5] << 16); o.w = e[6] | (e[7] << 16); VTo[pi] = o;
            }
            if (wave < 4) {
                const int su = wave, d = su & 1, h = 2 * kh + (su >> 1); const size_t row = (size_t)64 * c + lane;
                const float a = AB[row * 128 + d * 64 + h], b = AB[row * 128 + d * 64 + 32 + h];
                const float x = a + p.in[13][d * 32 + h], sp = x > 20.f ? x : log1pf(expf(x));
                const float lg = -expf(p.in[12][d * 32 + h]) * sp, beta = 1.0f / (1.0f + expf(-b));
                float pre = lg;
#pragma unroll
                for (int o = 1; o < 64; o <<= 1) { const float v = __shfl_up(pre, o); if (lane >= o) pre += v; }
                const float total = __shfl(pre, 63);
                const float gc = d ? (total - pre + lg) : pre;
                gcs[su * 64 + lane] = gc; bes[su * 64 + lane] = beta;
                float* V = VEC + (size_t)((c * 32 + h) * 2 + d) * 192; V[lane] = expf(gc); V[64 + lane] = expf(total - gc); if (lane == 0) V[128] = expf(total);
            }
        }
        LDS_BAR();
        if (!(fl & 8)) {
            const int mat = wave >> 2, mt = wave & 3;
            bf16x8 af[4];
#pragma unroll
            for (int ks = 0; ks < 4; ++ks) af[ks] = as_frag(FB[(mat ? 1024 : 0) + (mt * 4 + ks) * 64 + lane]);
            LAS float* M = mat ? Pm : Gm;
#pragma unroll
            for (int nt = 0; nt < 4; ++nt) { f32x4 acc = {0.f, 0.f, 0.f, 0.f};
#pragma unroll
                for (int ks = 0; ks < 4; ++ks) acc = MFMA16(af[ks], as_frag(FB[(nt * 4 + ks) * 64 + lane]), acc);
#pragma unroll
                for (int r = 0; r < 4; ++r) M[(16 * mt + 4 * q4 + r) * 65 + 16 * nt + c16] = acc[r]; }
        }
        LDS_BAR();
        if (fl & 1) { } else if (wave < 4) {
            const int su = wave, d = su & 1, h = 2 * kh + (su >> 1);
            const LAS float* gc_ = gcs + su * 64; const LAS float* be_ = bes + su * 64;
            if (!(fl & 32)) { const int j = d ? 63 - lane : lane; const float gcj = gc_[j];
#pragma unroll
              for (int b0 = 0; b0 < 64; b0 += 16) { float gi[16], bi[16], gm[16];
#pragma unroll
                  for (int k = 0; k < 16; ++k) { const int ip = b0 + k, i = d ? 63 - ip : ip; gi[k] = gc_[i]; bi[k] = be_[i]; gm[k] = Gm[i * 65 + j]; }
                  __builtin_amdgcn_sched_barrier(0);
#pragma unroll
                  for (int k = 0; k < 16; ++k) { const int ip = b0 + k; As[ip * 68 + lane] = (lane < ip) ? bi[k] * gm[k] * __expf(fminf(gi[k] - gcj, 0.f)) : 0.f; }
                  __builtin_amdgcn_sched_barrier(0); } }
            LDS_WAIT();
            if (!(fl & 16)) tri_inverse_64(As, lane);
            if (u + G < 1536) dnf_load_x(QKV, u + G, tid, xr);
            int c16b = c16, q4b = q4; asm volatile("" : "+v"(c16b), "+v"(q4b));
            v4u* TBo = (v4u*)(ws + WS_TB) + (size_t)((c * 32 + h) * 2 + d) * 512 + 16 * q4b + c16b;
            if (!(fl & 64))
#pragma unroll
            for (int ps = 0; ps < 8; ++ps) { const int mt = ps >> 1, ks = ps & 1, i = 16 * mt + c16b, ip = d ? 63 - i : i; float e[8];
                float bb[8];
#pragma unroll
                for (int k = 0; k < 8; ++k) { const int cc = 32 * ks + 16 * (k >> 2) + 4 * q4b + (k & 3), cp = d ? 63 - cc : cc; e[k] = As[ip * 65 + cp]; bb[k] = be_[cc]; }
                __builtin_amdgcn_sched_barrier(0);
#pragma unroll
                for (int k = 0; k < 8; ++k) e[k] *= bb[k];
                v4u o; o.x = pk2(e[0], e[1]); o.y = pk2(e[2], e[3]); o.z = pk2(e[4], e[5]); o.w = pk2(e[6], e[7]); TBo[ps * 64] = o; asm volatile("" ::: "memory"); }
        } else {
            const int su = wave - 4, d = su & 1, h = 2 * kh + (su >> 1);
            if (u + G < 1536) dnf_load_x(QKV, u + G, tid, xr);
            const LAS float* gc_ = gcs + su * 64;
            v4u* INo = (v4u*)(ws + WS_IN) + (size_t)((c * 32 + h) * 2 + d) * 512 + lane;
            if (!(fl & 128))
#pragma unroll
            for (int ps = 0; ps < 8; ++ps) { const int mt = ps >> 1, ks = ps & 1, i = 16 * mt + c16; const float gci = gc_[i]; float e[8];
                float gj[8];
#pragma unroll
                for (int k = 0; k < 8; ++k) { const int jn = 32 * ks + 16 * (k >> 2) + 4 * q4 + (k & 3); e[k] = Pm[i * 65 + jn]; gj[k] = gc_[jn]; }
                __builtin_amdgcn_sched_barrier(0);
#pragma unroll
                for (int k = 0; k < 8; ++k) { const int jn = 32 * ks + 16 * (k >> 2) + 4 * q4 + (k & 3); const bool ok = d ? (jn >= i) : (jn <= i);
                    e[k] = ok ? e[k] * __expf(fminf(gci - gj[k], 0.f)) : 0.f; }
                v4u o; o.x = pk2(e[0], e[1]); o.y = pk2(e[2], e[3]); o.z = pk2(e[4], e[5]); o.w = pk2(e[6], e[7]); INo[ps * 64] = o; asm volatile("" ::: "memory"); }
        }
        LDS_BAR();
    }
}

#ifndef DQ_SYNC
#define DQ_SYNC 0
#endif
constexpr int DQ_BUF = 50176, DQ_QA = 0, DQ_KT = 16384, DQ_TB = 32768, DQ_IN = 40960, DQ_VEC = 49152, DQ_KA = 2 * DQ_BUF, DQ_V = DQ_KA + 16384;
struct DnStep { int c, h, d; };
__device__ __forceinline__ void dq_group(int gi, int& lat, int& seq, int& h, int& d) { lat = gi < 128; const int gj = lat ? gi : gi - 128; seq = lat ? 16 + (gj >> 6) : (gj >> 6); h = (gj >> 1) & 31; d = gj & 1; }
__device__ __forceinline__ int dq_chunk(int lat, int seq, int d, int n) { const int nch = lat ? 16 : 4, cbase = lat ? 64 + 16 * (seq - 16) : 4 * seq; return cbase + (d ? nch - 1 - n : n); }
#define DMA16(gsrc, ldst) __builtin_amdgcn_global_load_lds((const unsigned*)(gsrc), (LAS unsigned*)(ldst), 16, 0, 0)
__device__ __forceinline__ void dq_issue_db(unsigned char* ws, LAS unsigned char* buf, const DnStep st, int wave, int lane) {
    const int kh = st.h >> 1; const size_t ck = (size_t)(st.c * 16 + kh) * 16384, chd = (size_t)((st.c * 32 + st.h) * 2 + st.d);
    const unsigned char* qa = ws + WS_QA + ck + lane * 16; const unsigned char* kt = ws + WS_KT + ck + lane * 16;
    const unsigned char* tb = ws + WS_TB + chd * 8192 + lane * 16; const unsigned char* in = ws + WS_IN + chd * 8192 + lane * 16;
#pragma unroll
    for (int i = 0; i < 2; ++i) { const int pc = wave + 8 * i; DMA16(qa + pc * 1024, buf + DQ_QA + pc * 1024); DMA16(kt + pc * 1024, buf + DQ_KT + pc * 1024); }
    DMA16(tb + wave * 1024, buf + DQ_TB + wave * 1024); DMA16(in + wave * 1024, buf + DQ_IN + wave * 1024);
    if (wave == 0) DMA16(ws + WS_VEC + chd * 768 + lane * 16, buf + DQ_VEC);
}
__device__ __forceinline__ void dq_issue_sb(unsigned char* ws, LAS unsigned char* lds, const DnStep st, int wave, int lane) {
    const int kh = st.h >> 1; const unsigned char* ka = ws + WS_KA + (size_t)(st.c * 16 + kh) * 16384 + lane * 16;
    const unsigned char* vt = ws + WS_VT + (size_t)(st.c * 32 + st.h) * 16384 + wave * 2048 + lane * 16;
#pragma unroll
    for (int i = 0; i < 2; ++i) { const int pc = wave + 8 * i; DMA16(ka + pc * 1024, lds + DQ_KA + pc * 1024); DMA16(vt + i * 1024, lds + DQ_V + wave * 2048 + i * 1024); }
}
__device__ __forceinline__ bf16x8 pack2(const f32x4 a, const f32x4 b) { return __builtin_bit_cast(bf16x8, pack8f(a, b)); }
__device__ __forceinline__ void phase_dn_seq(const Params& p, LAS unsigned char* lds, int lane, int wave, int vcu, int G) {
    unsigned char* ws = p.ws;
    const int c16 = lane & 15, q4 = lane >> 4;
    const int total_groups = (G == 256) ? (vcu < 128 ? 3 : 6) : ((1152 - vcu + G - 1) / G);
#define DQ_GROUP_AT(gp) ((G == 256) ? (vcu < 128 ? ((gp) == 0 ? vcu : 128 + 2 * vcu + (gp) - 1) : 384 + 6 * (vcu - 128) + (gp)) : vcu + (gp) * G)
    int gpos = 0, gi = DQ_GROUP_AT(0), n = 0, lat = 0, seq = 0, h = 0, d = 0, nch = 0;
    if (total_groups <= 0 || gi >= 1152) return;
    dq_group(gi, lat, seq, h, d); nch = lat ? 16 : 4;
    DnStep cur{dq_chunk(lat, seq, d, 0), h, d};
    dq_issue_db(ws, lds, cur, wave, lane); dq_issue_sb(ws, lds, cur, wave, lane);
    asm volatile("s_waitcnt vmcnt(0)\n\ts_barrier" ::: "memory");
    f32x4 S[8];
    int par = 0;
    for (;;) {
        if (n == 0) {
            if (lat) { const float* stp = p.in[d ? 3 : 2] + (size_t)((seq - 16) * 32 + h) * 16384 + 16 * wave + c16;
#pragma unroll
                for (int dt = 0; dt < 8; ++dt)
#pragma unroll
                    for (int r = 0; r < 4; ++r) S[dt][r] = stp[(16 * dt + 4 * q4 + r) * 128];
            } else {
#pragma unroll
                for (int dt = 0; dt < 8; ++dt) S[dt] = (f32x4){0.f, 0.f, 0.f, 0.f}; }
        }
        int n_gpos = gpos, n_gi = gi, n_n = n + 1, n_lat = lat, n_seq = seq, n_h = h, n_d = d; bool has_next = true;
        if (n_n == nch) { n_n = 0; n_gpos = gpos + 1; if (n_gpos >= total_groups) has_next = false; else { n_gi = DQ_GROUP_AT(n_gpos); dq_group(n_gi, n_lat, n_seq, n_h, n_d); } }
        const DnStep nxt{has_next ? dq_chunk(n_lat, n_seq, n_d, n_n) : cur.c, n_h, n_d};
        LAS unsigned char* buf = lds + par * DQ_BUF;
#if DQ_SYNC
        if (n != 0 || gpos != 0) { dq_issue_db(ws, buf, cur, wave, lane); dq_issue_sb(ws, lds, cur, wave, lane); asm volatile("s_waitcnt vmcnt(0)\n\ts_barrier" ::: "memory"); }
#endif
        bf16x8 Sb[4];
#pragma unroll
        for (int ks = 0; ks < 4; ++ks) Sb[ks] = pack2(S[2 * ks], S[2 * ks + 1]);
        if (has_next && !DQ_SYNC) dq_issue_db(ws, lds + (par ^ 1) * DQ_BUF, nxt, wave, lane);
        const LAS float* vec = (const LAS float*)(buf + DQ_VEC);
        f32x4 R[4];
        { const v4u v0 = *(const LAS v4u*)(lds + DQ_V + wave * 2048 + lane * 16), v1 = *(const LAS v4u*)(lds + DQ_V + wave * 2048 + 1024 + lane * 16);
          const f32x4 V[4] = {{bflo(v0.x), bfhi(v0.x), bflo(v0.y), bfhi(v0.y)}, {bflo(v0.z), bfhi(v0.z), bflo(v0.w), bfhi(v0.w)}, {bflo(v1.x), bfhi(v1.x), bflo(v1.y), bfhi(v1.y)}, {bflo(v1.z), bfhi(v1.z), bflo(v1.w), bfhi(v1.w)}};
#pragma unroll
          for (int mt = 0; mt < 4; ++mt) { f32x4 acc = {0.f, 0.f, 0.f, 0.f};
#pragma unroll
              for (int ks = 0; ks < 4; ++ks) acc = MFMA16(as_frag(*(const LAS v4u*)(lds + DQ_KA + ((mt * 4 + ks) * 64 + lane) * 16)), Sb[ks], acc);
              const f32x4 eg = *(const LAS f32x4*)(vec + 16 * mt + 4 * q4);
              R[mt] = V[mt] - eg * acc; } }
        const bf16x8 Rb[2] = {pack2(R[0], R[1]), pack2(R[2], R[3])};
        asm volatile("s_waitcnt lgkmcnt(0)\n\ts_barrier" ::: "memory");
        if (has_next && !DQ_SYNC) dq_issue_sb(ws, lds, nxt, wave, lane);
        f32x4 vn[4];
#pragma unroll
        for (int mt = 0; mt < 4; ++mt) { f32x4 acc = {0.f, 0.f, 0.f, 0.f};
#pragma unroll
            for (int ks = 0; ks < 2; ++ks) acc = MFMA16(as_frag(*(const LAS v4u*)(buf + DQ_TB + ((mt * 2 + ks) * 64 + lane) * 16)), Rb[ks], acc);
            vn[mt] = acc; }
        const bf16x8 vb[2] = {pack2(vn[0], vn[1]), pack2(vn[2], vn[3])};
#pragma unroll
        for (int mt = 0; mt < 4; ++mt) vn[mt] = vn[mt] * *(const LAS f32x4*)(vec + 64 + 16 * mt + 4 * q4);
        const bf16x8 vd[2] = {pack2(vn[0], vn[1]), pack2(vn[2], vn[3])};
        { bf16* op = (bf16*)(ws + WS_QKV) + (size_t)cur.d * MROWS * 4096 + (size_t)(64 * cur.c + 4 * q4) * 4096 + cur.h * 128 + 16 * wave + c16;
#pragma unroll
          for (int mt = 0; mt < 4; ++mt) { f32x4 acc = {0.f, 0.f, 0.f, 0.f};
#pragma unroll
              for (int ks = 0; ks < 4; ++ks) acc = MFMA16(as_frag(*(const LAS v4u*)(buf + DQ_QA + ((mt * 4 + ks) * 64 + lane) * 16)), Sb[ks], acc);
              acc = acc * *(const LAS f32x4*)(vec + 16 * mt + 4 * q4);
#pragma unroll
              for (int ks = 0; ks < 2; ++ks) acc = MFMA16(as_frag(*(const LAS v4u*)(buf + DQ_IN + ((mt * 2 + ks) * 64 + lane) * 16)), vb[ks], acc);
#pragma unroll
              for (int r = 0; r < 4; ++r) op[(size_t)(16 * mt + r) * 4096] = (bf16)f2bf(acc[r]); } }
        { const float egl = vec[128];
#pragma unroll
          for (int dt = 0; dt < 8; ++dt) { f32x4 acc = S[dt] * egl;
#pragma unroll
              for (int ks = 0; ks < 2; ++ks) acc = MFMA16(as_frag(*(const LAS v4u*)(buf + DQ_KT + ((dt * 2 + ks) * 64 + lane) * 16)), vd[ks], acc);
              S[dt] = acc; } }
        if (n + 1 == nch && !lat) {
            float* so = p.out + (d ? OUT_SB : OUT_SF) + (size_t)(seq * 32 + h) * 16384 + 16 * wave + c16;
#pragma unroll
            for (int dt = 0; dt < 8; ++dt)
#pragma unroll
                for (int r = 0; r < 4; ++r) so[(16 * dt + 4 * q4 + r) * 128] = S[dt][r]; }
        asm volatile("s_waitcnt vmcnt(0) lgkmcnt(0)\n\ts_barrier" ::: "memory");
        if (!has_next) break;
        gpos = n_gpos; gi = n_gi; n = n_n; lat = n_lat; seq = n_seq; h = n_h; d = n_d; nch = lat ? 16 : 4; cur = nxt; par ^= 1;
    }
}

__device__ __forceinline__ void phase_combine(const Params& p, int lane, int wave, int vcu, int G) {
    unsigned char* ws = p.ws;
    const bf16* OF = (const bf16*)(ws + WS_QKV); const bf16* OB = OF + (size_t)MROWS * 4096; const bf16* Z = (const bf16*)(ws + WS_Z); bf16* OG = (bf16*)(ws + WS_KA);
    const int gw = vcu * NWAVES + wave, NGW = G * NWAVES, half = lane >> 5, l32 = lane & 31;
    const f32x4 nw = *(const f32x4*)(p.in[14] + 4 * l32);
    for (int it = gw; it < MROWS * 16; it += NGW) {
        const int row = it >> 4, hv = (it & 15) * 2 + half; const size_t off = (size_t)row * 4096 + hv * 128 + 4 * l32;
        const v2u a = *(const v2u*)(OF + off), b = *(const v2u*)(OB + off), z = *(const v2u*)(Z + off);
        f32x4 o = {bflo(a.x) + bflo(b.x), bfhi(a.x) + bfhi(b.x), bflo(a.y) + bflo(b.y), bfhi(a.y) + bfhi(b.y)};
        float ss = (o[0] * o[0] + o[1] * o[1]) + (o[2] * o[2] + o[3] * o[3]);
#pragma unroll
        for (int m = 1; m < 32; m <<= 1) ss += __shfl_xor(ss, m);
        const float r = 1.0f / sqrtf(ss * (1.0f / 128.0f) + 1e-6f);
        const f32x4 zz = {silu_f(bflo(z.x)), silu_f(bfhi(z.x)), silu_f(bflo(z.y)), silu_f(bfhi(z.y))};
        const f32x4 y = o * r * nw * zz; v2u w; w.x = pk2(y[0], y[1]); w.y = pk2(y[2], y[3]); *(v2u*)(OG + off) = w;
    }
}

__device__ __forceinline__ void phase_spatial(const Params& p, LAS unsigned char* lds, int tid0, int lane0, int wave, int vcu, int G) {
    unsigned char* ws = p.ws;
    LAS bf16* VL = (LAS bf16*)lds;
    LAS bf16* WL = (LAS bf16*)(lds + 67584);
    LAS float* RS = (LAS float*)(lds + 67584 + 34816);
    LAS float* BS = RS + 256;
    LAS bf16* UL = (LAS bf16*)(lds + 67584 + 34816 + 2048);
    const bf16* H = (const bf16*)(ws + WS_QKV); bf16* UV = (bf16*)(ws + WS_Z); const float* STATS = (const float*)(ws + WS_STATS);
    const int per = (768 + G - 1) / G, u0 = vcu * per, u1 = (u0 + per < 768) ? u0 + per : 768;
    int cur_tc = -1;
    for (int u = u0; u < u1; ++u) {
        const int tc = u >> 4, g = u & 15;
        int tid_o = tid0; asm volatile("" : "+v"(tid_o));
        const int tid = tid_o, lane = tid & 63, l31 = lane & 31, hh = lane >> 5, col = 32 * wave + l31;
        LDS_BAR();
        if (tc != cur_tc) {
            const int q = tid >> 2, part = tid & 3; const f32x4* st = (const f32x4*)(STATS + (size_t)(128 * tc + q) * 128 + part * 32); f32x4 x[8];
#pragma unroll
            for (int i = 0; i < 8; ++i) x[i] = st[i];
            float s1 = 0.f, s2 = 0.f;
#pragma unroll
            for (int i = 0; i < 8; ++i) { s1 += x[i][0] + x[i][2]; s2 += x[i][1] + x[i][3]; }
            s1 += __shfl_xor(s1, 1); s1 += __shfl_xor(s1, 2); s2 += __shfl_xor(s2, 1); s2 += __shfl_xor(s2, 2);
            const float mu = s1 * (1.0f / 4096.0f), var = s2 * (1.0f / 4096.0f) - mu * mu;
            if (part == 0) { RS[2 * q] = mu; RS[2 * q + 1] = 1.0f / sqrtf(fmaxf(var, 0.f) + 1e-6f); }
            cur_tc = tc;
        }
        v4u vraw[8], wraw[4], uraw[8];
#pragma unroll
        for (int k = 0; k < 8; ++k) { const int pi = tid + 512 * k, q = pi >> 5, c8 = pi & 31; vraw[k] = *(const v4u*)(H + (size_t)(128 * tc + q) * 8192 + 4096 + 256 * g + 8 * c8); }
#pragma unroll
        for (int k = 0; k < 4; ++k) { const int pi = tid + 512 * k, pr = pi >> 4, c8 = pi & 15; wraw[k] = *(const v4u*)((const bf16*)(ws + WS_WSB) + (size_t)g * 16384 + pr * 128 + 8 * c8); }
#pragma unroll
        for (int k = 0; k < 8; ++k) { const int pi = tid + 512 * k, q = pi >> 5, c8 = pi & 31; uraw[k] = *(const v4u*)(H + (size_t)(128 * tc + q) * 8192 + 256 * g + 8 * c8); }
        const int c8v = tid & 31;
        const float* lw = p.in[18] + 256 * g + 8 * c8v; const float* lb = p.in[19] + 256 * g + 8 * c8v;
        const f32x4 w0 = *(const f32x4*)lw, w1 = *(const f32x4*)(lw + 4), b0 = *(const f32x4*)lb, b1 = *(const f32x4*)(lb + 4);
        f32x4 bsr = {0.f, 0.f, 0.f, 0.f}; if (tid < 32) bsr = *(const f32x4*)(p.in[21] + g * 128 + 4 * tid);
        LDS_BAR();
#pragma unroll
        for (int k = 0; k < 8; ++k) { const int pi = tid + 512 * k, q = pi >> 5, c8 = pi & 31; const v4u raw = vraw[k];
            const float mu = RS[2 * q], rs = RS[2 * q + 1];
            const f32x4 x0 = {bflo(raw.x), bfhi(raw.x), bflo(raw.y), bfhi(raw.y)}, x1 = {bflo(raw.z), bfhi(raw.z), bflo(raw.w), bfhi(raw.w)};
            const f32x4 y0 = (x0 - mu) * rs * w0 + b0, y1 = (x1 - mu) * rs * w1 + b1;
            *(LAS v4u*)(VL + q * 264 + 8 * c8) = pack8f(y0, y1); }
#pragma unroll
        for (int k = 0; k < 4; ++k) { const int pi = tid + 512 * k, pr = pi >> 4, c8 = pi & 15; *(LAS v4u*)(WL + pr * 136 + 8 * c8) = wraw[k]; }
        if (tid < 32) *(LAS f32x4*)(BS + 4 * tid) = bsr;
#pragma unroll
        for (int k = 0; k < 4; ++k) { const int pi = tid + 512 * k, q = pi >> 5, c8 = pi & 31; *(LAS v4u*)(UL + q * 264 + 8 * c8) = uraw[k]; }
        LDS_BAR();
        bf16x8 bfr[8];
        { unsigned t[8][8];
#pragma unroll
          for (int s = 0; s < 8; ++s)
#pragma unroll
              for (int e = 0; e < 8; ++e) t[s][e] = VL[(16 * s + 8 * hh + e) * 264 + col];
          __builtin_amdgcn_sched_barrier(0);
#pragma unroll
          for (int s = 0; s < 8; ++s)
#pragma unroll
              for (int e = 0; e < 8; ++e) bfr[s][e] = (short)t[s][e]; }
        f32x16 acc[4];
#pragma unroll
        for (int rb = 0; rb < 4; ++rb) {
#pragma unroll
            for (int e = 0; e < 16; ++e) acc[rb][e] = 0.f;
            bf16x8 af[8];
#pragma unroll
            for (int s = 0; s < 8; ++s) af[s] = *(const LAS bf16x8*)(WL + (32 * rb + l31) * 136 + 16 * s + 8 * hh);
#pragma unroll
            for (int s = 0; s < 8; ++s) acc[rb] = __builtin_amdgcn_mfma_f32_32x32x16_bf16(af[s], bfr[s], acc[rb], 0, 0, 0);
        }
#pragma unroll
        for (int hf = 0; hf < 2; ++hf) {
            if (hf == 1) { LDS_BAR();
#pragma unroll
                for (int k = 0; k < 4; ++k) { const int pi = tid + 512 * k, q = pi >> 5, c8 = pi & 31; *(LAS v4u*)(UL + q * 264 + 8 * c8) = uraw[4 + k]; }
                LDS_BAR(); }
#pragma unroll
            for (int r2 = 0; r2 < 2; ++r2) { const int rb = 2 * hf + r2; unsigned uv[16];
#pragma unroll
                for (int e = 0; e < 16; ++e) uv[e] = UL[(32 * r2 + (e & 3) + 8 * (e >> 2) + 4 * hh) * 264 + col];
                __builtin_amdgcn_sched_barrier(0);
#pragma unroll
                for (int e = 0; e < 16; ++e) { const int prl = 32 * r2 + (e & 3) + 8 * (e >> 2) + 4 * hh; const float val = acc[rb][e] + BS[64 * hf + prl];
                    UL[prl * 264 + col] = (bf16)f2bf(bf2f((bf16)uv[e]) * val); } }
            LDS_BAR();
#pragma unroll
            for (int k = 0; k < 4; ++k) { const int pi = tid + 512 * k, q = pi >> 5, c8 = pi & 31; *(v4u*)(UV + (size_t)(128 * tc + 64 * hf + q) * 4096 + 256 * g + 8 * c8) = *(const LAS v4u*)(UL + q * 264 + 8 * c8); }
        }
    }
}

#define XB_TMO      128
#define XB_XCNT(j)  (256  + 64 * (j))
#define XB_XSUB(j)  (1280 + 64 * (j))
#define XB_XGEN(j)  (2304 + 64 * (j))
#define XB_TOP      3328
#define XB_TOPGEN   3392
#define XCD_BAR_WORDS 3456
#define XB_SPIN_CAP (1u << 18)

__device__ __forceinline__ unsigned xb_ld(unsigned* p)              { return __hip_atomic_load(p, __ATOMIC_RELAXED, __HIP_MEMORY_SCOPE_AGENT); }
__device__ __forceinline__ unsigned xb_add(unsigned* p, unsigned v) { return __hip_atomic_fetch_add(p, v, __ATOMIC_RELAXED, __HIP_MEMORY_SCOPE_AGENT); }
__device__ __forceinline__ unsigned xb_xcc_id() { return (unsigned)__builtin_amdgcn_s_getreg((3 << 11) | 20) & 0xFu; }
#define XB_SPIN(cond, bar) do { unsigned _sp = 0; while (cond) { __builtin_amdgcn_s_sleep(1); \
    if ((++_sp & 255u) == 0u) { if (xb_ld(&(bar)[XB_TMO])) break; if (_sp > XB_SPIN_CAP) { atomicAdd(&(bar)[XB_TMO], 1u); break; } } } } while (0)

struct XcdBarrier {
    unsigned* bar; unsigned x;
    volatile LAS unsigned* st;
};

__device__ __forceinline__ XcdBarrier xcd_barrier_post(unsigned* bar, volatile LAS unsigned* st) {
    XcdBarrier b; b.bar = bar; b.x = xb_xcc_id(); b.st = st;
    if (threadIdx.x == 0) (void)xb_add(&bar[XB_XCNT(b.x)], 1u);
    return b;
}
__device__ __forceinline__ void xcd_barrier_complete(unsigned* bar, unsigned x, unsigned& nloc, unsigned& nx) {
    const unsigned G = gridDim.x * gridDim.y * gridDim.z;
    unsigned sum, cnt, mine, sp = 0u;
    for (;;) {
        sum = 0u; cnt = 0u; mine = 0u;
#pragma unroll
        for (unsigned j = 0; j < 16; ++j) { const unsigned c = xb_ld(&bar[XB_XCNT(j)]); sum += c; cnt += (c > 0u) ? 1u : 0u; mine = (j == x) ? c : mine; }
        if (sum == G) break;
        __builtin_amdgcn_s_sleep(1);
        if ((++sp & 255u) == 0u) { if (xb_ld(&bar[XB_TMO])) break; if (sp > XB_SPIN_CAP) { atomicAdd(&bar[XB_TMO], 1u); break; } }
    }
    nloc = mine > 0u ? mine : 1u; nx = cnt > 0u ? cnt : 1u;
}

__device__ __forceinline__ void xcd_barrier(const XcdBarrier& b) {
    asm volatile("s_waitcnt vmcnt(0)" ::: "memory");
    __syncthreads();
    if (threadIdx.x == 0) {
        unsigned* bar = b.bar;
        __builtin_amdgcn_s_waitcnt(0);
        unsigned nloc = b.st[0], nx = b.st[1];
        if (nloc == 0u) { xcd_barrier_complete(bar, b.x, nloc, nx); b.st[0] = nloc; b.st[1] = nx; }
        const unsigned old = xb_add(&bar[XB_XSUB(b.x)], 1u);
        const unsigned gen = old / nloc;
        if (old + 1u == (gen + 1u) * nloc) {
            __builtin_amdgcn_fence(__ATOMIC_RELEASE, "agent");
            asm volatile("s_waitcnt vmcnt(0)" ::: "memory");
            const unsigned og = xb_add(&bar[XB_TOP], 1u);
            const unsigned tg = og / nx;
            if (og + 1u == (tg + 1u) * nx) xb_add(&bar[XB_TOPGEN], 1u);
            else XB_SPIN(xb_ld(&bar[XB_TOPGEN]) == tg, bar);
            __builtin_amdgcn_fence(__ATOMIC_ACQUIRE, "agent");
            xb_add(&bar[XB_XGEN(b.x)], 1u);
            asm volatile("s_waitcnt vmcnt(0)" ::: "memory");
        } else {
            XB_SPIN(xb_ld(&bar[XB_XGEN(b.x)]) == gen, bar);
            __builtin_amdgcn_fence(__ATOMIC_ACQUIRE, "agent");
            asm volatile("s_waitcnt vmcnt(0)" ::: "memory");
        }
    }
    __syncthreads();
}

constexpr int XB_LDS_OFF = LDS_BYTES - 256, CW_BAR = 4096;
__device__ __forceinline__ int rep_opaque(int v) { if (v == 0) return 0; asm volatile("" : "+s"(v)); return v; }
#ifndef DN_NAIVE
#define DN_NAIVE 0
#endif
#ifndef USE_CG_SYNC
#define USE_CG_SYNC 0
#endif
constexpr int NPHASE = 19;
__global__ void __launch_bounds__(NWAVES * 64, 2) mega_fwd(Params p) {
    extern __shared__ __attribute__((aligned(16))) unsigned char lds_raw[];
    LAS unsigned char* lds = (LAS unsigned char*)lds_raw;
    const int tid = threadIdx.x, lane = tid & 63, wave = __builtin_amdgcn_readfirstlane(tid >> 6);
    const int G = gridDim.x, bx = blockIdx.x, vcu = (G % 8 == 0) ? (bx % 8) * (G / 8) + bx / 8 : bx;
    unsigned char* ws = p.ws;
    const int lo = p.ph_lo, hi = p.ph_hi;
    XcdBarrier bar; bar.bar = (unsigned*)(ws + WS_CTL) + CW_BAR; bar.x = 0; bar.st = (volatile LAS unsigned*)(lds + XB_LDS_OFF);
    if (!USE_CG_SYNC && hi - lo > 1) {
        if (tid < 64) ((volatile LAS unsigned*)(lds + XB_LDS_OFF))[tid] = 0u;
        __syncthreads();
        bar = xcd_barrier_post((unsigned*)(ws + WS_CTL) + CW_BAR, (volatile LAS unsigned*)(lds + XB_LDS_OFF));
    }
#ifndef PH_MASK
#define PH_MASK 0xFFFFFFFFu
#endif
#ifndef REP_MASK
#define REP_MASK 0u
#endif
#ifndef HOST_REP_MASK
#define HOST_REP_MASK 0u
#endif
#ifndef HOST_VAR_FLAGS
#define HOST_VAR_FLAGS 0
#endif
#define REP(k) ((int)((REP_MASK >> (k)) & 1u))
#define IN(k) (((PH_MASK >> (k)) & 1u) && lo <= (k) && (k) < hi)
#define SEAM(k) do { if (IN(k) && (IN((k) + 1) || ((k) == 3 && IN(5)))) { if (USE_CG_SYNC) cg::this_grid().sync(); else xcd_barrier(bar); } STAMP((k) + 1); } while (0)
#ifdef PROBE_A_LO
    unsigned long long* TS = (unsigned long long*)(ws + WS_CTL + 1024);
#define STAMP(k) do { if (bx == 0 && tid == 0) __hip_atomic_store(TS + (k), __builtin_amdgcn_s_memrealtime(), __ATOMIC_RELAXED, __HIP_MEMORY_SCOPE_AGENT); } while (0)
#else
#define STAMP(k) do { } while (0)
#endif
    const float* MOD = (const float*)(ws + WS_MOD); const float* ZG = (const float*)(ws + WS_CTL + 65536);
    bf16* XN = (bf16*)(ws + WS_XN); float* X = (float*)(ws + WS_X); bf16* Hb = (bf16*)(ws + WS_QKV);

    STAMP(0);
    if (IN(0)) _Pragma("nounroll") for (int rep_ = 0, nrep_ = rep_opaque(REP(0)); rep_ <= nrep_; ++rep_) { phase_prologue(p, lds, tid, lane, wave, vcu, G); } SEAM(0);
    if (IN(1)) _Pragma("nounroll") for (int rep_ = 0, nrep_ = rep_opaque(REP(1)); rep_ <= nrep_; ++rep_) { phase_norm<0>(p, 0, 0, lane, wave, vcu, G); } SEAM(1);
    if (IN(2)) _Pragma("nounroll") for (int rep_ = 0, nrep_ = rep_opaque(REP(2)); rep_ <= nrep_; ++rep_) { pg8::Gemm g{XN, (const bf16*)(ws + WS_WIN), MROWS, NPROJ_PAD, 2048}; pg8::StaticOrder S; S.init(MROWS, NPROJ_PAD, G, bx);
        pg8::EpiProj E{(bf16*)(ws + WS_QKV), (bf16*)(ws + WS_Z), (float*)(ws + WS_AB)};
        pg8::gemm_phase<pg8::EpiProj, pg8::StaticOrder, true, true>(lds, g, S, E); } SEAM(2);
    if (IN(3)) _Pragma("nounroll") for (int rep_ = 0, nrep_ = rep_opaque(REP(3)); rep_ <= nrep_; ++rep_) { phase_dn_front(p, lds, tid, lane, wave, vcu, G); } SEAM(3);
    if (IN(5)) _Pragma("nounroll") for (int rep_ = 0, nrep_ = rep_opaque(REP(5)); rep_ <= nrep_; ++rep_) { phase_dn_seq(p, lds, lane, wave, vcu, G); } SEAM(5);
    if (IN(6)) _Pragma("nounroll") for (int rep_ = 0, nrep_ = rep_opaque(REP(6)); rep_ <= nrep_; ++rep_) { phase_combine(p, lane, wave, vcu, G); } SEAM(6);
    if (IN(7)) _Pragma("nounroll") for (int rep_ = 0, nrep_ = rep_opaque(REP(7)); rep_ <= nrep_; ++rep_) { pg8::Gemm g{(const bf16*)(ws + WS_KA), (const bf16*)(ws + WS_WOUT), MROWS, 2048, 4096}; pg8::StaticOrder S; S.init(MROWS, 2048, G, bx);
        pg8::EpiRes E{X, (rep_ || (p.flags & 256)) ? ZG : MOD + 4096};
        pg8::gemm_phase<pg8::EpiRes, pg8::StaticOrder, true, true>(lds, g, S, E);
        if (G == 256 && bx >= 192 && rep_ == 0) { convert_items(p, lds, 22592, 26688, (bx - 192) * NWAVES + wave, 64 * NWAVES, wave, lane); }
    } SEAM(7);
    if (IN(8)) _Pragma("nounroll") for (int rep_ = 0, nrep_ = rep_opaque(REP(8)); rep_ <= nrep_; ++rep_) { phase_norm<1>(p, 0, 1, lane, wave, vcu, G); } SEAM(8);
    if (IN(9)) _Pragma("nounroll") for (int rep_ = 0, nrep_ = rep_opaque(REP(9)); rep_ <= nrep_; ++rep_) { pg8::Gemm g{XN, (const bf16*)(ws + WS_WFF1), MROWS, 8192, 2048}; pg8::StaticOrder S; S.init(MROWS, 8192, G, bx);
        pg8::EpiAct<0> E{Hb, nullptr, nullptr};
        pg8::gemm_phase<pg8::EpiAct<0>, pg8::StaticOrder, true, true>(lds, g, S, E); } SEAM(9);
    if (IN(10)) _Pragma("nounroll") for (int rep_ = 0, nrep_ = rep_opaque(REP(10)); rep_ <= nrep_; ++rep_) { pg8::Gemm g{Hb, (const bf16*)(ws + WS_WFF2), MROWS, 2048, 8192}; pg8::StaticOrder S; S.init(MROWS, 2048, G, bx);
        pg8::EpiRes E{X, (rep_ || (p.flags & 256)) ? ZG : MOD + 10240};
        pg8::gemm_phase<pg8::EpiRes, pg8::StaticOrder, true, true>(lds, g, S, E);
        if (G == 256 && bx >= 192 && rep_ == 0) { convert_items(p, lds, 8256, 12352, (bx - 192) * NWAVES + wave, 64 * NWAVES, wave, lane); convert_items(p, lds, 12352, 14400, (bx - 192) * NWAVES + wave, 64 * NWAVES, wave, lane); convert_items(p, lds, 18496, 22592, (bx - 192) * NWAVES + wave, 64 * NWAVES, wave, lane); }
    } SEAM(10);
    if (IN(11)) _Pragma("nounroll") for (int rep_ = 0, nrep_ = rep_opaque(REP(11)); rep_ <= nrep_; ++rep_) { phase_norm<1>(p, 1, 0, lane, wave, vcu, G); } SEAM(11);
    if (IN(12)) _Pragma("nounroll") for (int rep_ = 0, nrep_ = rep_opaque(REP(12)); rep_ <= nrep_; ++rep_) { pg8::Gemm g{XN, (const bf16*)(ws + WS_WCMIN), MROWS, 8192, 2048}; pg8::StaticOrder S; S.init(MROWS, 8192, G, bx);
        pg8::EpiAct<1> E{Hb, p.in[17], (float*)(ws + WS_STATS)};
        pg8::gemm_phase<pg8::EpiAct<1>, pg8::StaticOrder, true, true>(lds, g, S, E); } SEAM(12);
    if (IN(13)) _Pragma("nounroll") for (int rep_ = 0, nrep_ = rep_opaque(REP(13)); rep_ <= nrep_; ++rep_) { phase_spatial(p, lds, tid, lane, wave, vcu, G); } SEAM(13);
    if (IN(14)) _Pragma("nounroll") for (int rep_ = 0, nrep_ = rep_opaque(REP(14)); rep_ <= nrep_; ++rep_) { pg8::Gemm g{(const bf16*)(ws + WS_Z), (const bf16*)(ws + WS_WCMOUT), MROWS, 2048, 4096}; pg8::StaticOrder S; S.init(MROWS, 2048, G, bx);
        pg8::EpiRes E{X, (rep_ || (p.flags & 256)) ? ZG : MOD + 3 * 12288 + 4096};
        pg8::gemm_phase<pg8::EpiRes, pg8::StaticOrder, true, true>(lds, g, S, E);
        if (G == 256 && bx >= 192 && rep_ == 0) { convert_items(p, lds, 26688, 30784, (bx - 192) * NWAVES + wave, 64 * NWAVES, wave, lane); }
    } SEAM(14);
    if (IN(15)) _Pragma("nounroll") for (int rep_ = 0, nrep_ = rep_opaque(REP(15)); rep_ <= nrep_; ++rep_) { phase_norm<1>(p, 1, 1, lane, wave, vcu, G); } SEAM(15);
    if (IN(16)) _Pragma("nounroll") for (int rep_ = 0, nrep_ = rep_opaque(REP(16)); rep_ <= nrep_; ++rep_) { pg8::Gemm g{XN, (const bf16*)(ws + WS_WFF1) + (size_t)2048 * 8192, MROWS, 8192, 2048}; pg8::StaticOrder S; S.init(MROWS, 8192, G, bx);
        pg8::EpiAct<0> E{Hb, nullptr, nullptr};
        pg8::gemm_phase<pg8::EpiAct<0>, pg8::StaticOrder, true, true>(lds, g, S, E); } SEAM(16);
    if (IN(17)) _Pragma("nounroll") for (int rep_ = 0, nrep_ = rep_opaque(REP(17)); rep_ <= nrep_; ++rep_) { pg8::Gemm g{Hb, (const bf16*)(ws + WS_WFF2) + (size_t)2048 * 8192, MROWS, 2048, 8192}; pg8::StaticOrder S; S.init(MROWS, 2048, G, bx);
        pg8::EpiRes E{X, (rep_ || (p.flags & 256)) ? ZG : MOD + 3 * 12288 + 10240};
        pg8::gemm_phase<pg8::EpiRes, pg8::StaticOrder, true, true>(lds, g, S, E); } SEAM(17);
    if (IN(18)) _Pragma("nounroll") for (int rep_ = 0, nrep_ = rep_opaque(REP(18)); rep_ <= nrep_; ++rep_) { phase_norm<2>(p, 0, 0, lane, wave, vcu, G); }
#undef IN
#undef SEAM
}

extern "C" void kernel_launch(void* const* d_in, const int* in_sizes, int n_in, void* d_out, int out_size, void* d_ws, size_t ws_size, hipStream_t stream) {
    static int grid = 0;
    if (grid == 0) {
        if (n_in != 26 || ws_size < WS_END) { fprintf(stderr, "kernel_launch: expected 26 inputs and >= %zu bytes of workspace; got %d, %zu\n", (size_t)WS_END, n_in, ws_size); grid = -1; return; }
        int dev = 0, cus = 0, per_cu = 0;
        if (hipGetDevice(&dev) != hipSuccess || hipDeviceGetAttribute(&cus, hipDeviceAttributeMultiprocessorCount, dev) != hipSuccess) { grid = -1; return; }
        if (hipFuncSetAttribute((const void*)mega_fwd, hipFuncAttributeMaxDynamicSharedMemorySize, LDS_BYTES) != hipSuccess) { fprintf(stderr, "kernel_launch: hipFuncSetAttribute failed\n"); grid = -1; return; }
        if (hipOccupancyMaxActiveBlocksPerMultiprocessor(&per_cu, (const void*)mega_fwd, NWAVES * 64, LDS_BYTES) != hipSuccess || per_cu < 1) { fprintf(stderr, "kernel_launch: occupancy query reports %d blocks per CU\n", per_cu); (void)hipGetLastError(); per_cu = 1; }
        grid = cus;
    }
    if (grid < 0) return;
    if (hipMemsetAsync((char*)d_ws + WS_CTL, 0, (REP_MASK || HOST_REP_MASK) ? 262144 : 65536, stream) != hipSuccess) { fprintf(stderr, "kernel_launch: hipMemsetAsync failed\n"); return; }
    Params a{};
    for (int i = 0; i < 26; ++i) a.in[i] = (const float*)d_in[i];
    a.out = (float*)d_out; a.ws = (unsigned char*)d_ws;
#if MK_PER_PHASE
    for (int ph = 0; ph < NPHASE; ++ph) { if (ph == 4) continue; a.ph_lo = ph; a.ph_hi = ph + 1; for (int r = 0; r <= (int)((HOST_REP_MASK >> ph) & 1u); ++r) { a.flags = (r == 0 && ((HOST_REP_MASK >> ph) & 1u)) ? HOST_VAR_FLAGS : 0; hipLaunchKernelGGL(mega_fwd, dim3(grid), dim3(NWAVES * 64), LDS_BYTES, stream, a); } }
#else
    a.ph_lo = 0; a.ph_hi = NPHASE;
    void* args[] = {&a};
    hipError_t e = hipLaunchCooperativeKernel((const void*)mega_fwd, dim3(grid), dim3(NWAVES * 64), args, LDS_BYTES, stream);
    if (e != hipSuccess) fprintf(stderr, "kernel_launch: cooperative launch failed: %s (grid %d)\n", hipGetErrorString(e), grid);
#endif
}
```
